# Optimizing an MI355X kernel written in HIP

```python
import math
import jax, jax.numpy as jnp
from jax import lax
import numpy as np

D_MODEL = 1024
BATCH = 16
SEQ = 2048
DEPTH = 2

D_MIX = 2 * D_MODEL
GROUP_W = D_MIX // 4
HEAD_DIM = 64
N_HEADS_DIFF = GROUP_W // (2 * HEAD_DIM)
DIFF_V_DIM = 2 * HEAD_DIM
N_HEADS_SB = GROUP_W // HEAD_DIM
N_HEADS_FOX = GROUP_W // HEAD_DIM
N_HEADS_MEM = 4
MEM_HEAD_DIM = GROUP_W // N_HEADS_MEM
MEM_LEN = 256
NUM_BUCKETS = 32
MAX_DISTANCE = 128
BLOCK_Q = 128
EPS = 1e-6
NEG = -1e30
COL_SIZES = (GROUP_W, GROUP_W, GROUP_W, GROUP_W, GROUP_W, GROUP_W, GROUP_W, GROUP_W, GROUP_W, N_HEADS_FOX, GROUP_W, D_MIX)
D_IN_PROJ = sum(COL_SIZES)
COL_SPLITS = tuple(int(c) for c in np.cumsum(COL_SIZES)[:-1])

kernel_name = 'hybrid_diff_stickbreak_fox_mem_block'


def _rmsnorm(x, g):
    x32 = x.astype(jnp.float32)
    y = x32 * lax.rsqrt(jnp.mean(x32 * x32, axis=-1, keepdims=True) + EPS)
    return y.astype(x.dtype) * g


def _heads(t, n):
    b, s, _ = t.shape
    return t.reshape(b, s, n, -1).transpose(0, 2, 1, 3)


def _merge(t):
    b, h, s, d = t.shape
    return t.transpose(0, 2, 1, 3).reshape(b, s, h * d)


def _to_blocks(t):
    b, h, s = t.shape[:3]
    t = t.reshape((b, h, s // BLOCK_Q, BLOCK_Q) + t.shape[3:])
    return jnp.moveaxis(t, 2, 0)


def _from_blocks(t):
    nb, b, h, bq, d = t.shape
    return jnp.moveaxis(t, 0, 2).reshape(b, h, nb * bq, d)


def _block_dist(i, s):
    q_pos = i * BLOCK_Q + jnp.arange(BLOCK_Q, dtype=jnp.int32)
    k_pos = jnp.arange(s, dtype=jnp.int32)
    return q_pos[:, None] - k_pos[None, :]


def _t5_bucket(n):
    max_exact = NUM_BUCKETS // 2
    nf = jnp.maximum(n, 1).astype(jnp.float32)
    large = max_exact + (jnp.log(nf / max_exact) / math.log(MAX_DISTANCE / max_exact)
                         * (NUM_BUCKETS - max_exact)).astype(jnp.int32)
    large = jnp.minimum(large, NUM_BUCKETS - 1)
    return jnp.where(n < max_exact, n, large)


def _diff_attention(q, k, v, rel_bias, lam):
    s = q.shape[2]
    scale = HEAD_DIM ** -0.5
    v32 = v.astype(jnp.float32)

    def block(args):
        i, qb = args
        dist = _block_dist(i, s)
        bias = rel_bias[_t5_bucket(jnp.maximum(dist, 0))]
        bias = jnp.moveaxis(bias, -1, 0).astype(jnp.float32)
        logits = jnp.einsum('bhqcd,bhkcd->bchqk', qb, k).astype(jnp.float32) * scale + bias
        logits = jnp.where(dist >= 0, logits, NEG)
        p = jax.nn.softmax(logits, axis=-1)
        a = p[:, 0] - lam * p[:, 1]
        return jnp.einsum('bhqk,bhkd->bhqd', a, v32)

    out = lax.map(block, (jnp.arange(s // BLOCK_Q), _to_blocks(q)))
    return _from_blocks(out)


def _stick_breaking(q, k, v):
    s = q.shape[2]
    scale = HEAD_DIM ** -0.5
    v32 = v.astype(jnp.float32)

    def block(args):
        i, qb = args
        strict = _block_dist(i, s) > 0
        z = jnp.einsum('bhqd,bhkd->bhqk', qb, k).astype(jnp.float32) * scale
        log_rest = jnp.where(strict, jax.nn.log_sigmoid(-z), 0.0)
        tail = lax.cumsum(log_rest, axis=3, reverse=True) - log_rest
        log_a = jax.nn.log_sigmoid(z) + tail
        a = jnp.where(strict, jnp.exp(log_a), 0.0)
        return jnp.einsum('bhqk,bhkd->bhqd', a, v32)

    out = lax.map(block, (jnp.arange(s // BLOCK_Q), _to_blocks(q)))
    return _from_blocks(out)


def _forgetting_attention(q, k, v, log_f):
    s = q.shape[2]
    scale = HEAD_DIM ** -0.5
    v32 = v.astype(jnp.float32)
    c = jnp.cumsum(log_f, axis=-1)

    def block(args):
        i, qb, cb = args
        dist = _block_dist(i, s)
        logits = jnp.einsum('bhqd,bhkd->bhqk', qb, k).astype(jnp.float32) * scale
        logits = logits + (cb[..., :, None] - c[..., None, :])
        logits = jnp.where(dist >= 0, logits, NEG)
        p = jax.nn.softmax(logits, axis=-1)
        return jnp.einsum('bhqk,bhkd->bhqd', p, v32)

    out = lax.map(block, (jnp.arange(s // BLOCK_Q), _to_blocks(q), _to_blocks(c)))
    return _from_blocks(out)


def _memory_attention(q, km, vm):
    scale = MEM_HEAD_DIM ** -0.5
    logits = jnp.einsum('bhqd,bhkd->bhqk', q, km).astype(jnp.float32) * scale
    p = jax.nn.softmax(logits, axis=-1)
    return jnp.einsum('bhqk,bhkd->bhqd', p, vm.astype(jnp.float32))


def setup_inputs(seed: int = 0) -> dict:
    key = jax.random.key(seed)
    ks = jax.random.split(key, 12)
    f32 = jnp.float32
    x = jax.random.normal(ks[0], (BATCH, SEQ, D_MODEL), f32)
    mem = jax.random.normal(ks[1], (BATCH, MEM_LEN, D_MODEL), f32)
    w_in = jax.random.normal(ks[2], (DEPTH, D_MODEL, D_IN_PROJ), f32) * D_MODEL ** -0.5
    b_forget = jax.random.uniform(ks[3], (DEPTH, N_HEADS_FOX), f32, minval=1.0, maxval=4.0)
    w_mem_kv = jax.random.normal(ks[4], (DEPTH, D_MODEL, 2 * GROUP_W), f32) * D_MODEL ** -0.5
    w_out = jax.random.normal(ks[5], (DEPTH, D_MIX, D_MODEL), f32) * D_MIX ** -0.5
    pre_norm = 1.0 + 0.05 * jax.random.normal(ks[6], (DEPTH, D_MODEL), f32)
    post_norm = 1.0 + 0.05 * jax.random.normal(ks[7], (DEPTH, D_MODEL), f32)
    mem_norm = 1.0 + 0.05 * jax.random.normal(ks[8], (DEPTH, D_MODEL), f32)
    diff_lambda = 0.1 * jax.random.normal(ks[9], (DEPTH, 4, HEAD_DIM), f32)
    diff_head_norm = 1.0 + 0.05 * jax.random.normal(ks[10], (DEPTH, DIFF_V_DIM), f32)
    rel_bias = 0.5 * jax.random.normal(ks[11], (NUM_BUCKETS, N_HEADS_DIFF), f32)
    return {'x': x, 'mem': mem, 'w_in': w_in, 'b_forget': b_forget, 'w_mem_kv': w_mem_kv,
            'w_out': w_out, 'pre_norm': pre_norm, 'post_norm': post_norm, 'mem_norm': mem_norm,
            'diff_lambda': diff_lambda, 'diff_head_norm': diff_head_norm, 'rel_bias': rel_bias}


def reference(x, mem, w_in, b_forget, w_mem_kv, w_out, pre_norm, post_norm, mem_norm,
              diff_lambda, diff_head_norm, rel_bias):
    dt = x.dtype
    b, s, _ = x.shape
    for l in range(DEPTH):
        h = _rmsnorm(x, pre_norm[l])
        proj = h @ w_in[l]
        (a_q, a_k, a_v, sb_q, sb_k, sb_v, f_q, f_k, f_v, f_logit, m_q, gate) = jnp.split(
            proj, COL_SPLITS, axis=-1)

        lam_init = 0.8 - 0.6 * math.exp(-0.3 * l)
        lam_p = diff_lambda[l].astype(jnp.float32)
        lam = (jnp.exp(jnp.sum(lam_p[0] * lam_p[1])) - jnp.exp(jnp.sum(lam_p[2] * lam_p[3]))
               + lam_init)
        qa = _heads(a_q, N_HEADS_DIFF).reshape(b, N_HEADS_DIFF, s, 2, HEAD_DIM)
        ka = _heads(a_k, N_HEADS_DIFF).reshape(b, N_HEADS_DIFF, s, 2, HEAD_DIM)
        va = _heads(a_v, N_HEADS_DIFF)
        o_a = _diff_attention(qa, ka, va, rel_bias, lam)
        o_a = _rmsnorm(o_a, diff_head_norm[l]) * (1.0 - lam_init)

        o_b = _stick_breaking(_heads(sb_q, N_HEADS_SB), _heads(sb_k, N_HEADS_SB),
                              _heads(sb_v, N_HEADS_SB))

        log_f = jax.nn.log_sigmoid((f_logit + b_forget[l]).astype(jnp.float32)).transpose(0, 2, 1)
        o_c = _forgetting_attention(_heads(f_q, N_HEADS_FOX), _heads(f_k, N_HEADS_FOX),
                                    _heads(f_v, N_HEADS_FOX), log_f)

        kv = _rmsnorm(mem, mem_norm[l]) @ w_mem_kv[l]
        km, vm = jnp.split(kv, 2, axis=-1)
        o_m = _memory_attention(_heads(m_q, N_HEADS_MEM), _heads(km, N_HEADS_MEM),
                                _heads(vm, N_HEADS_MEM))

        y = jnp.concatenate([_merge(o_a).astype(dt), _merge(o_b).astype(dt),
                             _merge(o_c).astype(dt), _merge(o_m).astype(dt)], axis=-1)
        y = y * jax.nn.silu(gate)
        x = x + _rmsnorm(y @ w_out[l], post_norm[l])
    return x
```

```cpp
#include <hip/hip_runtime.h>
#include <cstdio>
#include <cstdint>
namespace pg8 {
#define PG8_LAS __attribute__((address_space(3)))
typedef unsigned short bf16_t;
typedef short bf16x8 __attribute__((ext_vector_type(8)));
typedef float f32x4 __attribute__((ext_vector_type(4)));
typedef unsigned u32x4 __attribute__((ext_vector_type(4)));
constexpr int BM = 256, BK = 64, HALF = 128, HTB = HALF * BK * 2  , STAGE_BYTES = 8 * HTB, NXCD = 8, WGM = 8;

__host__ __device__ __forceinline__ int lds_byte(int r, int c) { const int st = (r >> 4) * 2 + (c >> 5), rr = r & 15, cc = c & 31, ob = rr * 64 + cc * 2; return st * 1024 + (ob ^ (((ob >> 9) & 1) << 5)); }
__host__ __device__ __forceinline__ void stage_rc(int b, int& R, int& C) { const int st = b / 1024, sb = b % 1024, swz = sb ^ (((sb >> 9) & 1) << 5); R = (st >> 1) * 16 + swz / 64; C = (st & 1) * 32 + (swz % 64) / 2; }
__host__ __device__ __forceinline__ int perm32(int rho) { const int n = rho >> 4, i = rho & 15; return 8 * (i >> 2) + 4 * n + (i & 3); }

struct Unit { int pm, pn; };
struct Gemm { const bf16_t* A; const bf16_t* Bt; int M, N, K, lda; };

struct StaticOrder {
    int nM, nN, nwg, G, c;
    __host__ __device__ void init(int M, int N, int G_, int c_) { nM = M / BM; nN = N / BM; nwg = nM * nN; G = G_; c = c_; }
    __host__ __device__ bool next(int i, Unit& u) const {
        const long L = (long)i * G + c; if (L >= nwg) return false;
        int wgid = (int)L; { const int q = nwg / NXCD, r = nwg % NXCD, xcd = wgid % NXCD, off = wgid / NXCD; wgid = (xcd < r ? xcd * (q + 1) : r * (q + 1) + (xcd - r) * q) + off; }
        const int nig = WGM * nN, gid = wgid / nig, fm = gid * WGM, gsz = (nM - fm) < WGM ? (nM - fm) : WGM;
        u.pm = fm + ((wgid % nig) % gsz); u.pn = (wgid % nig) / gsz; return true;
    }
    __device__ __forceinline__ void a_ready(const Unit&) const {}
    __device__ __forceinline__ void done(const Unit&) const {}
};

__device__ __forceinline__ unsigned cvt_pk_bf16(float lo, float hi) { unsigned r; asm volatile("v_cvt_pk_bf16_f32 %0, %1, %2" : "=v"(r) : "v"(lo), "v"(hi)); return r; }

struct EpiBf16 {
    static constexpr bool PERM = true, AFTER_DRAIN = false;
    bf16_t* O; int ldc;
    __device__ __forceinline__ void operator()(const f32x4 (&acc)[2][2][4][2], const Unit& u, int wr, int wc, int fr, int fq) const {
        const int row0 = u.pm * BM + wr * 64 + fr; const int col0 = u.pn * BM + wc * 32 + 8 * fq;
#pragma unroll
        for (int ai = 0; ai < 2; ++ai)
#pragma unroll
            for (int m = 0; m < 4; ++m) { bf16_t* rowp = O + (size_t)(row0 + ai * HALF + m * 16) * ldc + col0;
#pragma unroll
                for (int bj = 0; bj < 2; ++bj) { const f32x4 v0 = acc[ai][bj][m][0], v1 = acc[ai][bj][m][1];
                    u32x4 w; w.x = cvt_pk_bf16(v0[0], v0[1]); w.y = cvt_pk_bf16(v0[2], v0[3]); w.z = cvt_pk_bf16(v1[0], v1[1]); w.w = cvt_pk_bf16(v1[2], v1[3]);
                    *(u32x4*)(rowp + bj * HALF) = w; } }
    }
};
__device__ __forceinline__ float silu_f(float v) { return v * __builtin_amdgcn_rcpf(1.0f + __builtin_amdgcn_exp2f(-1.4426950408889634f * v)); }
struct EpiProj {
    static constexpr bool PERM = true, AFTER_DRAIN = false;
    bf16_t* proj; bf16_t* y; size_t seg_stride;
    __device__ __forceinline__ void operator()(const f32x4 (&acc)[2][2][4][2], const Unit& u, int wr, int wc, int fr, int fq) const {
        const int row0 = u.pm * BM + wr * 64 + fr; const int colt = u.pn * BM; const bool gate = colt >= 5120;
        bf16_t* base; int ldc, col0;
        if (gate) { base = y; ldc = 2048; col0 = colt - 5120 + wc * 32 + 8 * fq; }
        else { base = proj + (size_t)(colt >> 9) * seg_stride; ldc = 512; col0 = (colt & 511) + wc * 32 + 8 * fq; }
#pragma unroll
        for (int ai = 0; ai < 2; ++ai)
#pragma unroll
            for (int m = 0; m < 4; ++m) { bf16_t* rowp = base + (size_t)(row0 + ai * HALF + m * 16) * ldc + col0;
#pragma unroll
                for (int bj = 0; bj < 2; ++bj) { f32x4 v0 = acc[ai][bj][m][0], v1 = acc[ai][bj][m][1];
                    if (gate) {
#pragma unroll
                        for (int e = 0; e < 4; ++e) { v0[e] = silu_f(v0[e]); v1[e] = silu_f(v1[e]); } }
                    u32x4 w; w.x = cvt_pk_bf16(v0[0], v0[1]); w.y = cvt_pk_bf16(v0[2], v0[3]); w.z = cvt_pk_bf16(v1[0], v1[1]); w.w = cvt_pk_bf16(v1[2], v1[3]);
                    *(u32x4*)(rowp + bj * HALF) = w; } }
    }
};
struct EpiF32 {
    static constexpr bool PERM = false, AFTER_DRAIN = false;
    float* O; int ldc;
    __device__ __forceinline__ void operator()(const f32x4 (&acc)[2][2][4][2], const Unit& u, int wr, int wc, int fr, int fq) const {
        const int col0 = u.pn * BM + wc * 32 + 4 * fq;
#pragma unroll
        for (int ai = 0; ai < 2; ++ai)
#pragma unroll
            for (int m = 0; m < 4; ++m) { float* rowp = O + (size_t)(u.pm * BM + ai * HALF + wr * 64 + m * 16 + fr) * ldc + col0;
#pragma unroll
                for (int bj = 0; bj < 2; ++bj)
#pragma unroll
                    for (int n = 0; n < 2; ++n) *(f32x4*)(rowp + bj * HALF + n * 16) = acc[ai][bj][m][n]; }
    }
};

template <class Epi, class Sched, bool ALIGN_EPI = false, bool SP2 = false>
__device__ __forceinline__ void gemm_phase(PG8_LAS unsigned char* lds, const Gemm g, const Sched& S, const Epi& E) {
    int tid_ = threadIdx.x; asm volatile("" : "+v"(tid_));
    const int tid = tid_, wid = __builtin_amdgcn_readfirstlane(tid >> 6), lane = tid & 63, wr = wid >> 2, wc = wid & 3, fr = lane & 15, fq = lane >> 4;
    const int K = g.K, nt = K / BK;
    unsigned voffA[2], voffB[2];
#pragma unroll
    for (int i = 0; i < 2; ++i) { int R, C; stage_rc(tid * 16 + i * 8192, R, C); const int Rb = Epi::PERM ? ((R & ~31) + perm32(R & 31)) : R;
        voffA[i] = (unsigned)(R * g.lda + C) * 2u; voffB[i] = (unsigned)(Rb * K + C) * 2u; }
    const size_t kstep = (size_t)(BK * 2);
    const size_t hstepA = (size_t)HALF * g.lda * 2, hstepB = (size_t)HALF * K * 2;
    const size_t tstepA = 2 * hstepA, tstepB = 2 * hstepB;
    const unsigned ldsw = (unsigned)wid * 1024u;
    const int aoff = lds_byte(wr * 64 + fr, fq * 8), boff = lds_byte(wc * 32 + fr, fq * 8);
#define PG8_SA(b, h) (((b) * 2 + (h)) * HTB)
#define PG8_SB(b, h) ((4 + (b) * 2 + (h)) * HTB)
#define PG8_STAGE(bufoff, gbase, voff) do { _Pragma("unroll") for (int _i = 0; _i < 2; ++_i) \
        __builtin_amdgcn_global_load_lds((const unsigned*)((const char*)(gbase) + (voff)[_i]), (PG8_LAS unsigned*)(lds + (bufoff) + ldsw + _i * 8192), 16, 0, 0); } while (0)
#define PG8_LDA(dst, b, h) do { _Pragma("unroll") for (int m = 0; m < 4; ++m) _Pragma("unroll") for (int k = 0; k < 2; ++k) dst[m][k] = *(const PG8_LAS bf16x8*)(lds + PG8_SA(b, h) + aoff + m * 2048 + k * 1024); } while (0)
#define PG8_LDB(dst, b, h) do { _Pragma("unroll") for (int n = 0; n < 2; ++n) _Pragma("unroll") for (int k = 0; k < 2; ++k) dst[n][k] = *(const PG8_LAS bf16x8*)(lds + PG8_SB(b, h) + boff + n * 2048 + k * 1024); } while (0)
#define PG8_MMA(ai, bj, At, Bt) do { __builtin_amdgcn_s_setprio(1); _Pragma("unroll") for (int m = 0; m < 4; ++m) _Pragma("unroll") for (int n = 0; n < 2; ++n) _Pragma("unroll") for (int k = 0; k < 2; ++k) \
        acc[ai][bj][m][n] = __builtin_amdgcn_mfma_f32_16x16x32_bf16(Bt[n][k], At[m][k], acc[ai][bj][m][n], 0, 0, 0); __builtin_amdgcn_s_setprio(0); } while (0)
#define PG8_WAIT_V(n) asm volatile("s_waitcnt vmcnt(" #n ")" ::: "memory")
#define PG8_WAIT_L(n) asm volatile("s_waitcnt lgkmcnt(" #n ")" ::: "memory")
#define PG8_BAR __builtin_amdgcn_s_barrier()
#define PG8_SCHED __builtin_amdgcn_sched_barrier(0)
    Unit cur, nxt; int ui = 0;
    if (!S.next(0, cur)) return;
    f32x4 acc[2][2][4][2];
#pragma unroll
    for (int a = 0; a < 2; ++a)
#pragma unroll
        for (int b = 0; b < 2; ++b)
#pragma unroll
            for (int m = 0; m < 4; ++m)
#pragma unroll
                for (int n = 0; n < 2; ++n) acc[a][b][m][n] = (f32x4){0.f, 0.f, 0.f, 0.f};
    bf16x8 At[4][2], B0[2][2], B1[2][2];
    const char* cA = (const char*)g.A + (size_t)cur.pm * tstepA; const char* cB = (const char*)g.Bt + (size_t)cur.pn * tstepB;
    S.a_ready(cur);
    if constexpr (SP2) {
        PG8_STAGE(PG8_SB(0, 0), cB, voffB); PG8_STAGE(PG8_SB(0, 1), cB + hstepB, voffB); PG8_STAGE(PG8_SA(0, 0), cA, voffA); PG8_STAGE(PG8_SA(0, 1), cA + hstepA, voffA);
        if (wr == 1) PG8_BAR;
        PG8_WAIT_V(2); PG8_BAR;
        PG8_STAGE(PG8_SB(1, 0), cB + kstep, voffB); PG8_STAGE(PG8_SA(1, 0), cA + kstep, voffA); PG8_STAGE(PG8_SB(1, 1), cB + hstepB + kstep, voffB);
        PG8_WAIT_V(6); PG8_BAR;
    } else {
        PG8_STAGE(PG8_SB(0, 0), cB, voffB); PG8_STAGE(PG8_SA(0, 0), cA, voffA); PG8_STAGE(PG8_SB(0, 1), cB + hstepB, voffB); PG8_STAGE(PG8_SA(0, 1), cA + hstepA, voffA);
        if (wr == 1) PG8_BAR;
        PG8_WAIT_V(4); PG8_BAR;
        PG8_STAGE(PG8_SB(1, 0), cB + kstep, voffB); PG8_STAGE(PG8_SA(1, 0), cA + kstep, voffA); PG8_STAGE(PG8_SB(1, 1), cB + hstepB + kstep, voffB);
        PG8_WAIT_V(6); PG8_BAR;
    }
    for (;;) {
        const bool has_next = S.next(ui + 1, nxt);
        const char* nA = has_next ? (const char*)g.A + (size_t)nxt.pm * tstepA : cA; const char* nB = has_next ? (const char*)g.Bt + (size_t)nxt.pn * tstepB : cB;
        for (int t = 0; t < nt; t += 2) {
            const bool last = (t == nt - 2);
            const char* a1 = cA + (size_t)(t + 1) * kstep;
            const char* a2 = last ? nA : cA + (size_t)(t + 2) * kstep; const char* b2 = last ? nB : cB + (size_t)(t + 2) * kstep;
            const char* a3 = a2 + kstep; const char* b3 = b2 + kstep;
            if (last && has_next) S.a_ready(nxt);
            if constexpr (SP2) {
            PG8_LDB(B0, 0, 0); PG8_LDB(B1, 0, 1); PG8_SCHED; PG8_LDA(At, 0, 0); PG8_STAGE(PG8_SA(1, 1), a1 + hstepA, voffA);
            PG8_WAIT_V(8); PG8_WAIT_L(0); PG8_BAR; PG8_MMA(0, 0, At, B0); PG8_MMA(0, 1, At, B1); PG8_BAR; PG8_SCHED;
            PG8_LDA(At, 0, 1); PG8_STAGE(PG8_SB(0, 0), b2, voffB); PG8_STAGE(PG8_SB(0, 1), b2 + hstepB, voffB); PG8_STAGE(PG8_SA(0, 0), a2, voffA);
            PG8_WAIT_V(8); PG8_WAIT_L(0); PG8_BAR; PG8_MMA(1, 0, At, B0); PG8_MMA(1, 1, At, B1); PG8_BAR; PG8_SCHED;
            PG8_LDB(B0, 1, 0); PG8_LDB(B1, 1, 1); PG8_SCHED; PG8_LDA(At, 1, 0); PG8_STAGE(PG8_SA(0, 1), a2 + hstepA, voffA);
            PG8_WAIT_V(8); PG8_WAIT_L(0); PG8_BAR; PG8_MMA(0, 0, At, B0); PG8_MMA(0, 1, At, B1); PG8_BAR; PG8_SCHED;
            PG8_LDA(At, 1, 1); PG8_STAGE(PG8_SB(1, 0), b3, voffB); PG8_STAGE(PG8_SB(1, 1), b3 + hstepB, voffB); PG8_STAGE(PG8_SA(1, 0), a3, voffA);
            PG8_WAIT_V(8); PG8_WAIT_L(0); PG8_BAR; PG8_MMA(1, 0, At, B0); PG8_MMA(1, 1, At, B1); PG8_BAR; PG8_SCHED;
            } else {
            PG8_LDB(B0, 0, 0); PG8_SCHED; PG8_LDA(At, 0, 0); PG8_STAGE(PG8_SA(1, 1), a1 + hstepA, voffA);
            PG8_WAIT_L(8); PG8_BAR; PG8_WAIT_L(0); PG8_MMA(0, 0, At, B0); PG8_BAR; PG8_SCHED;
            PG8_LDB(B1, 0, 1); PG8_STAGE(PG8_SB(0, 0), b2, voffB);
            PG8_BAR; PG8_WAIT_L(0); PG8_MMA(0, 1, At, B1); PG8_BAR;
            PG8_LDA(At, 0, 1); PG8_STAGE(PG8_SA(0, 0), a2, voffA);
            PG8_BAR; PG8_WAIT_L(0); PG8_MMA(1, 0, At, B0); PG8_BAR; PG8_SCHED;
            PG8_STAGE(PG8_SB(0, 1), b2 + hstepB, voffB);
            PG8_WAIT_V(6); PG8_BAR; PG8_MMA(1, 1, At, B1); PG8_BAR;
            PG8_LDB(B0, 1, 0); PG8_SCHED; PG8_LDA(At, 1, 0); PG8_STAGE(PG8_SA(0, 1), a2 + hstepA, voffA);
            PG8_WAIT_L(8); PG8_BAR; PG8_WAIT_L(0); PG8_MMA(0, 0, At, B0); PG8_BAR; PG8_SCHED;
            PG8_LDB(B1, 1, 1); PG8_STAGE(PG8_SB(1, 0), b3, voffB);
            PG8_BAR; PG8_WAIT_L(0); PG8_MMA(0, 1, At, B1); PG8_BAR;
            PG8_LDA(At, 1, 1); PG8_STAGE(PG8_SA(1, 0), a3, voffA);
            PG8_BAR; PG8_WAIT_L(0); PG8_MMA(1, 0, At, B0); PG8_BAR; PG8_SCHED;
            PG8_STAGE(PG8_SB(1, 1), b3 + hstepB, voffB);
            PG8_WAIT_V(6); PG8_BAR; PG8_MMA(1, 1, At, B1); PG8_BAR;
            }
        }
        if constexpr (ALIGN_EPI) { if (wr == 0) PG8_BAR; }
        if constexpr (!Epi::AFTER_DRAIN) { E(acc, cur, wr, wc, fr, fq); S.done(cur); }
        if (!has_next) break;
#pragma unroll
        for (int a = 0; a < 2; ++a)
#pragma unroll
            for (int b = 0; b < 2; ++b)
#pragma unroll
                for (int m = 0; m < 4; ++m)
#pragma unroll
                    for (int n = 0; n < 2; ++n) acc[a][b][m][n] = (f32x4){0.f, 0.f, 0.f, 0.f};
        cur = nxt; cA = nA; cB = nB; ++ui;
        if constexpr (ALIGN_EPI) { if (wr == 1) PG8_BAR; }
    }
    PG8_WAIT_V(0);
    if constexpr (!ALIGN_EPI) { if (wr == 0) PG8_BAR; }
    PG8_BAR;
    if constexpr (Epi::AFTER_DRAIN) { E.fused(acc, cur, wr, wc, fr, fq, lds, wid, lane); S.done(cur); }
#undef PG8_SA
#undef PG8_SB
#undef PG8_STAGE
#undef PG8_LDA
#undef PG8_LDB
#undef PG8_MMA
#undef PG8_WAIT_V
#undef PG8_WAIT_L
#undef PG8_BAR
#undef PG8_SCHED
}
}

constexpr int BATCH = 16, SEQ = 2048, DMODEL = 1024, MROWS = BATCH * SEQ;
constexpr int DMIX = 2048, NPROJ = 7168, DIN = 7176, NHF = 8;
constexpr int MEM_LEN = 256, MMEM = BATCH * MEM_LEN;
constexpr float EPS = 1e-6f, LOG2E = 1.4426950408889634f;
constexpr float QSCALE64 = 0.125f * LOG2E;
constexpr float QSCALE128 = 0.08838834764831845f * LOG2E;

constexpr size_t MiB = 1u << 20;
constexpr size_t WS_PROJ = 0;
constexpr size_t SEG_BYTES = 32 * MiB;
constexpr size_t WS_Y = 320 * MiB;
constexpr size_t WS_OG = 0;
constexpr size_t WS_WIN = 448 * MiB;
constexpr size_t WS_WOUT = 462 * MiB;
constexpr size_t WS_WMKV = 466 * MiB;
constexpr size_t WS_HM = 468 * MiB;
constexpr size_t WS_MKV = 476 * MiB;
constexpr size_t WS_LOGF = 484 * MiB;
constexpr size_t WS_C2 = 485 * MiB;
constexpr size_t WS_CTL = 486 * MiB, CTL_ZERO_BYTES = 1 * MiB;
constexpr size_t WS_END = 487 * MiB;
constexpr int CW_BAR = 4096;
constexpr int CW_QUEUE = 16384;

constexpr int RING_BYTES = 131072;
constexpr int LDSCTL_OFF = RING_BYTES, MISC_OFF = LDSCTL_OFF + 320;
constexpr int LDS_BYTES = 147456;
constexpr int NWAVES = 8;

#define GAS __attribute__((address_space(1)))
#define LAS __attribute__((address_space(3)))
typedef unsigned short bf16;
typedef unsigned v4u __attribute__((ext_vector_type(4)));
typedef float f32x4 __attribute__((ext_vector_type(4)));
typedef short bf16x8 __attribute__((ext_vector_type(8)));
typedef GAS unsigned gu32;
typedef GAS unsigned long long gu64;
#define RLX_AGENT __ATOMIC_RELAXED, __HIP_MEMORY_SCOPE_AGENT
#define LDS_WAIT() asm volatile("s_waitcnt lgkmcnt(0)" ::: "memory")
#define VM_WAIT() asm volatile("s_waitcnt vmcnt(0)" ::: "memory")
__device__ __forceinline__ unsigned long long rt() { return __builtin_amdgcn_s_memrealtime(); }
__device__ __forceinline__ unsigned f2bf(float f) { unsigned u = __builtin_bit_cast(unsigned, f); return (u + 0x7fffu + ((u >> 16) & 1u)) >> 16; }
__device__ __forceinline__ unsigned pk2(float lo, float hi) { return f2bf(lo) | (f2bf(hi) << 16); }

#define XB_TMO      128
#define XB_XCNT(j)  (256  + 64 * (j))
#define XB_XSUB(j)  (1280 + 64 * (j))
#define XB_XGEN(j)  (2304 + 64 * (j))
#define XB_TOP      3328
#define XB_TOPGEN   3392
#define XCD_BAR_WORDS 3456
#define XB_SPIN_CAP (1u << 18)

__device__ __forceinline__ unsigned xb_ld(unsigned* p)              { return __hip_atomic_load(p, __ATOMIC_RELAXED, __HIP_MEMORY_SCOPE_AGENT); }
__device__ __forceinline__ unsigned xb_add(unsigned* p, unsigned v) { return __hip_atomic_fetch_add(p, v, __ATOMIC_RELAXED, __HIP_MEMORY_SCOPE_AGENT); }
__device__ __forceinline__ unsigned xb_xcc_id() { return (unsigned)__builtin_amdgcn_s_getreg((3 << 11) | 20) & 0xFu; }
#define XB_SPIN(cond, bar) do { unsigned _sp = 0; while (cond) { __builtin_amdgcn_s_sleep(1); \
    if ((++_sp & 255u) == 0u) { if (xb_ld(&(bar)[XB_TMO])) break; if (_sp > XB_SPIN_CAP) { atomicAdd(&(bar)[XB_TMO], 1u); break; } } } } while (0)

struct XcdBarrier {
    unsigned* bar; unsigned x;
    volatile LAS unsigned* st;
};

__device__ __forceinline__ XcdBarrier xcd_barrier_post(unsigned* bar, volatile LAS unsigned* st) {
    XcdBarrier b; b.bar = bar; b.x = xb_xcc_id(); b.st = st;
    if (threadIdx.x == 0) (void)xb_add(&bar[XB_XCNT(b.x)], 1u);
    return b;
}
__device__ __forceinline__ void xcd_barrier_complete(unsigned* bar, unsigned x, unsigned& nloc, unsigned& nx) {
    const unsigned G = gridDim.x * gridDim.y * gridDim.z;
    unsigned sum, cnt, mine, sp = 0u;
    for (;;) {
        sum = 0u; cnt = 0u; mine = 0u;
#pragma unroll
        for (unsigned j = 0; j < 16; ++j) { const unsigned c = xb_ld(&bar[XB_XCNT(j)]); sum += c; cnt += (c > 0u) ? 1u : 0u; mine = (j == x) ? c : mine; }
        if (sum == G) break;
        __builtin_amdgcn_s_sleep(1);
        if ((++sp & 255u) == 0u) { if (xb_ld(&bar[XB_TMO])) break; if (sp > XB_SPIN_CAP) { atomicAdd(&bar[XB_TMO], 1u); break; } }
    }
    nloc = mine > 0u ? mine : 1u; nx = cnt > 0u ? cnt : 1u;
}

__device__ __forceinline__ void xcd_barrier(const XcdBarrier& b) {
    asm volatile("s_waitcnt vmcnt(0)" ::: "memory");
    __syncthreads();
    if (threadIdx.x == 0) {
        unsigned* bar = b.bar;
        __builtin_amdgcn_s_waitcnt(0);
        unsigned nloc = b.st[0], nx = b.st[1];
        if (nloc == 0u) { xcd_barrier_complete(bar, b.x, nloc, nx); b.st[0] = nloc; b.st[1] = nx; }
        const unsigned old = xb_add(&bar[XB_XSUB(b.x)], 1u);
        const unsigned gen = old / nloc;
        if (old + 1u == (gen + 1u) * nloc) {
            __builtin_amdgcn_fence(__ATOMIC_RELEASE, "agent");
            asm volatile("s_waitcnt vmcnt(0)" ::: "memory");
            const unsigned og = xb_add(&bar[XB_TOP], 1u);
            const unsigned tg = og / nx;
            if (og + 1u == (tg + 1u) * nx) xb_add(&bar[XB_TOPGEN], 1u);
            else XB_SPIN(xb_ld(&bar[XB_TOPGEN]) == tg, bar);
            __builtin_amdgcn_fence(__ATOMIC_ACQUIRE, "agent");
            xb_add(&bar[XB_XGEN(b.x)], 1u);
            asm volatile("s_waitcnt vmcnt(0)" ::: "memory");
        } else {
            XB_SPIN(xb_ld(&bar[XB_XGEN(b.x)]) == gen, bar);
            __builtin_amdgcn_fence(__ATOMIC_ACQUIRE, "agent");
            asm volatile("s_waitcnt vmcnt(0)" ::: "memory");
        }
    }
    __syncthreads();
}

struct Args { const float* in[12]; float* out; unsigned char* ws; int ph_lo, ph_hi; };

struct Frame {
    LAS unsigned char* lds;
    volatile LAS unsigned* MISC;
    gu32* ctl;
    int tid, lane, wave;
    int vcu, G;
    const Args* a;
};
#define F_X(F) ((F).a->in[0])
#define F_MEM(F) ((F).a->in[1])
#define F_WIN(F) ((F).a->in[2])
#define F_BFORGET(F) ((F).a->in[3])
#define F_WMKV(F) ((F).a->in[4])
#define F_WOUT(F) ((F).a->in[5])
#define F_PRE(F) ((F).a->in[6])
#define F_POST(F) ((F).a->in[7])
#define F_MEMNORM(F) ((F).a->in[8])
#define F_DLAM(F) ((F).a->in[9])
#define F_DHN(F) ((F).a->in[10])
#define F_RELB(F) ((F).a->in[11])
#define F_OUT(F) ((F).a->out)
#define F_WS(F) ((F).a->ws)
__device__ __forceinline__ float bf2f(unsigned short u) { return __uint_as_float((unsigned)u << 16); }
__device__ __forceinline__ float wave_sum(float v) {
#pragma unroll
    for (int o = 1; o < 64; o <<= 1) v += __shfl_xor(v, o);
    return v;
}
__device__ __forceinline__ float log_sigmoid_f(float v) { return v >= 0.f ? -log1pf(expf(-v)) : v - log1pf(expf(v)); }

__device__ __forceinline__ void p0_transpose_item(const float* W, int ldw, int K, bf16* WT, int k0, int n0, int csrc0, float sc, LAS float* scr, int lane) {
#pragma unroll 8
    for (int i = 0; i < 32; ++i) { const int kk = 2 * i + (lane >> 5); scr[kk * 33 + (lane & 31)] = W[(size_t)(k0 + kk) * ldw + csrc0 + (lane & 31)]; }
    LDS_WAIT(); asm volatile("" ::: "memory");
    const int c = lane & 7;
#pragma unroll
    for (int j = 0; j < 4; ++j) { const int n = (lane >> 3) + 8 * j; const LAS float* s = scr + (8 * c) * 33 + n;
        v4u o; o.x = pk2(s[0 * 33] * sc, s[1 * 33] * sc); o.y = pk2(s[2 * 33] * sc, s[3 * 33] * sc); o.z = pk2(s[4 * 33] * sc, s[5 * 33] * sc); o.w = pk2(s[6 * 33] * sc, s[7 * 33] * sc);
        *(GAS v4u*)(WT + (size_t)(n0 + n) * K + k0 + 8 * c) = o; }
    LDS_WAIT(); asm volatile("" ::: "memory");
}
__device__ __forceinline__ void p0_weights(Frame& F0, int l) {
    Frame F = F0; asm volatile("" : "+v"(F.lane), "+v"(F.tid));
    LAS float* scr = (LAS float*)(F.lds + F.wave * 8448);
    const int gw = F.vcu * NWAVES + F.wave, NGW = F.G * NWAVES;
    constexpr int I_IN = 16 * 224, I_OUT = 32 * 32, I_MKV = 16 * 32;
    const float* win = F_WIN(F) + (size_t)l * DMODEL * DIN; const float* wout = F_WOUT(F) + (size_t)l * DMIX * DMODEL; const float* wmkv = F_WMKV(F) + (size_t)l * DMODEL * 1024;
    for (int it = gw; it < I_IN + I_OUT + I_MKV; it += NGW) {
        int r = it;
        if (r < I_IN) { const int kb = r / 224, nb = r % 224, n0 = 32 * nb; const int csrc0 = n0 + (n0 >= 4608 ? 8 : 0);
            float sc = 1.f; if (n0 < 512 || (n0 >= 1536 && n0 < 2048) || (n0 >= 3072 && n0 < 3584)) sc = QSCALE64; else if (n0 >= 4608 && n0 < 5120) sc = QSCALE128;
            p0_transpose_item(win, DIN, DMODEL, (bf16*)(F_WS(F) + WS_WIN), 64 * kb, n0, csrc0, sc, scr, F.lane); continue; }
        r -= I_IN;
        if (r < I_OUT) { const int kb = r / 32, nb = r % 32; p0_transpose_item(wout, DMODEL, DMIX, (bf16*)(F_WS(F) + WS_WOUT), 64 * kb, 32 * nb, 32 * nb, 1.f, scr, F.lane); continue; }
        r -= I_OUT;
        { const int kb = r / 32, nb = r % 32; p0_transpose_item(wmkv, 1024, DMODEL, (bf16*)(F_WS(F) + WS_WMKV), 64 * kb, 32 * nb, 32 * nb, 1.f, scr, F.lane); }
    }
}
__device__ __forceinline__ void p0_mem_rows(Frame& F0, int l) {
    Frame F = F0; asm volatile("" : "+v"(F.lane), "+v"(F.tid));
    const int gw = F.vcu * NWAVES + F.wave, NGW = F.G * NWAVES;
    const GAS f32x4* gp = (const GAS f32x4*)(F_MEMNORM(F) + l * DMODEL) + F.lane; f32x4 g[4];
#pragma unroll
    for (int j = 0; j < 4; ++j) g[j] = gp[64 * j];
    for (int m = gw; m < MMEM; m += NGW) {
        const GAS f32x4* xr = (const GAS f32x4*)(F_MEM(F) + (size_t)m * DMODEL) + F.lane; f32x4 v[4]; float s2 = 0.f;
#pragma unroll
        for (int j = 0; j < 4; ++j) { v[j] = xr[64 * j]; s2 += (v[j].x * v[j].x + v[j].y * v[j].y) + (v[j].z * v[j].z + v[j].w * v[j].w); }
        const float r = 1.0f / sqrtf(wave_sum(s2) * (1.f / DMODEL) + EPS);
        GAS unsigned long long* o8 = (GAS unsigned long long*)(F_WS(F) + WS_HM + (size_t)m * DMODEL * 2) + F.lane;
#pragma unroll
        for (int j = 0; j < 4; ++j) { const f32x4 h = v[j] * r * g[j]; o8[64 * j] = (unsigned long long)pk2(h.x, h.y) | ((unsigned long long)pk2(h.z, h.w) << 32); }
    }
}
__device__ __forceinline__ void p0_rows(Frame& F0, int l) {
    Frame F = F0; asm volatile("" : "+v"(F.lane), "+v"(F.tid));
    const int gw = F.vcu * NWAVES + F.wave, NGW = F.G * NWAVES, lane = F.lane;
    LAS float* wf = (LAS float*)(F.lds + 98304);
    if (l < 2) {
        const float* win = F_WIN(F) + (size_t)l * DMODEL * DIN + 4608;
        for (int idx = F.tid; idx < 8192; idx += NWAVES * 64) { const int k = idx >> 3, f = idx & 7; wf[f * 1024 + k] = win[(size_t)k * DIN + f]; }
        __syncthreads();
    }
    f32x4 gpre[4], gpost[4];
#pragma unroll
    for (int j = 0; j < 4; ++j) { gpre[j] = (f32x4){0.f, 0.f, 0.f, 0.f}; gpost[j] = gpre[j]; }
    if (l < 2) { const GAS f32x4* gp = (const GAS f32x4*)(F_PRE(F) + l * DMODEL) + lane;
#pragma unroll
        for (int j = 0; j < 4; ++j) gpre[j] = gp[64 * j]; }
    if (l > 0) { const GAS f32x4* gp = (const GAS f32x4*)(F_POST(F) + (l - 1) * DMODEL) + lane;
#pragma unroll
        for (int j = 0; j < 4; ++j) gpost[j] = gp[64 * j]; }
    const float* og = (const float*)(F_WS(F) + WS_OG);
    for (int m = gw; m < MROWS; m += NGW) {
        const GAS f32x4* xr = (const GAS f32x4*)(F_X(F) + (size_t)m * DMODEL) + lane; f32x4 v[4];
#pragma unroll
        for (int j = 0; j < 4; ++j) v[j] = xr[64 * j];
        unsigned char* slot = (unsigned char*)F_OUT(F) + (size_t)m * 4096;
        if (l > 0) {
            const GAS f32x4* orow = (const GAS f32x4*)(og + (size_t)m * DMODEL) + lane; f32x4 o[4]; float so = 0.f;
#pragma unroll
            for (int j = 0; j < 4; ++j) { o[j] = orow[64 * j]; so += (o[j].x * o[j].x + o[j].y * o[j].y) + (o[j].z * o[j].z + o[j].w * o[j].w); }
            const float ro = 1.0f / sqrtf(wave_sum(so) * (1.f / DMODEL) + EPS);
            if (l == 1) {
                GAS unsigned long long* n8 = (GAS unsigned long long*)slot + lane;
#pragma unroll
                for (int j = 0; j < 4; ++j) { const f32x4 n = o[j] * ro * gpost[j]; const unsigned lo = pk2(n.x, n.y), hi = pk2(n.z, n.w);
                    n8[64 * j] = (unsigned long long)lo | ((unsigned long long)hi << 32);
                    v[j].x += __uint_as_float(lo << 16); v[j].y += __uint_as_float(lo & 0xffff0000u); v[j].z += __uint_as_float(hi << 16); v[j].w += __uint_as_float(hi & 0xffff0000u); }
            } else {
                const GAS unsigned long long* n8 = (const GAS unsigned long long*)slot + lane; unsigned long long nn[4];
#pragma unroll
                for (int j = 0; j < 4; ++j) nn[j] = n8[64 * j];
                asm volatile("s_waitcnt vmcnt(0)" ::: "memory");
                GAS f32x4* outr = (GAS f32x4*)slot + lane;
#pragma unroll
                for (int j = 0; j < 4; ++j) { const unsigned lo = (unsigned)nn[j], hi = (unsigned)(nn[j] >> 32);
                    f32x4 r = v[j] + o[j] * ro * gpost[j];
                    r.x += __uint_as_float(lo << 16); r.y += __uint_as_float(lo & 0xffff0000u); r.z += __uint_as_float(hi << 16); r.w += __uint_as_float(hi & 0xffff0000u);
                    outr[64 * j] = r; }
                continue;
            }
        }
        float s2 = 0.f;
#pragma unroll
        for (int j = 0; j < 4; ++j) s2 += (v[j].x * v[j].x + v[j].y * v[j].y) + (v[j].z * v[j].z + v[j].w * v[j].w);
        const float r = 1.0f / sqrtf(wave_sum(s2) * (1.f / DMODEL) + EPS);
        GAS unsigned long long* h8 = (GAS unsigned long long*)(slot + 2048) + lane;
        float fl[8];
#pragma unroll
        for (int f = 0; f < 8; ++f) fl[f] = 0.f;
#pragma unroll
        for (int j = 0; j < 4; ++j) { const f32x4 h = v[j] * r * gpre[j]; h8[64 * j] = (unsigned long long)pk2(h.x, h.y) | ((unsigned long long)pk2(h.z, h.w) << 32);
#pragma unroll
            for (int f = 0; f < 8; ++f) { const f32x4 w = *(const LAS f32x4*)(wf + f * 1024 + 256 * j + 4 * lane); fl[f] += (h.x * w.x + h.y * w.y) + (h.z * w.z + h.w * w.w); } }
        float t4[4], t2[2];
        { const bool up = (lane & 32) != 0;
#pragma unroll
          for (int i = 0; i < 4; ++i) { const float send = up ? fl[i] : fl[4 + i], keep = up ? fl[4 + i] : fl[i]; t4[i] = keep + __shfl_xor(send, 32); } }
        { const bool up = (lane & 16) != 0;
#pragma unroll
          for (int i = 0; i < 2; ++i) { const float send = up ? t4[i] : t4[2 + i], keep = up ? t4[2 + i] : t4[i]; t2[i] = keep + __shfl_xor(send, 16); } }
        float fv; { const bool up = (lane & 8) != 0; const float send = up ? t2[0] : t2[1], keep = up ? t2[1] : t2[0]; fv = keep + __shfl_xor(send, 8); }
        fv += __shfl_xor(fv, 4); fv += __shfl_xor(fv, 2); fv += __shfl_xor(fv, 1);
        if ((lane & 7) == 0) { const int f = ((lane >> 5) & 1) * 4 + ((lane >> 4) & 1) * 2 + ((lane >> 3) & 1); const int b = m / SEQ, s = m % SEQ;
            ((float*)(F_WS(F) + WS_LOGF))[((size_t)b * NHF + f) * SEQ + s] = log_sigmoid_f(fv + F_BFORGET(F)[l * NHF + f]); }
    }
}
__device__ __forceinline__ void cumsum_logf(Frame& F0) {
    Frame F = F0; asm volatile("" : "+v"(F.lane), "+v"(F.tid));
    const int bh = blockIdx.x;
    if (bh >= BATCH * NHF || F.wave != 0) return;
    const float* src = (const float*)(F_WS(F) + WS_LOGF) + (size_t)bh * SEQ + 32 * F.lane; float* dst = (float*)(F_WS(F) + WS_C2) + (size_t)bh * SEQ + 32 * F.lane;
    float v[32];
#pragma unroll
    for (int i = 0; i < 8; ++i) { const f32x4 t = *(const GAS f32x4*)(src + 4 * i); v[4 * i] = t.x; v[4 * i + 1] = t.y; v[4 * i + 2] = t.z; v[4 * i + 3] = t.w; }
#pragma unroll
    for (int i = 1; i < 32; ++i) v[i] += v[i - 1];
    float tot = v[31], inc = tot;
#pragma unroll
    for (int o = 1; o < 64; o <<= 1) { const float t = __shfl_up(inc, o); if (F.lane >= o) inc += t; }
    const float off = inc - tot;
#pragma unroll
    for (int i = 0; i < 8; ++i) { f32x4 t; t.x = (v[4 * i] + off) * LOG2E; t.y = (v[4 * i + 1] + off) * LOG2E; t.z = (v[4 * i + 2] + off) * LOG2E; t.w = (v[4 * i + 3] + off) * LOG2E; *(GAS f32x4*)(dst + 4 * i) = t; }
}

struct NArgs { const unsigned char* ws; unsigned char* wsw; const float* diff_lambda; const float* diff_head_norm; const float* rel_bias; int layer; int pad; };
__device__ __forceinline__ void ld_row64(const bf16* p, float* q) {
#pragma unroll
    for (int i = 0; i < 8; ++i) { const uint4 u = *(const uint4*)(p + 8 * i);
        q[8 * i] = __uint_as_float(u.x << 16); q[8 * i + 1] = __uint_as_float(u.x & 0xffff0000u); q[8 * i + 2] = __uint_as_float(u.y << 16); q[8 * i + 3] = __uint_as_float(u.y & 0xffff0000u);
        q[8 * i + 4] = __uint_as_float(u.z << 16); q[8 * i + 5] = __uint_as_float(u.z & 0xffff0000u); q[8 * i + 6] = __uint_as_float(u.w << 16); q[8 * i + 7] = __uint_as_float(u.w & 0xffff0000u); }
}
__device__ __forceinline__ float dot64(const bf16* p, const float* q) {
    float s = 0.f;
#pragma unroll
    for (int i = 0; i < 8; ++i) { const uint4 u = *(const uint4*)(p + 8 * i);
        s += q[8 * i] * __uint_as_float(u.x << 16) + q[8 * i + 1] * __uint_as_float(u.x & 0xffff0000u) + q[8 * i + 2] * __uint_as_float(u.y << 16) + q[8 * i + 3] * __uint_as_float(u.y & 0xffff0000u)
           + q[8 * i + 4] * __uint_as_float(u.z << 16) + q[8 * i + 5] * __uint_as_float(u.z & 0xffff0000u) + q[8 * i + 6] * __uint_as_float(u.w << 16) + q[8 * i + 7] * __uint_as_float(u.w & 0xffff0000u); }
    return s;
}
__device__ __forceinline__ void axpy64(const bf16* p, float a, float* acc) {
#pragma unroll
    for (int i = 0; i < 8; ++i) { const uint4 u = *(const uint4*)(p + 8 * i);
        acc[8 * i] += a * __uint_as_float(u.x << 16); acc[8 * i + 1] += a * __uint_as_float(u.x & 0xffff0000u); acc[8 * i + 2] += a * __uint_as_float(u.y << 16); acc[8 * i + 3] += a * __uint_as_float(u.y & 0xffff0000u);
        acc[8 * i + 4] += a * __uint_as_float(u.z << 16); acc[8 * i + 5] += a * __uint_as_float(u.z & 0xffff0000u); acc[8 * i + 6] += a * __uint_as_float(u.w << 16); acc[8 * i + 7] += a * __uint_as_float(u.w & 0xffff0000u); }
}
__device__ __forceinline__ void store_y64(bf16* yrow, const float* o) {
#pragma unroll
    for (int i = 0; i < 8; ++i) { uint4 u = *(const uint4*)(yrow + 8 * i);
        u.x = pk2(o[8 * i] * __uint_as_float(u.x << 16), o[8 * i + 1] * __uint_as_float(u.x & 0xffff0000u)); u.y = pk2(o[8 * i + 2] * __uint_as_float(u.y << 16), o[8 * i + 3] * __uint_as_float(u.y & 0xffff0000u));
        u.z = pk2(o[8 * i + 4] * __uint_as_float(u.z << 16), o[8 * i + 5] * __uint_as_float(u.z & 0xffff0000u)); u.w = pk2(o[8 * i + 6] * __uint_as_float(u.w << 16), o[8 * i + 7] * __uint_as_float(u.w & 0xffff0000u));
        *(uint4*)(yrow + 8 * i) = u; }
}
__device__ __forceinline__ int t5_bucket(int n) {
    if (n < 16) return n;
    int large = 16 + (int)(logf((float)n / 16.0f) / logf(8.0f) * 16.0f);
    return large < 31 ? large : 31;
}
__device__ __forceinline__ float diff_lam(const float* dl, int l, float& lam_init) {
    float s1 = 0.f, s2 = 0.f;
    for (int i = 0; i < 64; ++i) { s1 += dl[l * 256 + i] * dl[l * 256 + 64 + i]; s2 += dl[l * 256 + 128 + i] * dl[l * 256 + 192 + i]; }
    lam_init = 0.8f - 0.6f * expf(-0.3f * (float)l);
    return expf(s1) - expf(s2) + lam_init;
}
__global__ void __launch_bounds__(256) naive_sb(NArgs a) {
    const int qb = blockIdx.x & 7, h = (blockIdx.x >> 3) & 7, b = blockIdx.x >> 6; const int t = qb * 256 + threadIdx.x; const size_t row = (size_t)b * SEQ + t;
    const bf16* Q = (const bf16*)(a.ws + WS_PROJ + 3 * SEG_BYTES); const bf16* K = (const bf16*)(a.ws + WS_PROJ + 4 * SEG_BYTES); const bf16* V = (const bf16*)(a.ws + WS_PROJ + 5 * SEG_BYTES);
    float q[64], acc[64]; ld_row64(Q + row * 512 + h * 64, q);
#pragma unroll
    for (int d = 0; d < 64; ++d) acc[d] = 0.f;
    float tail = 0.f;
    for (int s = qb * 256 + 254; s >= 0; --s) {
        if (s < t) { const size_t kr = ((size_t)b * SEQ + s) * 512 + h * 64; const float z = dot64(K + kr, q); const float e = exp2f(z), L = log2f(1.0f + e);
            const float w = exp2f(z - L + tail); tail -= L; axpy64(V + kr, w, acc); }
    }
    store_y64((bf16*)(a.wsw + WS_Y) + row * 2048 + 512 + h * 64, acc);
}
__global__ void __launch_bounds__(256) naive_fox(NArgs a) {
    const int qb = blockIdx.x & 7, h = (blockIdx.x >> 3) & 7, b = blockIdx.x >> 6; const int t = qb * 256 + threadIdx.x; const size_t row = (size_t)b * SEQ + t;
    const bf16* Q = (const bf16*)(a.ws + WS_PROJ + 6 * SEG_BYTES); const bf16* K = (const bf16*)(a.ws + WS_PROJ + 7 * SEG_BYTES); const bf16* V = (const bf16*)(a.ws + WS_PROJ + 8 * SEG_BYTES);
    const float* c2 = (const float*)(a.ws + WS_C2) + ((size_t)b * NHF + h) * SEQ;
    float q[64], acc[64]; ld_row64(Q + row * 512 + h * 64, q);
#pragma unroll
    for (int d = 0; d < 64; ++d) acc[d] = 0.f;
    float m = -1e30f, lsum = 0.f; const float ct = c2[t];
    for (int s = 0; s <= qb * 256 + 255; ++s) {
        if (s <= t) { const size_t kr = ((size_t)b * SEQ + s) * 512 + h * 64; const float xx = dot64(K + kr, q) + (ct - c2[s]); const float mn = fmaxf(m, xx), al = exp2f(m - mn), p = exp2f(xx - mn);
            lsum = lsum * al + p; m = mn;
#pragma unroll
            for (int d = 0; d < 64; ++d) acc[d] *= al;
            axpy64(V + kr, p, acc); }
    }
    const float il = 1.0f / lsum;
#pragma unroll
    for (int d = 0; d < 64; ++d) acc[d] *= il;
    store_y64((bf16*)(a.wsw + WS_Y) + row * 2048 + 1024 + h * 64, acc);
}
__global__ void __launch_bounds__(256) naive_mem(NArgs a) {
    const int qb = blockIdx.x & 7, h = (blockIdx.x >> 3) & 3, b = blockIdx.x >> 5; const int t = qb * 256 + threadIdx.x; const size_t row = (size_t)b * SEQ + t;
    const bf16* Q = (const bf16*)(a.ws + WS_PROJ + 9 * SEG_BYTES); const bf16* KV = (const bf16*)(a.ws + WS_MKV);
    float q[128]; ld_row64(Q + row * 512 + h * 128, q); ld_row64(Q + row * 512 + h * 128 + 64, q + 64);
#pragma unroll
    for (int dh = 0; dh < 2; ++dh) {
        float acc[64];
#pragma unroll
        for (int d = 0; d < 64; ++d) acc[d] = 0.f;
        float m = -1e30f, lsum = 0.f;
        for (int s = 0; s < MEM_LEN; ++s) { const size_t kr = ((size_t)b * MEM_LEN + s) * 1024 + h * 128; const float xx = dot64(KV + kr, q) + dot64(KV + kr + 64, q + 64);
            const float mn = fmaxf(m, xx), al = exp2f(m - mn), p = exp2f(xx - mn); lsum = lsum * al + p; m = mn;
#pragma unroll
            for (int d = 0; d < 64; ++d) acc[d] *= al;
            axpy64(KV + kr + 512 + dh * 64, p, acc); }
        const float il = 1.0f / lsum;
#pragma unroll
        for (int d = 0; d < 64; ++d) acc[d] *= il;
        store_y64((bf16*)(a.wsw + WS_Y) + row * 2048 + 1536 + h * 128 + dh * 64, acc);
    }
}
template <int C> __device__ __forceinline__ void naive_diff_pass(const bf16* Q, const bf16* K, const bf16* V, const float* rel_bias, int b, int h, int t, int tmax, int dh, float* res, float coef) {
    const size_t row = (size_t)b * SEQ + t; float q[64], acc[64]; ld_row64(Q + row * 512 + h * 128 + C * 64, q);
#pragma unroll
    for (int d = 0; d < 64; ++d) acc[d] = 0.f;
    float m = -1e30f, lsum = 0.f;
    for (int s = 0; s <= tmax; ++s) {
        if (s <= t) { const size_t kr = ((size_t)b * SEQ + s) * 512 + h * 128; const float xx = dot64(K + kr + C * 64, q) + rel_bias[t5_bucket(t - s) * 4 + h] * LOG2E;
            const float mn = fmaxf(m, xx), al = exp2f(m - mn), p = exp2f(xx - mn); lsum = lsum * al + p; m = mn;
#pragma unroll
            for (int d = 0; d < 64; ++d) acc[d] *= al;
            axpy64(V + kr + dh * 64, p, acc); }
    }
    const float il = coef / lsum;
#pragma unroll
    for (int d = 0; d < 64; ++d) res[d] += acc[d] * il;
}
__global__ void __launch_bounds__(256) naive_diff(NArgs a) {
    const int qb = blockIdx.x & 7, h = (blockIdx.x >> 3) & 3, b = blockIdx.x >> 5; const int t = qb * 256 + threadIdx.x; const size_t row = (size_t)b * SEQ + t;
    const bf16* Q = (const bf16*)(a.ws + WS_PROJ); const bf16* K = (const bf16*)(a.ws + WS_PROJ + 1 * SEG_BYTES); const bf16* V = (const bf16*)(a.ws + WS_PROJ + 2 * SEG_BYTES);
    float lam_init; const float lam = diff_lam(a.diff_lambda, a.layer, lam_init);
    float o0[64], o1[64];
#pragma unroll
    for (int d = 0; d < 64; ++d) { o0[d] = 0.f; o1[d] = 0.f; }
    const int tmax = qb * 256 + 255;
    naive_diff_pass<0>(Q, K, V, a.rel_bias, b, h, t, tmax, 0, o0, 1.0f); naive_diff_pass<1>(Q, K, V, a.rel_bias, b, h, t, tmax, 0, o0, -lam);
    naive_diff_pass<0>(Q, K, V, a.rel_bias, b, h, t, tmax, 1, o1, 1.0f); naive_diff_pass<1>(Q, K, V, a.rel_bias, b, h, t, tmax, 1, o1, -lam);
    float ss = 0.f;
#pragma unroll
    for (int d = 0; d < 64; ++d) ss += o0[d] * o0[d] + o1[d] * o1[d];
    const float r = (1.0f / sqrtf(ss * (1.0f / 128.0f) + EPS)) * (1.0f - lam_init); const float* g = a.diff_head_norm + a.layer * 128;
#pragma unroll
    for (int d = 0; d < 64; ++d) { o0[d] *= r * g[d]; o1[d] *= r * g[64 + d]; }
    bf16* yrow = (bf16*)(a.wsw + WS_Y) + row * 2048 + h * 128; store_y64(yrow, o0); store_y64(yrow + 64, o1);
}

constexpr int N_PHASES = 9;
#ifndef MK_ONE_LAUNCH
#define MK_ONE_LAUNCH 0
#endif
#ifndef MK_NAIVE_ATTN
#define MK_NAIVE_ATTN 1
#endif
__global__ void __launch_bounds__(NWAVES * 64, 2) mega_fwd(Args args) {
    extern __shared__ __attribute__((aligned(16))) unsigned char lds[];
    Frame F;
    F.lds = (LAS unsigned char*)lds;
    F.MISC = (volatile LAS unsigned*)(F.lds + MISC_OFF);
    F.tid = threadIdx.x; F.lane = F.tid & 63; F.wave = __builtin_amdgcn_readfirstlane(F.tid >> 6);
    F.G = gridDim.x; { const int bx = blockIdx.x; F.vcu = (F.G % 8 == 0) ? (bx % 8) * (F.G / 8) + bx / 8 : bx; }
    F.a = &args; F.ctl = (gu32*)(args.ws + WS_CTL);
    for (int u = F.tid; u < (LDS_BYTES - LDSCTL_OFF) / 4; u += NWAVES * 64) ((LAS unsigned*)(F.lds + LDSCTL_OFF))[u] = 0u;
    __syncthreads();
    XcdBarrier bar; bar.bar = (unsigned*)(F.ctl + CW_BAR); bar.x = 0; bar.st = nullptr;
    if (MK_ONE_LAUNCH) bar = xcd_barrier_post((unsigned*)(F.ctl + CW_BAR), F.MISC + 8);
    const int lo = args.ph_lo, hi = args.ph_hi;
#define IN(k) (lo <= (k) && (k) < hi)
#define SEAM(k) do { if (IN(k) && IN((k) + 1)) xcd_barrier(bar); } while (0)
    for (int l = 0; l < 2; ++l) {
        if (IN(4 * l + 0)) { p0_weights(F, l); p0_mem_rows(F, l); p0_rows(F, l); }
        SEAM(4 * l + 0);
        if (IN(4 * l + 1)) {
            cumsum_logf(F);
            { pg8::Gemm g{(const bf16*)F_OUT(F) + 1024, (const bf16*)(F_WS(F) + WS_WIN), MROWS, NPROJ, DMODEL, 2048}; pg8::StaticOrder S; S.init(MROWS, NPROJ, F.G, (int)blockIdx.x);
              pg8::EpiProj E{(bf16*)(F_WS(F) + WS_PROJ), (bf16*)(F_WS(F) + WS_Y), SEG_BYTES / 2};
              pg8::gemm_phase<pg8::EpiProj, pg8::StaticOrder, true, true>(F.lds, g, S, E); }
            { pg8::Gemm g{(const bf16*)(F_WS(F) + WS_HM), (const bf16*)(F_WS(F) + WS_WMKV), MMEM, 1024, DMODEL, DMODEL}; pg8::StaticOrder S; S.init(MMEM, 1024, F.G, (int)blockIdx.x);
              pg8::EpiBf16 E{(bf16*)(F_WS(F) + WS_MKV), 1024};
              pg8::gemm_phase<pg8::EpiBf16, pg8::StaticOrder, true, true>(F.lds, g, S, E); }
        }
        SEAM(4 * l + 1);
        if (IN(4 * l + 2)) {   }
        SEAM(4 * l + 2);
        if (IN(4 * l + 3)) {
            pg8::Gemm g{(const bf16*)(F_WS(F) + WS_Y), (const bf16*)(F_WS(F) + WS_WOUT), MROWS, DMODEL, DMIX, DMIX}; pg8::StaticOrder S; S.init(MROWS, DMODEL, F.G, (int)blockIdx.x);
            pg8::EpiF32 E{(float*)(F_WS(F) + WS_OG), DMODEL};
            pg8::gemm_phase<pg8::EpiF32, pg8::StaticOrder, true, true>(F.lds, g, S, E);
        }
        SEAM(4 * l + 3);
    }
    if (IN(8)) p0_rows(F, 2);
#undef IN
#undef SEAM
}

extern "C" void kernel_launch(void* const* d_in, const int* in_sizes, int n_in, void* d_out, int out_size, void* d_ws, size_t ws_size, hipStream_t stream) {
    static int grid = 0;
    if (grid == 0) {
        if (n_in != 12 || out_size != MROWS * DMODEL || ws_size < WS_END) { fprintf(stderr, "kernel_launch: unexpected shapes (n_in %d out %d ws %zu)\n", n_in, out_size, ws_size); grid = -1; return; }
        int dev = 0, cus = 0, per_cu = 0;
        if (hipGetDevice(&dev) != hipSuccess || hipDeviceGetAttribute(&cus, hipDeviceAttributeMultiprocessorCount, dev) != hipSuccess) { grid = -1; return; }
        if (hipFuncSetAttribute((const void*)mega_fwd, hipFuncAttributeMaxDynamicSharedMemorySize, LDS_BYTES) != hipSuccess) { fprintf(stderr, "kernel_launch: hipFuncSetAttribute failed\n"); grid = -1; return; }
        if (hipOccupancyMaxActiveBlocksPerMultiprocessor(&per_cu, (const void*)mega_fwd, NWAVES * 64, LDS_BYTES) != hipSuccess || per_cu < 1) fprintf(stderr, "kernel_launch: occupancy query says %d\n", per_cu);
        (void)hipGetLastError();
        grid = cus;
    }
    if (grid < 0) return;
    (void)hipMemsetAsync((char*)d_ws + WS_CTL, 0, CTL_ZERO_BYTES, stream);
    Args a{};
    for (int i = 0; i < 12; ++i) a.in[i] = (const float*)d_in[i];
    a.out = (float*)d_out; a.ws = (unsigned char*)d_ws;
#if MK_ONE_LAUNCH
    a.ph_lo = 0; a.ph_hi = N_PHASES;
    hipLaunchKernelGGL(mega_fwd, dim3(grid), dim3(NWAVES * 64), LDS_BYTES, stream, a);
#else
    for (int p = 0; p < N_PHASES; ++p) {
        if (MK_NAIVE_ATTN && (p == 2 || p == 6)) {
            NArgs na{}; na.ws = (const unsigned char*)d_ws; na.wsw = (unsigned char*)d_ws; na.diff_lambda = (const float*)d_in[9]; na.diff_head_norm = (const float*)d_in[10]; na.rel_bias = (const float*)d_in[11]; na.layer = p / 4;
            hipLaunchKernelGGL(naive_diff, dim3(BATCH * 4 * 8), dim3(256), 0, stream, na);
            hipLaunchKernelGGL(naive_sb, dim3(BATCH * 8 * 8), dim3(256), 0, stream, na);
            hipLaunchKernelGGL(naive_fox, dim3(BATCH * 8 * 8), dim3(256), 0, stream, na);
            hipLaunchKernelGGL(naive_mem, dim3(BATCH * 4 * 8), dim3(256), 0, stream, na);
            continue;
        }
        a.ph_lo = p; a.ph_hi = p + 1;
        hipLaunchKernelGGL(mega_fwd, dim3(grid), dim3(NWAVES * 64), LDS_BYTES, stream, a);
    }
#endif
}
```

```cpp
#include <hip/hip_runtime.h>
#include <cstdio>
#include <cstdint>
namespace pg8 {
#define PG8_LAS __attribute__((address_space(3)))
typedef unsigned short bf16_t;
typedef short bf16x8 __attribute__((ext_vector_type(8)));
typedef float f32x4 __attribute__((ext_vector_type(4)));
typedef unsigned u32x4 __attribute__((ext_vector_type(4)));
constexpr int BM = 256, BK = 64, HALF = 128, HTB = HALF * BK * 2  , STAGE_BYTES = 8 * HTB, NXCD = 8, WGM = 8;

__host__ __device__ __forceinline__ int lds_byte(int r, int c) { const int st = (r >> 4) * 2 + (c >> 5), rr = r & 15, cc = c & 31, ob = rr * 64 + cc * 2; return st * 1024 + (ob ^ (((ob >> 9) & 1) << 5)); }
__host__ __device__ __forceinline__ void stage_rc(int b, int& R, int& C) { const int st = b / 1024, sb = b % 1024, swz = sb ^ (((sb >> 9) & 1) << 5); R = (st >> 1) * 16 + swz / 64; C = (st & 1) * 32 + (swz % 64) / 2; }
__host__ __device__ __forceinline__ int perm32(int rho) { const int n = rho >> 4, i = rho & 15; return 8 * (i >> 2) + 4 * n + (i & 3); }

struct Unit { int pm, pn; };
struct Gemm { const bf16_t* A; const bf16_t* Bt; int M, N, K, lda; };

struct StaticOrder {
    int nM, nN, nwg, G, c;
    __host__ __device__ void init(int M, int N, int G_, int c_) { nM = M / BM; nN = N / BM; nwg = nM * nN; G = G_; c = c_; }
    __host__ __device__ bool next(int i, Unit& u) const {
        const long L = (long)i * G + c; if (L >= nwg) return false;
        int wgid = (int)L; { const int q = nwg / NXCD, r = nwg % NXCD, xcd = wgid % NXCD, off = wgid / NXCD; wgid = (xcd < r ? xcd * (q + 1) : r * (q + 1) + (xcd - r) * q) + off; }
        const int nig = WGM * nN, gid = wgid / nig, fm = gid * WGM, gsz = (nM - fm) < WGM ? (nM - fm) : WGM;
        u.pm = fm + ((wgid % nig) % gsz); u.pn = (wgid % nig) / gsz; return true;
    }
    __device__ __forceinline__ void a_ready(const Unit&) const {}
    __device__ __forceinline__ void done(const Unit&) const {}
};

__device__ __forceinline__ unsigned cvt_pk_bf16(float lo, float hi) { unsigned r; asm volatile("v_cvt_pk_bf16_f32 %0, %1, %2" : "=v"(r) : "v"(lo), "v"(hi)); return r; }

struct EpiBf16 {
    static constexpr bool PERM = true, AFTER_DRAIN = false;
    bf16_t* O; int ldc;
    __device__ __forceinline__ void operator()(const f32x4 (&acc)[2][2][4][2], const Unit& u, int wr, int wc, int fr, int fq) const {
        const int row0 = u.pm * BM + wr * 64 + fr; const int col0 = u.pn * BM + wc * 32 + 8 * fq;
#pragma unroll
        for (int ai = 0; ai < 2; ++ai)
#pragma unroll
            for (int m = 0; m < 4; ++m) { bf16_t* rowp = O + (size_t)(row0 + ai * HALF + m * 16) * ldc + col0;
#pragma unroll
                for (int bj = 0; bj < 2; ++bj) { const f32x4 v0 = acc[ai][bj][m][0], v1 = acc[ai][bj][m][1];
                    u32x4 w; w.x = cvt_pk_bf16(v0[0], v0[1]); w.y = cvt_pk_bf16(v0[2], v0[3]); w.z = cvt_pk_bf16(v1[0], v1[1]); w.w = cvt_pk_bf16(v1[2], v1[3]);
                    *(u32x4*)(rowp + bj * HALF) = w; } }
    }
};
__device__ __forceinline__ float silu_f(float v) { return v * __builtin_amdgcn_rcpf(1.0f + __builtin_amdgcn_exp2f(-1.4426950408889634f * v)); }
struct EpiProj {
    static constexpr bool PERM = true, AFTER_DRAIN = false;
    bf16_t* proj; bf16_t* y; size_t seg_stride;
    __device__ __forceinline__ void operator()(const f32x4 (&acc)[2][2][4][2], const Unit& u, int wr, int wc, int fr, int fq) const {
        const int row0 = u.pm * BM + wr * 64 + fr; const int colt = u.pn * BM; const bool gate = colt >= 5120;
        bf16_t* base; int ldc, col0;
        if (gate) { base = y; ldc = 2048; col0 = colt - 5120 + wc * 32 + 8 * fq; }
        else { base = proj + (size_t)(colt >> 9) * seg_stride; ldc = 512; col0 = (colt & 511) + wc * 32 + 8 * fq; }
#pragma unroll
        for (int ai = 0; ai < 2; ++ai)
#pragma unroll
            for (int m = 0; m < 4; ++m) { bf16_t* rowp = base + (size_t)(row0 + ai * HALF + m * 16) * ldc + col0;
#pragma unroll
                for (int bj = 0; bj < 2; ++bj) { f32x4 v0 = acc[ai][bj][m][0], v1 = acc[ai][bj][m][1];
                    if (gate) {
#pragma unroll
                        for (int e = 0; e < 4; ++e) { v0[e] = silu_f(v0[e]); v1[e] = silu_f(v1[e]); } }
                    u32x4 w; w.x = cvt_pk_bf16(v0[0], v0[1]); w.y = cvt_pk_bf16(v0[2], v0[3]); w.z = cvt_pk_bf16(v1[0], v1[1]); w.w = cvt_pk_bf16(v1[2], v1[3]);
                    *(u32x4*)(rowp + bj * HALF) = w; } }
    }
};
struct EpiF32 {
    static constexpr bool PERM = false, AFTER_DRAIN = false;
    float* O; int ldc;
    __device__ __forceinline__ void operator()(const f32x4 (&acc)[2][2][4][2], const Unit& u, int wr, int wc, int fr, int fq) const {
        const int col0 = u.pn * BM + wc * 32 + 4 * fq;
#pragma unroll
        for (int ai = 0; ai < 2; ++ai)
#pragma unroll
            for (int m = 0; m < 4; ++m) { float* rowp = O + (size_t)(u.pm * BM + ai * HALF + wr * 64 + m * 16 + fr) * ldc + col0;
#pragma unroll
                for (int bj = 0; bj < 2; ++bj)
#pragma unroll
                    for (int n = 0; n < 2; ++n) *(f32x4*)(rowp + bj * HALF + n * 16) = acc[ai][bj][m][n]; }
    }
};

template <class Epi, class Sched, bool ALIGN_EPI = false, bool SP2 = false>
__device__ __forceinline__ void gemm_phase(PG8_LAS unsigned char* lds, const Gemm g, const Sched& S, const Epi& E) {
    int tid_ = threadIdx.x; asm volatile("" : "+v"(tid_));
    const int tid = tid_, wid = __builtin_amdgcn_readfirstlane(tid >> 6), lane = tid & 63, wr = wid >> 2, wc = wid & 3, fr = lane & 15, fq = lane >> 4;
    const int K = g.K, nt = K / BK;
    unsigned voffA[2], voffB[2];
#pragma unroll
    for (int i = 0; i < 2; ++i) { int R, C; stage_rc(tid * 16 + i * 8192, R, C); const int Rb = Epi::PERM ? ((R & ~31) + perm32(R & 31)) : R;
        voffA[i] = (unsigned)(R * g.lda + C) * 2u; voffB[i] = (unsigned)(Rb * K + C) * 2u; }
    const size_t kstep = (size_t)(BK * 2);
    const size_t hstepA = (size_t)HALF * g.lda * 2, hstepB = (size_t)HALF * K * 2;
    const size_t tstepA = 2 * hstepA, tstepB = 2 * hstepB;
    const unsigned ldsw = (unsigned)wid * 1024u;
    const int aoff = lds_byte(wr * 64 + fr, fq * 8), boff = lds_byte(wc * 32 + fr, fq * 8);
#define PG8_SA(b, h) (((b) * 2 + (h)) * HTB)
#define PG8_SB(b, h) ((4 + (b) * 2 + (h)) * HTB)
#define PG8_STAGE(bufoff, gbase, voff) do { _Pragma("unroll") for (int _i = 0; _i < 2; ++_i) \
        __builtin_amdgcn_global_load_lds((const unsigned*)((const char*)(gbase) + (voff)[_i]), (PG8_LAS unsigned*)(lds + (bufoff) + ldsw + _i * 8192), 16, 0, 0); } while (0)
#define PG8_LDA(dst, b, h) do { _Pragma("unroll") for (int m = 0; m < 4; ++m) _Pragma("unroll") for (int k = 0; k < 2; ++k) dst[m][k] = *(const PG8_LAS bf16x8*)(lds + PG8_SA(b, h) + aoff + m * 2048 + k * 1024); } while (0)
#define PG8_LDB(dst, b, h) do { _Pragma("unroll") for (int n = 0; n < 2; ++n) _Pragma("unroll") for (int k = 0; k < 2; ++k) dst[n][k] = *(const PG8_LAS bf16x8*)(lds + PG8_SB(b, h) + boff + n * 2048 + k * 1024); } while (0)
#define PG8_MMA(ai, bj, At, Bt) do { __builtin_amdgcn_s_setprio(1); _Pragma("unroll") for (int m = 0; m < 4; ++m) _Pragma("unroll") for (int n = 0; n < 2; ++n) _Pragma("unroll") for (int k = 0; k < 2; ++k) \
        acc[ai][bj][m][n] = __builtin_amdgcn_mfma_f32_16x16x32_bf16(Bt[n][k], At[m][k], acc[ai][bj][m][n], 0, 0, 0); __builtin_amdgcn_s_setprio(0); } while (0)
#define PG8_WAIT_V(n) asm volatile("s_waitcnt vmcnt(" #n ")" ::: "memory")
#define PG8_WAIT_L(n) asm volatile("s_waitcnt lgkmcnt(" #n ")" ::: "memory")
#define PG8_BAR __builtin_amdgcn_s_barrier()
#define PG8_SCHED __builtin_amdgcn_sched_barrier(0)
    Unit cur, nxt; int ui = 0;
    if (!S.next(0, cur)) return;
    f32x4 acc[2][2][4][2];
#pragma unroll
    for (int a = 0; a < 2; ++a)
#pragma unroll
        for (int b = 0; b < 2; ++b)
#pragma unroll
            for (int m = 0; m < 4; ++m)
#pragma unroll
                for (int n = 0; n < 2; ++n) acc[a][b][m][n] = (f32x4){0.f, 0.f, 0.f, 0.f};
    bf16x8 At[4][2], B0[2][2], B1[2][2];
    const char* cA = (const char*)g.A + (size_t)cur.pm * tstepA; const char* cB = (const char*)g.Bt + (size_t)cur.pn * tstepB;
    S.a_ready(cur);
    if constexpr (SP2) {
        PG8_STAGE(PG8_SB(0, 0), cB, voffB); PG8_STAGE(PG8_SB(0, 1), cB + hstepB, voffB); PG8_STAGE(PG8_SA(0, 0), cA, voffA); PG8_STAGE(PG8_SA(0, 1), cA + hstepA, voffA);
        if (wr == 1) PG8_BAR;
        PG8_WAIT_V(2); PG8_BAR;
        PG8_STAGE(PG8_SB(1, 0), cB + kstep, voffB); PG8_STAGE(PG8_SA(1, 0), cA + kstep, voffA); PG8_STAGE(PG8_SB(1, 1), cB + hstepB + kstep, voffB);
        PG8_WAIT_V(6); PG8_BAR;
    } else {
        PG8_STAGE(PG8_SB(0, 0), cB, voffB); PG8_STAGE(PG8_SA(0, 0), cA, voffA); PG8_STAGE(PG8_SB(0, 1), cB + hstepB, voffB); PG8_STAGE(PG8_SA(0, 1), cA + hstepA, voffA);
        if (wr == 1) PG8_BAR;
        PG8_WAIT_V(4); PG8_BAR;
        PG8_STAGE(PG8_SB(1, 0), cB + kstep, voffB); PG8_STAGE(PG8_SA(1, 0), cA + kstep, voffA); PG8_STAGE(PG8_SB(1, 1), cB + hstepB + kstep, voffB);
        PG8_WAIT_V(6); PG8_BAR;
    }
    for (;;) {
        const bool has_next = S.next(ui + 1, nxt);
        const char* nA = has_next ? (const char*)g.A + (size_t)nxt.pm * tstepA : cA; const char* nB = has_next ? (const char*)g.Bt + (size_t)nxt.pn * tstepB : cB;
        for (int t = 0; t < nt; t += 2) {
            const bool last = (t == nt - 2);
            const char* a1 = cA + (size_t)(t + 1) * kstep;
            const char* a2 = last ? nA : cA + (size_t)(t + 2) * kstep; const char* b2 = last ? nB : cB + (size_t)(t + 2) * kstep;
            const char* a3 = a2 + kstep; const char* b3 = b2 + kstep;
            if (last && has_next) S.a_ready(nxt);
            if constexpr (SP2) {
            PG8_LDB(B0, 0, 0); PG8_LDB(B1, 0, 1); PG8_SCHED; PG8_LDA(At, 0, 0); PG8_STAGE(PG8_SA(1, 1), a1 + hstepA, voffA);
            PG8_WAIT_V(8); PG8_WAIT_L(0); PG8_BAR; PG8_MMA(0, 0, At, B0); PG8_MMA(0, 1, At, B1); PG8_BAR; PG8_SCHED;
            PG8_LDA(At, 0, 1); PG8_STAGE(PG8_SB(0, 0), b2, voffB); PG8_STAGE(PG8_SB(0, 1), b2 + hstepB, voffB); PG8_STAGE(PG8_SA(0, 0), a2, voffA);
            PG8_WAIT_V(8); PG8_WAIT_L(0); PG8_BAR; PG8_MMA(1, 0, At, B0); PG8_MMA(1, 1, At, B1); PG8_BAR; PG8_SCHED;
            PG8_LDB(B0, 1, 0); PG8_LDB(B1, 1, 1); PG8_SCHED; PG8_LDA(At, 1, 0); PG8_STAGE(PG8_SA(0, 1), a2 + hstepA, voffA);
            PG8_WAIT_V(8); PG8_WAIT_L(0); PG8_BAR; PG8_MMA(0, 0, At, B0); PG8_MMA(0, 1, At, B1); PG8_BAR; PG8_SCHED;
            PG8_LDA(At, 1, 1); PG8_STAGE(PG8_SB(1, 0), b3, voffB); PG8_STAGE(PG8_SB(1, 1), b3 + hstepB, voffB); PG8_STAGE(PG8_SA(1, 0), a3, voffA);
            PG8_WAIT_V(8); PG8_WAIT_L(0); PG8_BAR; PG8_MMA(1, 0, At, B0); PG8_MMA(1, 1, At, B1); PG8_BAR; PG8_SCHED;
            } else {
            PG8_LDB(B0, 0, 0); PG8_SCHED; PG8_LDA(At, 0, 0); PG8_STAGE(PG8_SA(1, 1), a1 + hstepA, voffA);
            PG8_WAIT_L(8); PG8_BAR; PG8_WAIT_L(0); PG8_MMA(0, 0, At, B0); PG8_BAR; PG8_SCHED;
            PG8_LDB(B1, 0, 1); PG8_STAGE(PG8_SB(0, 0), b2, voffB);
            PG8_BAR; PG8_WAIT_L(0); PG8_MMA(0, 1, At, B1); PG8_BAR;
            PG8_LDA(At, 0, 1); PG8_STAGE(PG8_SA(0, 0), a2, voffA);
            PG8_BAR; PG8_WAIT_L(0); PG8_MMA(1, 0, At, B0); PG8_BAR; PG8_SCHED;
            PG8_STAGE(PG8_SB(0, 1), b2 + hstepB, voffB);
            PG8_WAIT_V(6); PG8_BAR; PG8_MMA(1, 1, At, B1); PG8_BAR;
            PG8_LDB(B0, 1, 0); PG8_SCHED; PG8_LDA(At, 1, 0); PG8_STAGE(PG8_SA(0, 1), a2 + hstepA, voffA);
            PG8_WAIT_L(8); PG8_BAR; PG8_WAIT_L(0); PG8_MMA(0, 0, At, B0); PG8_BAR; PG8_SCHED;
            PG8_LDB(B1, 1, 1); PG8_STAGE(PG8_SB(1, 0), b3, voffB);
            PG8_BAR; PG8_WAIT_L(0); PG8_MMA(0, 1, At, B1); PG8_BAR;
            PG8_LDA(At, 1, 1); PG8_STAGE(PG8_SA(1, 0), a3, voffA);
            PG8_BAR; PG8_WAIT_L(0); PG8_MMA(1, 0, At, B0); PG8_BAR; PG8_SCHED;
            PG8_STAGE(PG8_SB(1, 1), b3 + hstepB, voffB);
            PG8_WAIT_V(6); PG8_BAR; PG8_MMA(1, 1, At, B1); PG8_BAR;
            }
        }
        if constexpr (ALIGN_EPI) { if (wr == 0) PG8_BAR; }
        if constexpr (!Epi::AFTER_DRAIN) { E(acc, cur, wr, wc, fr, fq); S.done(cur); }
        if (!has_next) break;
#pragma unroll
        for (int a = 0; a < 2; ++a)
#pragma unroll
            for (int b = 0; b < 2; ++b)
#pragma unroll
                for (int m = 0; m < 4; ++m)
#pragma unroll
                    for (int n = 0; n < 2; ++n) acc[a][b][m][n] = (f32x4){0.f, 0.f, 0.f, 0.f};
        cur = nxt; cA = nA; cB = nB; ++ui;
        if constexpr (ALIGN_EPI) { if (wr == 1) PG8_BAR; }
    }
    PG8_WAIT_V(0);
    if constexpr (!ALIGN_EPI) { if (wr == 0) PG8_BAR; }
    PG8_BAR;
    if constexpr (Epi::AFTER_DRAIN) { E.fused(acc, cur, wr, wc, fr, fq, lds, wid, lane); S.done(cur); }
#undef PG8_SA
#undef PG8_SB
#undef PG8_STAGE
#undef PG8_LDA
#undef PG8_LDB
#undef PG8_MMA
#undef PG8_WAIT_V
#undef PG8_WAIT_L
#undef PG8_BAR
#undef PG8_SCHED
}
}

constexpr int BATCH = 16, SEQ = 2048, DMODEL = 1024, MROWS = BATCH * SEQ;
constexpr int DMIX = 2048, NPROJ = 7168, DIN = 7176, NHF = 8;
constexpr int MEM_LEN = 256, MMEM = BATCH * MEM_LEN;
constexpr float EPS = 1e-6f, LOG2E = 1.4426950408889634f;
constexpr float QSCALE64 = 0.125f * LOG2E;
constexpr float QSCALE128 = 0.08838834764831845f * LOG2E;

constexpr size_t MiB = 1u << 20;
constexpr size_t WS_PROJ = 0;
constexpr size_t SEG_BYTES = 32 * MiB;
constexpr size_t WS_Y = 320 * MiB;
constexpr size_t WS_OG = 0;
constexpr size_t WS_WIN = 448 * MiB;
constexpr size_t WS_WOUT = 462 * MiB;
constexpr size_t WS_WMKV = 466 * MiB;
constexpr size_t WS_HM = 468 * MiB;
constexpr size_t WS_MKV = 476 * MiB;
constexpr size_t WS_LOGF = 484 * MiB;
constexpr size_t WS_C2 = 485 * MiB;
constexpr size_t WS_CTL = 486 * MiB, CTL_ZERO_BYTES = 1 * MiB;
constexpr size_t WS_END = 487 * MiB;
constexpr int CW_BAR = 4096;
constexpr int CW_QUEUE = 16384;

constexpr int RING_BYTES = 131072;
constexpr int LDSCTL_OFF = RING_BYTES, MISC_OFF = LDSCTL_OFF + 320;
constexpr int LDS_BYTES = 147456;
constexpr int NWAVES = 8;

#define GAS __attribute__((address_space(1)))
#define LAS __attribute__((address_space(3)))
typedef unsigned short bf16;
typedef unsigned v4u __attribute__((ext_vector_type(4)));
typedef float f32x4 __attribute__((ext_vector_type(4)));
typedef unsigned u32x4_t __attribute__((ext_vector_type(4)));
typedef short bf16x8 __attribute__((ext_vector_type(8)));
typedef GAS unsigned gu32;
typedef GAS unsigned long long gu64;
#define RLX_AGENT __ATOMIC_RELAXED, __HIP_MEMORY_SCOPE_AGENT
#define LDS_WAIT() asm volatile("s_waitcnt lgkmcnt(0)" ::: "memory")
#define VM_WAIT() asm volatile("s_waitcnt vmcnt(0)" ::: "memory")
__device__ __forceinline__ unsigned long long rt() { return __builtin_amdgcn_s_memrealtime(); }
__device__ __forceinline__ unsigned f2bf(float f) { unsigned u = __builtin_bit_cast(unsigned, f); return (u + 0x7fffu + ((u >> 16) & 1u)) >> 16; }
__device__ __forceinline__ unsigned pk2(float lo, float hi) { return f2bf(lo) | (f2bf(hi) << 16); }

#define XB_TMO      128
#define XB_XCNT(j)  (256  + 64 * (j))
#define XB_XSUB(j)  (1280 + 64 * (j))
#define XB_XGEN(j)  (2304 + 64 * (j))
#define XB_TOP      3328
#define XB_TOPGEN   3392
#define XCD_BAR_WORDS 3456
#define XB_SPIN_CAP (1u << 18)

__device__ __forceinline__ unsigned xb_ld(unsigned* p)              { return __hip_atomic_load(p, __ATOMIC_RELAXED, __HIP_MEMORY_SCOPE_AGENT); }
__device__ __forceinline__ unsigned xb_add(unsigned* p, unsigned v) { return __hip_atomic_fetch_add(p, v, __ATOMIC_RELAXED, __HIP_MEMORY_SCOPE_AGENT); }
__device__ __forceinline__ unsigned xb_xcc_id() { return (unsigned)__builtin_amdgcn_s_getreg((3 << 11) | 20) & 0xFu; }
#define XB_SPIN(cond, bar) do { unsigned _sp = 0; while (cond) { __builtin_amdgcn_s_sleep(1); \
    if ((++_sp & 255u) == 0u) { if (xb_ld(&(bar)[XB_TMO])) break; if (_sp > XB_SPIN_CAP) { atomicAdd(&(bar)[XB_TMO], 1u); break; } } } } while (0)

struct XcdBarrier {
    unsigned* bar; unsigned x;
    volatile LAS unsigned* st;
};

__device__ __forceinline__ XcdBarrier xcd_barrier_post(unsigned* bar, volatile LAS unsigned* st) {
    XcdBarrier b; b.bar = bar; b.x = xb_xcc_id(); b.st = st;
    if (threadIdx.x == 0) (void)xb_add(&bar[XB_XCNT(b.x)], 1u);
    return b;
}
__device__ __forceinline__ void xcd_barrier_complete(unsigned* bar, unsigned x, unsigned& nloc, unsigned& nx) {
    const unsigned G = gridDim.x * gridDim.y * gridDim.z;
    unsigned sum, cnt, mine, sp = 0u;
    for (;;) {
        sum = 0u; cnt = 0u; mine = 0u;
#pragma unroll
        for (unsigned j = 0; j < 16; ++j) { const unsigned c = xb_ld(&bar[XB_XCNT(j)]); sum += c; cnt += (c > 0u) ? 1u : 0u; mine = (j == x) ? c : mine; }
        if (sum == G) break;
        __builtin_amdgcn_s_sleep(1);
        if ((++sp & 255u) == 0u) { if (xb_ld(&bar[XB_TMO])) break; if (sp > XB_SPIN_CAP) { atomicAdd(&bar[XB_TMO], 1u); break; } }
    }
    nloc = mine > 0u ? mine : 1u; nx = cnt > 0u ? cnt : 1u;
}

__device__ __forceinline__ void xcd_barrier(const XcdBarrier& b) {
    asm volatile("s_waitcnt vmcnt(0)" ::: "memory");
    __syncthreads();
    if (threadIdx.x == 0) {
        unsigned* bar = b.bar;
        __builtin_amdgcn_s_waitcnt(0);
        unsigned nloc = b.st[0], nx = b.st[1];
        if (nloc == 0u) { xcd_barrier_complete(bar, b.x, nloc, nx); b.st[0] = nloc; b.st[1] = nx; }
        const unsigned old = xb_add(&bar[XB_XSUB(b.x)], 1u);
        const unsigned gen = old / nloc;
        if (old + 1u == (gen + 1u) * nloc) {
            __builtin_amdgcn_fence(__ATOMIC_RELEASE, "agent");
            asm volatile("s_waitcnt vmcnt(0)" ::: "memory");
            const unsigned og = xb_add(&bar[XB_TOP], 1u);
            const unsigned tg = og / nx;
            if (og + 1u == (tg + 1u) * nx) xb_add(&bar[XB_TOPGEN], 1u);
            else XB_SPIN(xb_ld(&bar[XB_TOPGEN]) == tg, bar);
            __builtin_amdgcn_fence(__ATOMIC_ACQUIRE, "agent");
            xb_add(&bar[XB_XGEN(b.x)], 1u);
            asm volatile("s_waitcnt vmcnt(0)" ::: "memory");
        } else {
            XB_SPIN(xb_ld(&bar[XB_XGEN(b.x)]) == gen, bar);
            __builtin_amdgcn_fence(__ATOMIC_ACQUIRE, "agent");
            asm volatile("s_waitcnt vmcnt(0)" ::: "memory");
        }
    }
    __syncthreads();
}

struct Args { const float* in[12]; float* out; unsigned char* ws; int ph_lo, ph_hi; };

struct Frame {
    LAS unsigned char* lds;
    volatile LAS unsigned* MISC;
    gu32* ctl;
    int tid, lane, wave;
    int vcu, G;
    const Args* a;
};
#define F_X(F) ((F).a->in[0])
#define F_MEM(F) ((F).a->in[1])
#define F_WIN(F) ((F).a->in[2])
#define F_BFORGET(F) ((F).a->in[3])
#define F_WMKV(F) ((F).a->in[4])
#define F_WOUT(F) ((F).a->in[5])
#define F_PRE(F) ((F).a->in[6])
#define F_POST(F) ((F).a->in[7])
#define F_MEMNORM(F) ((F).a->in[8])
#define F_DLAM(F) ((F).a->in[9])
#define F_DHN(F) ((F).a->in[10])
#define F_RELB(F) ((F).a->in[11])
#define F_OUT(F) ((F).a->out)
#define F_WS(F) ((F).a->ws)
__device__ __forceinline__ float bf2f(unsigned short u) { return __uint_as_float((unsigned)u << 16); }
__device__ __forceinline__ float wave_sum(float v) {
#pragma unroll
    for (int o = 1; o < 64; o <<= 1) v += __shfl_xor(v, o);
    return v;
}
__device__ __forceinline__ float log_sigmoid_f(float v) { return v >= 0.f ? -log1pf(expf(-v)) : v - log1pf(expf(v)); }

__device__ __forceinline__ void p0_transpose_item(const float* W, int ldw, int K, bf16* WT, int k0, int n0, int csrc0, float sc, LAS float* scr, int lane) {
#pragma unroll 8
    for (int i = 0; i < 32; ++i) { const int kk = 2 * i + (lane >> 5); scr[kk * 33 + (lane & 31)] = W[(size_t)(k0 + kk) * ldw + csrc0 + (lane & 31)]; }
    LDS_WAIT(); asm volatile("" ::: "memory");
    const int c = lane & 7;
#pragma unroll
    for (int j = 0; j < 4; ++j) { const int n = (lane >> 3) + 8 * j; const LAS float* s = scr + (8 * c) * 33 + n;
        v4u o; o.x = pk2(s[0 * 33] * sc, s[1 * 33] * sc); o.y = pk2(s[2 * 33] * sc, s[3 * 33] * sc); o.z = pk2(s[4 * 33] * sc, s[5 * 33] * sc); o.w = pk2(s[6 * 33] * sc, s[7 * 33] * sc);
        *(GAS v4u*)(WT + (size_t)(n0 + n) * K + k0 + 8 * c) = o; }
    LDS_WAIT(); asm volatile("" ::: "memory");
}
__device__ __forceinline__ void p0_weights(Frame& F0, int l) {
    Frame F = F0; asm volatile("" : "+v"(F.lane), "+v"(F.tid));
    LAS float* scr = (LAS float*)(F.lds + F.wave * 8448);
    const int gw = F.vcu * NWAVES + F.wave, NGW = F.G * NWAVES;
    constexpr int I_IN = 16 * 224, I_OUT = 32 * 32, I_MKV = 16 * 32;
    const float* win = F_WIN(F) + (size_t)l * DMODEL * DIN; const float* wout = F_WOUT(F) + (size_t)l * DMIX * DMODEL; const float* wmkv = F_WMKV(F) + (size_t)l * DMODEL * 1024;
    for (int it = gw; it < I_IN + I_OUT + I_MKV; it += NGW) {
        int r = it;
        if (r < I_IN) { const int kb = r / 224, nb = r % 224, n0 = 32 * nb; const int csrc0 = n0 + (n0 >= 4608 ? 8 : 0);
            float sc = 1.f; if (n0 < 512 || (n0 >= 1536 && n0 < 2048) || (n0 >= 3072 && n0 < 3584)) sc = QSCALE64; else if (n0 >= 4608 && n0 < 5120) sc = QSCALE128;
            p0_transpose_item(win, DIN, DMODEL, (bf16*)(F_WS(F) + WS_WIN), 64 * kb, n0, csrc0, sc, scr, F.lane); continue; }
        r -= I_IN;
        if (r < I_OUT) { const int kb = r / 32, nb = r % 32; p0_transpose_item(wout, DMODEL, DMIX, (bf16*)(F_WS(F) + WS_WOUT), 64 * kb, 32 * nb, 32 * nb, 1.f, scr, F.lane); continue; }
        r -= I_OUT;
        { const int kb = r / 32, nb = r % 32; p0_transpose_item(wmkv, 1024, DMODEL, (bf16*)(F_WS(F) + WS_WMKV), 64 * kb, 32 * nb, 32 * nb, 1.f, scr, F.lane); }
    }
}
__device__ __forceinline__ void p0_mem_rows(Frame& F0, int l) {
    Frame F = F0; asm volatile("" : "+v"(F.lane), "+v"(F.tid));
    const int gw = F.vcu * NWAVES + F.wave, NGW = F.G * NWAVES;
    const GAS f32x4* gp = (const GAS f32x4*)(F_MEMNORM(F) + l * DMODEL) + F.lane; f32x4 g[4];
#pragma unroll
    for (int j = 0; j < 4; ++j) g[j] = gp[64 * j];
    for (int m = gw; m < MMEM; m += NGW) {
        const GAS f32x4* xr = (const GAS f32x4*)(F_MEM(F) + (size_t)m * DMODEL) + F.lane; f32x4 v[4]; float s2 = 0.f;
#pragma unroll
        for (int j = 0; j < 4; ++j) { v[j] = xr[64 * j]; s2 += (v[j].x * v[j].x + v[j].y * v[j].y) + (v[j].z * v[j].z + v[j].w * v[j].w); }
        const float r = 1.0f / sqrtf(wave_sum(s2) * (1.f / DMODEL) + EPS);
        GAS unsigned long long* o8 = (GAS unsigned long long*)(F_WS(F) + WS_HM + (size_t)m * DMODEL * 2) + F.lane;
#pragma unroll
        for (int j = 0; j < 4; ++j) { const f32x4 h = v[j] * r * g[j]; o8[64 * j] = (unsigned long long)pk2(h.x, h.y) | ((unsigned long long)pk2(h.z, h.w) << 32); }
    }
}
struct RowIn { f32x4 v[4]; v4u og[2]; v4u n1[2]; };
__device__ __forceinline__ void bf8_to_f(const v4u u, f32x4& a, f32x4& b) {
    a.x = __uint_as_float(u.x << 16); a.y = __uint_as_float(u.x & 0xffff0000u); a.z = __uint_as_float(u.y << 16); a.w = __uint_as_float(u.y & 0xffff0000u);
    b.x = __uint_as_float(u.z << 16); b.y = __uint_as_float(u.z & 0xffff0000u); b.z = __uint_as_float(u.w << 16); b.w = __uint_as_float(u.w & 0xffff0000u); }
__device__ __forceinline__ v4u f_to_bf8(const f32x4 a, const f32x4 b) { v4u u; u.x = pk2(a.x, a.y); u.y = pk2(a.z, a.w); u.z = pk2(b.x, b.y); u.w = pk2(b.z, b.w); return u; }
__device__ __forceinline__ float sumsq4(const f32x4 (&v)[4]) { float s = 0.f;
#pragma unroll
    for (int j = 0; j < 4; ++j) s += (v[j].x * v[j].x + v[j].y * v[j].y) + (v[j].z * v[j].z + v[j].w * v[j].w);
    return s; }
__device__ __forceinline__ void row_load(Frame& F, int l, int m, int lane, RowIn& R) {
    const GAS f32x4* xr = (const GAS f32x4*)(F_X(F) + (size_t)m * DMODEL + 8 * lane);
    R.v[0] = xr[0]; R.v[1] = xr[1]; R.v[2] = xr[128]; R.v[3] = xr[129];
    if (l > 0) { const GAS v4u* orow = (const GAS v4u*)((const bf16*)(F_WS(F) + WS_OG) + (size_t)m * DMODEL + 8 * lane); R.og[0] = orow[0]; R.og[1] = orow[64]; }
    if (l == 2) { const GAS v4u* nr = (const GAS v4u*)((const bf16*)((unsigned char*)F_OUT(F) + (size_t)m * 4096) + 8 * lane); R.n1[0] = nr[0]; R.n1[1] = nr[64]; }
}
__device__ __forceinline__ void row_compute(Frame& F, int l, int m, int lane, RowIn& R, const f32x4 (&gpre)[4], const f32x4 (&gpost)[4], const LAS float* wf) {
    unsigned char* slot = (unsigned char*)F_OUT(F) + (size_t)m * 4096;
    f32x4 v[4];
#pragma unroll
    for (int j = 0; j < 4; ++j) v[j] = R.v[j];
    if (l > 0) {
        f32x4 o[4]; bf8_to_f(R.og[0], o[0], o[1]); bf8_to_f(R.og[1], o[2], o[3]);
        const float ro = 1.0f / sqrtf(wave_sum(sumsq4(o)) * (1.f / DMODEL) + EPS);
        if (l == 1) {
            f32x4 n[4];
#pragma unroll
            for (int j = 0; j < 4; ++j) n[j] = o[j] * ro * gpost[j];
            const v4u n0 = f_to_bf8(n[0], n[1]), n1 = f_to_bf8(n[2], n[3]);
            GAS v4u* nw = (GAS v4u*)((bf16*)slot + 8 * lane); nw[0] = n0; nw[64] = n1;
            f32x4 t[4]; bf8_to_f(n0, t[0], t[1]); bf8_to_f(n1, t[2], t[3]);
#pragma unroll
            for (int j = 0; j < 4; ++j) v[j] = v[j] + t[j];
        } else {
            f32x4 t[4]; bf8_to_f(R.n1[0], t[0], t[1]); bf8_to_f(R.n1[1], t[2], t[3]);
            GAS f32x4* outr = (GAS f32x4*)((float*)slot + 8 * lane);
            outr[0] = v[0] + t[0] + o[0] * ro * gpost[0]; outr[1] = v[1] + t[1] + o[1] * ro * gpost[1];
            outr[128] = v[2] + t[2] + o[2] * ro * gpost[2]; outr[129] = v[3] + t[3] + o[3] * ro * gpost[3];
            return;
        }
    }
    const float r = 1.0f / sqrtf(wave_sum(sumsq4(v)) * (1.f / DMODEL) + EPS);
    f32x4 h[4];
#pragma unroll
    for (int j = 0; j < 4; ++j) h[j] = v[j] * r * gpre[j];
    { GAS v4u* hw = (GAS v4u*)((bf16*)(slot + 2048) + 8 * lane); hw[0] = f_to_bf8(h[0], h[1]); hw[64] = f_to_bf8(h[2], h[3]); }
    float fl[8];
#pragma unroll
    for (int f = 0; f < 8; ++f) { const LAS f32x4* wp = (const LAS f32x4*)(wf + f * 1024 + 8 * lane); const f32x4 w0 = wp[0], w1 = wp[1], w2 = wp[128], w3 = wp[129];
        fl[f] = ((h[0].x * w0.x + h[0].y * w0.y) + (h[0].z * w0.z + h[0].w * w0.w)) + ((h[1].x * w1.x + h[1].y * w1.y) + (h[1].z * w1.z + h[1].w * w1.w))
              + ((h[2].x * w2.x + h[2].y * w2.y) + (h[2].z * w2.z + h[2].w * w2.w)) + ((h[3].x * w3.x + h[3].y * w3.y) + (h[3].z * w3.z + h[3].w * w3.w));
        if (f & 1) __builtin_amdgcn_sched_barrier(0); }
    float t4[4], t2[2];
    { const bool up = (lane & 32) != 0;
#pragma unroll
      for (int i = 0; i < 4; ++i) { const float send = up ? fl[i] : fl[4 + i], keep = up ? fl[4 + i] : fl[i]; t4[i] = keep + __shfl_xor(send, 32); } }
    { const bool up = (lane & 16) != 0;
#pragma unroll
      for (int i = 0; i < 2; ++i) { const float send = up ? t4[i] : t4[2 + i], keep = up ? t4[2 + i] : t4[i]; t2[i] = keep + __shfl_xor(send, 16); } }
    float fv; { const bool up = (lane & 8) != 0; const float send = up ? t2[0] : t2[1], keep = up ? t2[1] : t2[0]; fv = keep + __shfl_xor(send, 8); }
    fv += __shfl_xor(fv, 4); fv += __shfl_xor(fv, 2); fv += __shfl_xor(fv, 1);
    if ((lane & 7) == 0) { const int f = ((lane >> 5) & 1) * 4 + ((lane >> 4) & 1) * 2 + ((lane >> 3) & 1); const int b = m / SEQ, s = m % SEQ;
        ((float*)(F_WS(F) + WS_LOGF))[((size_t)b * NHF + f) * SEQ + s] = log_sigmoid_f(fv + F_BFORGET(F)[l * NHF + f]); }
}
__device__ __forceinline__ void p0_rows(Frame& F0, int l) {
    Frame F = F0; asm volatile("" : "+v"(F.lane), "+v"(F.tid));
    const int gw = F.vcu * NWAVES + F.wave, NGW = F.G * NWAVES, lane = F.lane;
    LAS float* wf = (LAS float*)(F.lds + 98304);
    if (l < 2) {
        const float* win = F_WIN(F) + (size_t)l * DMODEL * DIN + 4608;
        for (int idx = F.tid; idx < 8192; idx += NWAVES * 64) { const int k = idx >> 3, f = idx & 7; wf[f * 1024 + k] = win[(size_t)k * DIN + f]; }
        __syncthreads();
    }
    f32x4 gpre[4], gpost[4];
#pragma unroll
    for (int j = 0; j < 4; ++j) { gpre[j] = (f32x4){0.f, 0.f, 0.f, 0.f}; gpost[j] = gpre[j]; }
    if (l < 2) { const GAS f32x4* gp = (const GAS f32x4*)(F_PRE(F) + l * DMODEL + 8 * lane); gpre[0] = gp[0]; gpre[1] = gp[1]; gpre[2] = gp[128]; gpre[3] = gp[129]; }
    if (l > 0) { const GAS f32x4* gp = (const GAS f32x4*)(F_POST(F) + (l - 1) * DMODEL + 8 * lane); gpost[0] = gp[0]; gpost[1] = gp[1]; gpost[2] = gp[128]; gpost[3] = gp[129]; }
    for (int m = gw; m < MROWS; m += 2 * NGW) {
        const int m2 = m + NGW; const bool two = m2 < MROWS;
        RowIn A, B;
        row_load(F, l, m, lane, A);
        if (two) row_load(F, l, m2, lane, B);
        if (l == 2) asm volatile("s_waitcnt vmcnt(0)" ::: "memory");
        row_compute(F, l, m, lane, A, gpre, gpost, wf);
        if (two) row_compute(F, l, m2, lane, B, gpre, gpost, wf);
    }
}
__device__ __forceinline__ void cumsum_logf(Frame& F0) {
    Frame F = F0; asm volatile("" : "+v"(F.lane), "+v"(F.tid));
    const int bh = blockIdx.x;
    if (bh >= BATCH * NHF || F.wave != 0) return;
    const float* src = (const float*)(F_WS(F) + WS_LOGF) + (size_t)bh * SEQ + 32 * F.lane; float* dst = (float*)(F_WS(F) + WS_C2) + (size_t)bh * SEQ + 32 * F.lane;
    float v[32];
#pragma unroll
    for (int i = 0; i < 8; ++i) { const f32x4 t = *(const GAS f32x4*)(src + 4 * i); v[4 * i] = t.x; v[4 * i + 1] = t.y; v[4 * i + 2] = t.z; v[4 * i + 3] = t.w; }
#pragma unroll
    for (int i = 1; i < 32; ++i) v[i] += v[i - 1];
    float tot = v[31], inc = tot;
#pragma unroll
    for (int o = 1; o < 64; o <<= 1) { const float t = __shfl_up(inc, o); if (F.lane >= o) inc += t; }
    const float off = inc - tot;
#pragma unroll
    for (int i = 0; i < 8; ++i) { f32x4 t; t.x = (v[4 * i] + off) * -LOG2E; t.y = (v[4 * i + 1] + off) * -LOG2E; t.z = (v[4 * i + 2] + off) * -LOG2E; t.w = (v[4 * i + 3] + off) * -LOG2E; *(GAS f32x4*)(dst + 4 * i) = t; }
}

struct NArgs { const unsigned char* ws; unsigned char* wsw; const float* diff_lambda; const float* diff_head_norm; const float* rel_bias; int layer; int pad; };
__device__ __forceinline__ void ld_row64(const bf16* p, float* q) {
#pragma unroll
    for (int i = 0; i < 8; ++i) { const uint4 u = *(const uint4*)(p + 8 * i);
        q[8 * i] = __uint_as_float(u.x << 16); q[8 * i + 1] = __uint_as_float(u.x & 0xffff0000u); q[8 * i + 2] = __uint_as_float(u.y << 16); q[8 * i + 3] = __uint_as_float(u.y & 0xffff0000u);
        q[8 * i + 4] = __uint_as_float(u.z << 16); q[8 * i + 5] = __uint_as_float(u.z & 0xffff0000u); q[8 * i + 6] = __uint_as_float(u.w << 16); q[8 * i + 7] = __uint_as_float(u.w & 0xffff0000u); }
}
__device__ __forceinline__ float dot64(const bf16* p, const float* q) {
    float s = 0.f;
#pragma unroll
    for (int i = 0; i < 8; ++i) { const uint4 u = *(const uint4*)(p + 8 * i);
        s += q[8 * i] * __uint_as_float(u.x << 16) + q[8 * i + 1] * __uint_as_float(u.x & 0xffff0000u) + q[8 * i + 2] * __uint_as_float(u.y << 16) + q[8 * i + 3] * __uint_as_float(u.y & 0xffff0000u)
           + q[8 * i + 4] * __uint_as_float(u.z << 16) + q[8 * i + 5] * __uint_as_float(u.z & 0xffff0000u) + q[8 * i + 6] * __uint_as_float(u.w << 16) + q[8 * i + 7] * __uint_as_float(u.w & 0xffff0000u); }
    return s;
}
__device__ __forceinline__ void axpy64(const bf16* p, float a, float* acc) {
#pragma unroll
    for (int i = 0; i < 8; ++i) { const uint4 u = *(const uint4*)(p + 8 * i);
        acc[8 * i] += a * __uint_as_float(u.x << 16); acc[8 * i + 1] += a * __uint_as_float(u.x & 0xffff0000u); acc[8 * i + 2] += a * __uint_as_float(u.y << 16); acc[8 * i + 3] += a * __uint_as_float(u.y & 0xffff0000u);
        acc[8 * i + 4] += a * __uint_as_float(u.z << 16); acc[8 * i + 5] += a * __uint_as_float(u.z & 0xffff0000u); acc[8 * i + 6] += a * __uint_as_float(u.w << 16); acc[8 * i + 7] += a * __uint_as_float(u.w & 0xffff0000u); }
}
__device__ __forceinline__ void store_y64(bf16* yrow, const float* o) {
#pragma unroll
    for (int i = 0; i < 8; ++i) { uint4 u = *(const uint4*)(yrow + 8 * i);
        u.x = pk2(o[8 * i] * __uint_as_float(u.x << 16), o[8 * i + 1] * __uint_as_float(u.x & 0xffff0000u)); u.y = pk2(o[8 * i + 2] * __uint_as_float(u.y << 16), o[8 * i + 3] * __uint_as_float(u.y & 0xffff0000u));
        u.z = pk2(o[8 * i + 4] * __uint_as_float(u.z << 16), o[8 * i + 5] * __uint_as_float(u.z & 0xffff0000u)); u.w = pk2(o[8 * i + 6] * __uint_as_float(u.w << 16), o[8 * i + 7] * __uint_as_float(u.w & 0xffff0000u));
        *(uint4*)(yrow + 8 * i) = u; }
}
__device__ __forceinline__ int t5_bucket(int n) {
    if (n < 16) return n;
    int large = 16 + (int)(logf((float)n / 16.0f) / logf(8.0f) * 16.0f);
    return large < 31 ? large : 31;
}
__device__ __forceinline__ float diff_lam(const float* dl, int l, float& lam_init) {
    float s1 = 0.f, s2 = 0.f;
    for (int i = 0; i < 64; ++i) { s1 += dl[l * 256 + i] * dl[l * 256 + 64 + i]; s2 += dl[l * 256 + 128 + i] * dl[l * 256 + 192 + i]; }
    lam_init = 0.8f - 0.6f * expf(-0.3f * (float)l);
    return expf(s1) - expf(s2) + lam_init;
}
__global__ void __launch_bounds__(256) naive_sb(NArgs a) {
    const int qb = blockIdx.x & 7, h = (blockIdx.x >> 3) & 7, b = blockIdx.x >> 6; const int t = qb * 256 + threadIdx.x; const size_t row = (size_t)b * SEQ + t;
    const bf16* Q = (const bf16*)(a.ws + WS_PROJ + 3 * SEG_BYTES); const bf16* K = (const bf16*)(a.ws + WS_PROJ + 4 * SEG_BYTES); const bf16* V = (const bf16*)(a.ws + WS_PROJ + 5 * SEG_BYTES);
    float q[64], acc[64]; ld_row64(Q + row * 512 + h * 64, q);
#pragma unroll
    for (int d = 0; d < 64; ++d) acc[d] = 0.f;
    float tail = 0.f;
    for (int s = qb * 256 + 254; s >= 0; --s) {
        if (s < t) { const size_t kr = ((size_t)b * SEQ + s) * 512 + h * 64; const float z = dot64(K + kr, q); const float e = exp2f(z), L = log2f(1.0f + e);
            const float w = exp2f(z - L + tail); tail -= L; axpy64(V + kr, w, acc); }
    }
    store_y64((bf16*)(a.wsw + WS_Y) + row * 2048 + 512 + h * 64, acc);
}
__global__ void __launch_bounds__(256) naive_fox(NArgs a) {
    const int qb = blockIdx.x & 7, h = (blockIdx.x >> 3) & 7, b = blockIdx.x >> 6; const int t = qb * 256 + threadIdx.x; const size_t row = (size_t)b * SEQ + t;
    const bf16* Q = (const bf16*)(a.ws + WS_PROJ + 6 * SEG_BYTES); const bf16* K = (const bf16*)(a.ws + WS_PROJ + 7 * SEG_BYTES); const bf16* V = (const bf16*)(a.ws + WS_PROJ + 8 * SEG_BYTES);
    const float* c2 = (const float*)(a.ws + WS_C2) + ((size_t)b * NHF + h) * SEQ;
    float q[64], acc[64]; ld_row64(Q + row * 512 + h * 64, q);
#pragma unroll
    for (int d = 0; d < 64; ++d) acc[d] = 0.f;
    float m = -1e30f, lsum = 0.f; const float ct = c2[t];
    for (int s = 0; s <= qb * 256 + 255; ++s) {
        if (s <= t) { const size_t kr = ((size_t)b * SEQ + s) * 512 + h * 64; const float xx = dot64(K + kr, q) + (c2[s] - ct); const float mn = fmaxf(m, xx), al = exp2f(m - mn), p = exp2f(xx - mn);
            lsum = lsum * al + p; m = mn;
#pragma unroll
            for (int d = 0; d < 64; ++d) acc[d] *= al;
            axpy64(V + kr, p, acc); }
    }
    const float il = 1.0f / lsum;
#pragma unroll
    for (int d = 0; d < 64; ++d) acc[d] *= il;
    store_y64((bf16*)(a.wsw + WS_Y) + row * 2048 + 1024 + h * 64, acc);
}
__global__ void __launch_bounds__(256) naive_mem(NArgs a) {
    const int qb = blockIdx.x & 7, h = (blockIdx.x >> 3) & 3, b = blockIdx.x >> 5; const int t = qb * 256 + threadIdx.x; const size_t row = (size_t)b * SEQ + t;
    const bf16* Q = (const bf16*)(a.ws + WS_PROJ + 9 * SEG_BYTES); const bf16* KV = (const bf16*)(a.ws + WS_MKV);
    float q[128]; ld_row64(Q + row * 512 + h * 128, q); ld_row64(Q + row * 512 + h * 128 + 64, q + 64);
#pragma unroll
    for (int dh = 0; dh < 2; ++dh) {
        float acc[64];
#pragma unroll
        for (int d = 0; d < 64; ++d) acc[d] = 0.f;
        float m = -1e30f, lsum = 0.f;
        for (int s = 0; s < MEM_LEN; ++s) { const size_t kr = ((size_t)b * MEM_LEN + s) * 1024 + h * 128; const float xx = dot64(KV + kr, q) + dot64(KV + kr + 64, q + 64);
            const float mn = fmaxf(m, xx), al = exp2f(m - mn), p = exp2f(xx - mn); lsum = lsum * al + p; m = mn;
#pragma unroll
            for (int d = 0; d < 64; ++d) acc[d] *= al;
            axpy64(KV + kr + 512 + dh * 64, p, acc); }
        const float il = 1.0f / lsum;
#pragma unroll
        for (int d = 0; d < 64; ++d) acc[d] *= il;
        store_y64((bf16*)(a.wsw + WS_Y) + row * 2048 + 1536 + h * 128 + dh * 64, acc);
    }
}
template <int C> __device__ __forceinline__ void naive_diff_pass(const bf16* Q, const bf16* K, const bf16* V, const float* rel_bias, int b, int h, int t, int tmax, int dh, float* res, float coef) {
    const size_t row = (size_t)b * SEQ + t; float q[64], acc[64]; ld_row64(Q + row * 512 + h * 128 + C * 64, q);
#pragma unroll
    for (int d = 0; d < 64; ++d) acc[d] = 0.f;
    float m = -1e30f, lsum = 0.f;
    for (int s = 0; s <= tmax; ++s) {
        if (s <= t) { const size_t kr = ((size_t)b * SEQ + s) * 512 + h * 128; const float xx = dot64(K + kr + C * 64, q) + rel_bias[t5_bucket(t - s) * 4 + h] * LOG2E;
            const float mn = fmaxf(m, xx), al = exp2f(m - mn), p = exp2f(xx - mn); lsum = lsum * al + p; m = mn;
#pragma unroll
            for (int d = 0; d < 64; ++d) acc[d] *= al;
            axpy64(V + kr + dh * 64, p, acc); }
    }
    const float il = coef / lsum;
#pragma unroll
    for (int d = 0; d < 64; ++d) res[d] += acc[d] * il;
}
__global__ void __launch_bounds__(256) naive_diff(NArgs a) {
    const int qb = blockIdx.x & 7, h = (blockIdx.x >> 3) & 3, b = blockIdx.x >> 5; const int t = qb * 256 + threadIdx.x; const size_t row = (size_t)b * SEQ + t;
    const bf16* Q = (const bf16*)(a.ws + WS_PROJ); const bf16* K = (const bf16*)(a.ws + WS_PROJ + 1 * SEG_BYTES); const bf16* V = (const bf16*)(a.ws + WS_PROJ + 2 * SEG_BYTES);
    float lam_init; const float lam = diff_lam(a.diff_lambda, a.layer, lam_init);
    float o0[64], o1[64];
#pragma unroll
    for (int d = 0; d < 64; ++d) { o0[d] = 0.f; o1[d] = 0.f; }
    const int tmax = qb * 256 + 255;
    naive_diff_pass<0>(Q, K, V, a.rel_bias, b, h, t, tmax, 0, o0, 1.0f); naive_diff_pass<1>(Q, K, V, a.rel_bias, b, h, t, tmax, 0, o0, -lam);
    naive_diff_pass<0>(Q, K, V, a.rel_bias, b, h, t, tmax, 1, o1, 1.0f); naive_diff_pass<1>(Q, K, V, a.rel_bias, b, h, t, tmax, 1, o1, -lam);
    float ss = 0.f;
#pragma unroll
    for (int d = 0; d < 64; ++d) ss += o0[d] * o0[d] + o1[d] * o1[d];
    const float r = (1.0f / sqrtf(ss * (1.0f / 128.0f) + EPS)) * (1.0f - lam_init); const float* g = a.diff_head_norm + a.layer * 128;
#pragma unroll
    for (int d = 0; d < 64; ++d) { o0[d] *= r * g[d]; o1[d] *= r * g[64 + d]; }
    bf16* yrow = (bf16*)(a.wsw + WS_Y) + row * 2048 + h * 128; store_y64(yrow, o0); store_y64(yrow + 64, o1);
}

namespace att {
typedef float f32x16 __attribute__((ext_vector_type(16)));
typedef short s16x4 __attribute__((ext_vector_type(4)));
typedef short v4i16_t __attribute__((ext_vector_type(4)));
typedef LAS const char* lds_cptr;
typedef float f32x2_t __attribute__((ext_vector_type(2))); typedef __bf16 bf16x2_t __attribute__((ext_vector_type(2)));
constexpr int AK_OFF = 0, AV_OFF = 49152, SLOT = 16384, AC2_OFF = 98304, ATB_OFF = 106496, AQW_OFF = 111616, AFL_OFF = 111616 + 64, AX_OFF = 0;
constexpr int TBN = 320;
enum { M_SB = 0, M_FOX = 1, M_DIFF = 2, M_MEM = 3 };
constexpr float NEG = -1e30f;
#define SBAR() __builtin_amdgcn_sched_barrier(0)
__device__ __forceinline__ void glds16(const void* gsrc, unsigned lds_dst) { unsigned keep;
    asm volatile("s_mov_b32 %0, m0\n\ts_mov_b32 m0, %2\n\ts_nop 0\n\tglobal_load_lds_dwordx4 %1, off\n\ts_mov_b32 m0, %0" : "=&s"(keep) : "v"(gsrc), "s"(lds_dst) : "memory"); }
__device__ __forceinline__ s16x4 vtr(lds_cptr p) { return __builtin_bit_cast(s16x4, __builtin_amdgcn_ds_read_tr16_b64_v4i16((LAS v4i16_t*)p)); }
__device__ __forceinline__ unsigned cvtpk(float lo, float hi) { f32x2_t v = {lo, hi}; bf16x2_t b = __builtin_convertvector(v, bf16x2_t); return __builtin_bit_cast(unsigned, b); }
__device__ __forceinline__ float ex2(float v) { return __builtin_amdgcn_exp2f(v); }
__device__ __forceinline__ float lg2(float v) { return __builtin_amdgcn_logf(v); }
__device__ __forceinline__ float xsum(float v) { auto rr = __builtin_amdgcn_permlane32_swap(__float_as_uint(v), __float_as_uint(v), false, false); return __uint_as_float(rr[0]) + __uint_as_float(rr[1]); }
__device__ __forceinline__ float xmax(float v) { auto rr = __builtin_amdgcn_permlane32_swap(__float_as_uint(v), __float_as_uint(v), false, false); return fmaxf(__uint_as_float(rr[0]), __uint_as_float(rr[1])); }
__device__ __forceinline__ int kcol(int r) { return (r & 3) + 8 * (r >> 2); }

template <int MODE>
__device__ __forceinline__ void attn_unit(const Args* A, LAS unsigned char* L, int b, int h, int qb, int layer, float lam, float lam_init) {
    constexpr int DQK = (MODE == M_MEM) ? 128 : 64, DV = (MODE == M_SB || MODE == M_FOX) ? 64 : 128;
    constexpr int KCH = (MODE == M_SB || MODE == M_FOX) ? 8 : 16, VPC = DV / 8, ROWS = (MODE == M_DIFF) ? 128 : 256;
    constexpr int NQ = DQK / 16, NDB = DV / 32, NPT = KCH / 8 + VPC / 8;
    constexpr bool CAUSAL = MODE != M_MEM;
    int tid_ = threadIdx.x; asm volatile("" : "+v"(tid_));
    const int tid = tid_, lane = tid & 63, r32 = lane & 31, hi = lane >> 5, wid = __builtin_amdgcn_readfirstlane(tid >> 6);
    const int wrow = (MODE == M_DIFF) ? (wid & 3) : wid, comp = (MODE == M_DIFF) ? (wid >> 2) : 0;
    const int q0 = qb * ROWS, wq0 = q0 + wrow * 32;
    const unsigned char* ws = A->ws;
    const bf16 *Qg, *Kg, *Vg; int pitchK = 512, ycol;
    if (MODE == M_SB)   { Qg = (const bf16*)(ws + WS_PROJ + 3 * SEG_BYTES) + (size_t)b * SEQ * 512 + h * 64; Kg = (const bf16*)(ws + WS_PROJ + 4 * SEG_BYTES) + (size_t)b * SEQ * 512 + h * 64; Vg = (const bf16*)(ws + WS_PROJ + 5 * SEG_BYTES) + (size_t)b * SEQ * 512 + h * 64; ycol = 512 + h * 64; }
    if (MODE == M_FOX)  { Qg = (const bf16*)(ws + WS_PROJ + 6 * SEG_BYTES) + (size_t)b * SEQ * 512 + h * 64; Kg = (const bf16*)(ws + WS_PROJ + 7 * SEG_BYTES) + (size_t)b * SEQ * 512 + h * 64; Vg = (const bf16*)(ws + WS_PROJ + 8 * SEG_BYTES) + (size_t)b * SEQ * 512 + h * 64; ycol = 1024 + h * 64; }
    if (MODE == M_DIFF) { Qg = (const bf16*)(ws + WS_PROJ) + (size_t)b * SEQ * 512 + h * 128 + comp * 64; Kg = (const bf16*)(ws + WS_PROJ + 1 * SEG_BYTES) + (size_t)b * SEQ * 512 + h * 128; Vg = (const bf16*)(ws + WS_PROJ + 2 * SEG_BYTES) + (size_t)b * SEQ * 512 + h * 128; ycol = h * 128; }
    if (MODE == M_MEM)  { Qg = (const bf16*)(ws + WS_PROJ + 9 * SEG_BYTES) + (size_t)b * SEQ * 512 + h * 128; Kg = (const bf16*)(ws + WS_MKV) + (size_t)b * MEM_LEN * 1024 + h * 128; Vg = Kg + 512; pitchK = 1024; ycol = 1536 + h * 128; }
    const int NT = (MODE == M_MEM) ? 4 : (q0 + ROWS) / 64;
    const unsigned lds0 = (unsigned)(uintptr_t)L;
    const bf16* ksrc = Kg + (size_t)lane * pitchK + wid * 8;
    const bf16* vsrc = Vg + (size_t)(16 * (wid & 3) + (lane >> 2)) * pitchK + (wid >> 2) * 32 + (lane & 3) * 8;
#define ATT_ISSUE(kt, sl) do { const size_t toff_ = (size_t)(kt) * 64 * pitchK; \
        _Pragma("unroll") for (int i_ = 0; i_ < KCH / 8; ++i_) glds16(ksrc + toff_ + i_ * 64, (unsigned)__builtin_amdgcn_readfirstlane(lds0 + AK_OFF + (sl) * SLOT + (wid + 8 * i_) * 1024)); \
        _Pragma("unroll") for (int i_ = 0; i_ < VPC / 8; ++i_) glds16(vsrc + toff_ + i_ * 64, (unsigned)__builtin_amdgcn_readfirstlane(lds0 + AV_OFF + (sl) * SLOT + (wid + 8 * i_) * 1024)); } while (0)
#define ATT_KT(i) (CAUSAL ? (NT - 1 - (i)) : (i))
    if (MODE == M_FOX) { const float* c2 = (const float*)(ws + WS_C2) + ((size_t)b * NHF + h) * SEQ; glds16(c2 + wid * 256 + lane * 4, (unsigned)__builtin_amdgcn_readfirstlane(lds0 + AC2_OFF + wid * 1024)); }
    ATT_ISSUE(ATT_KT(0), 0);
    if (NT > 1) ATT_ISSUE(ATT_KT(1), 1);
    bf16x8 qr[NQ];
    { const bf16* qp = Qg + (size_t)(wq0 + r32) * 512 + hi * 8;
#pragma unroll
      for (int d0 = 0; d0 < NQ; ++d0) qr[d0] = *(const bf16x8*)(qp + d0 * 16);
#pragma unroll
      for (int d0 = 0; d0 < NQ; ++d0) asm volatile("" : "+v"(qr[d0])); }
    f32x16 o[NDB];
#pragma unroll
    for (int d = 0; d < NDB; ++d)
#pragma unroll
        for (int r = 0; r < 16; ++r) o[d][r] = 0.f;
    float m_run = NEG, l_run = 0.f, s_run = 1.0f;
    const int qabs = wq0 + r32;
    const lds_cptr L3 = (lds_cptr)L;
    const lds_cptr kp0 = L3 + AK_OFF + (comp * 8 + hi) * 1024 + r32 * 16;
    const lds_cptr vp0 = L3 + AV_OFF + ((lane >> 4) & 1) * 32 + (lane & 3) * 8 + (4 * hi + ((lane & 15) >> 2)) * 64;
    int sl = 0;
    for (int i = 0; i < NT; ++i) {
        if (i + 1 < NT) asm volatile("s_waitcnt vmcnt(%0) lgkmcnt(0)\n\ts_barrier" :: "n"(NPT) : "memory");
        else asm volatile("s_waitcnt vmcnt(0) lgkmcnt(0)\n\ts_barrier" ::: "memory");
        if (MODE == M_SB) { if (i > 0) {
            const LAS u32x4_t* fp = (const LAS u32x4_t*)(L + AFL_OFF + ((i - 1) & 1) * 32); const u32x4_t f0 = fp[0], f1 = fp[1];
            if (__builtin_amdgcn_readfirstlane((int)((f0.x | f0.y) | (f0.z | f0.w) | (f1.x | f1.y) | (f1.z | f1.w))) == 0) break; } }
        if (i + 2 < NT) { const int sl2 = (sl >= 1) ? sl - 1 : 2; ATT_ISSUE(ATT_KT(i + 2), sl2); }
        const int kt = ATT_KT(i);
        const bool active = !CAUSAL || (kt * 64 <= wq0 + 31);
        if (active) {
            f32x16 p0, p1;
            bf16x8 kf[8];
            const lds_cptr kp = kp0 + sl * SLOT;
#pragma unroll
            for (int d0 = 0; d0 < 4; ++d0) { kf[2 * d0] = *(const LAS bf16x8*)(kp + d0 * 2048); kf[2 * d0 + 1] = *(const LAS bf16x8*)(kp + d0 * 2048 + 512); }
            if (MODE == M_FOX) { const LAS float* cp = (const LAS float*)(L + AC2_OFF) + kt * 64 + 4 * hi;
#pragma unroll
                for (int g = 0; g < 4; ++g) { const f32x4 c0 = *(const LAS f32x4*)(cp + 8 * g), c1 = *(const LAS f32x4*)(cp + 32 + 8 * g);
#pragma unroll
                    for (int j = 0; j < 4; ++j) { p0[4 * g + j] = c0[j]; p1[4 * g + j] = c1[j]; } } }
            else {
#pragma unroll
                for (int r = 0; r < 16; ++r) { p0[r] = 0.f; p1[r] = 0.f; } }
            const bool near = (MODE == M_DIFF) && (kt * 64 > wq0 - 176);
            SBAR();
            __builtin_amdgcn_s_setprio(1);
#pragma unroll
            for (int d0 = 0; d0 < 4; ++d0) { p0 = __builtin_amdgcn_mfma_f32_32x32x16_bf16(kf[2 * d0], qr[d0], p0, 0, 0, 0); p1 = __builtin_amdgcn_mfma_f32_32x32x16_bf16(kf[2 * d0 + 1], qr[d0], p1, 0, 0, 0); }
            if (NQ > 4) { SBAR();
#pragma unroll
                for (int d0 = 0; d0 < 4; ++d0) { kf[2 * d0] = *(const LAS bf16x8*)(kp + (d0 + 4) * 2048); kf[2 * d0 + 1] = *(const LAS bf16x8*)(kp + (d0 + 4) * 2048 + 512); }
                SBAR();
#pragma unroll
                for (int d0 = 0; d0 < 4; ++d0) { p0 = __builtin_amdgcn_mfma_f32_32x32x16_bf16(kf[2 * d0], qr[NQ > 4 ? d0 + 4 : d0], p0, 0, 0, 0); p1 = __builtin_amdgcn_mfma_f32_32x32x16_bf16(kf[2 * d0 + 1], qr[NQ > 4 ? d0 + 4 : d0], p1, 0, 0, 0); } }
            __builtin_amdgcn_s_setprio(0);
            SBAR();
            s16x4 vlo[4 * NDB], vhi[4 * NDB];
            { const lds_cptr vp = vp0 + sl * SLOT;
#pragma unroll
              for (int d = 0; d < NDB; ++d)
#pragma unroll
                for (int ks = 0; ks < 4; ++ks) { vlo[4 * d + ks] = vtr(vp + d * 4096 + ks * 1024); vhi[4 * d + ks] = vtr(vp + d * 4096 + ks * 1024 + 512); } }
            SBAR();
            unsigned pw[16];
            if (MODE == M_SB) {
                if (kt * 64 + 63 >= wq0) { const int kb = kt * 64 + 4 * hi;
#pragma unroll
                    for (int r = 0; r < 16; ++r) { const int kv = kb + kcol(r); if (kv >= qabs) p0[r] = NEG; if (kv + 32 >= qabs) p1[r] = NEG; } }
                f32x16 l0, l1;
#pragma unroll
                for (int r = 0; r < 16; ++r) { l0[r] = __builtin_amdgcn_rcpf(1.0f + ex2(p0[r])); l1[r] = __builtin_amdgcn_rcpf(1.0f + ex2(p1[r])); }
#pragma unroll
                for (int hf = 1; hf >= 0; --hf)
#pragma unroll
                    for (int g = 3; g >= 0; --g) {
                        const float a0 = hf ? l1[4 * g] : l0[4 * g], a1 = hf ? l1[4 * g + 1] : l0[4 * g + 1], a2 = hf ? l1[4 * g + 2] : l0[4 * g + 2], a3 = hf ? l1[4 * g + 3] : l0[4 * g + 3];
                        const float town = (a0 * a1) * (a2 * a3);
                        const auto sw = __builtin_amdgcn_permlane32_swap(__float_as_uint(town), __float_as_uint(town), false, false);
                        const float v0 = __uint_as_float(sw[0]), v1 = __uint_as_float(sw[1]);
                        const float t3 = s_run * (hi ? 1.0f : v1), t2 = t3 * a3, t1 = t2 * a2, t0 = t1 * a1;
                        const float w0 = (1.0f - a0) * t0, w1 = (1.0f - a1) * t1, w2 = (1.0f - a2) * t2, w3 = (1.0f - a3) * t3;
                        pw[hf * 8 + g * 2] = cvtpk(w0, w1); pw[hf * 8 + g * 2 + 1] = cvtpk(w2, w3);
                        s_run *= v0 * v1;
                    }
            } else {
                if (MODE == M_DIFF) { if (near) { const LAS float* tp = (const LAS float*)(L + ATB_OFF) + h * TBN + (223 - (wq0 - kt * 64 + r32 - 4 * hi));
#pragma unroll
                    for (int r = 0; r < 16; ++r) { p0[r] += tp[kcol(r)]; p1[r] += tp[32 + kcol(r)]; } } }
                if (CAUSAL) { if (kt * 64 + 63 > wq0) { const int kb = kt * 64 + 4 * hi;
#pragma unroll
                    for (int r = 0; r < 16; ++r) { const int kv = kb + kcol(r); if (kv > qabs) p0[r] = NEG; if (kv + 32 > qabs) p1[r] = NEG; } } }
                float ra = fmaxf(fmaxf(p0[0], p0[1]), p1[0]), rb = fmaxf(fmaxf(p0[2], p0[3]), p1[1]); ra = fmaxf(fmaxf(ra, p1[2]), p1[3]);
#pragma unroll
                for (int r = 4; r < 16; r += 4) { ra = fmaxf(fmaxf(ra, p0[r]), p0[r + 1]); rb = fmaxf(fmaxf(rb, p0[r + 2]), p0[r + 3]); ra = fmaxf(fmaxf(ra, p1[r]), p1[r + 1]); rb = fmaxf(fmaxf(rb, p1[r + 2]), p1[r + 3]); }
                const float rm = xmax(fmaxf(ra, rb));
                const float mn = fmaxf(m_run, rm);
                if (__any(mn > m_run)) { const float al = ex2(m_run - mn); l_run *= al; m_run = mn;
#pragma unroll
                    for (int d = 0; d < NDB; ++d)
#pragma unroll
                        for (int r = 0; r < 16; ++r) o[d][r] *= al; }
                float sa = 0.f, sb = 0.f;
#pragma unroll
                for (int r = 0; r < 16; ++r) { p0[r] = ex2(p0[r] - m_run); p1[r] = ex2(p1[r] - m_run); sa += p0[r]; sb += p1[r]; }
                l_run += sa + sb;
#pragma unroll
                for (int w = 0; w < 8; ++w) { pw[w] = cvtpk(p0[2 * w], p0[2 * w + 1]); pw[8 + w] = cvtpk(p1[2 * w], p1[2 * w + 1]); }
            }
            SBAR();
            __builtin_amdgcn_s_setprio(1);
#pragma unroll
            for (int ks = 0; ks < 4; ++ks) { const u32x4_t pf = (u32x4_t){pw[4 * ks], pw[4 * ks + 1], pw[4 * ks + 2], pw[4 * ks + 3]};
#pragma unroll
                for (int d = 0; d < NDB; ++d) { const s16x4 lo = vlo[4 * d + ks], hh = vhi[4 * d + ks];
                    const bf16x8 vf = (bf16x8){lo[0], lo[1], lo[2], lo[3], hh[0], hh[1], hh[2], hh[3]};
                    o[d] = __builtin_amdgcn_mfma_f32_32x32x16_bf16(vf, __builtin_bit_cast(bf16x8, pf), o[d], 0, 0, 0); } }
            __builtin_amdgcn_s_setprio(0);
        }
        if (MODE == M_SB) { const bool alive = !active || __any(s_run != 0.0f);
            if (lane == 0) ((LAS unsigned*)(L + AFL_OFF + (i & 1) * 32))[wid] = alive ? 1u : 0u; }
        sl = (sl == 2) ? 0 : sl + 1;
    }
    if (MODE == M_SB) asm volatile("s_waitcnt vmcnt(0)" ::: "memory");
    if (MODE != M_SB) { const float il = 1.0f / xsum(l_run);
#pragma unroll
        for (int d = 0; d < NDB; ++d)
#pragma unroll
            for (int r = 0; r < 16; ++r) o[d][r] *= il; }
    if (MODE == M_DIFF) {
        asm volatile("s_waitcnt lgkmcnt(0)\n\ts_barrier" ::: "memory");
        LAS float* X = (LAS float*)(L + AX_OFF) + wrow * 4096 + lane;
        if (comp == 1) {
#pragma unroll
            for (int d = 0; d < NDB; ++d)
#pragma unroll
                for (int r = 0; r < 16; ++r) X[(d * 16 + r) * 64] = o[d][r] * lam; }
        asm volatile("s_waitcnt lgkmcnt(0)\n\ts_barrier" ::: "memory");
        if (comp == 0) { float ss = 0.f;
#pragma unroll
            for (int d = 0; d < NDB; ++d)
#pragma unroll
                for (int r = 0; r < 16; ++r) { o[d][r] -= X[(d * 16 + r) * 64]; ss += o[d][r] * o[d][r]; }
            ss = xsum(ss);
            const float rn = (1.0f / sqrtf(ss * (1.0f / 128.0f) + EPS)) * (1.0f - lam_init);
            const float* gn = A->in[10] + layer * 128 + 4 * hi;
#pragma unroll
            for (int d = 0; d < NDB; ++d)
#pragma unroll
                for (int g = 0; g < 4; ++g) { const f32x4 gv = *(const f32x4*)(gn + 32 * d + 8 * g);
#pragma unroll
                    for (int j = 0; j < 4; ++j) o[d][4 * g + j] *= rn * gv[j]; } }
    }
    if (MODE != M_DIFF || comp == 0) {
        bf16* yrow = (bf16*)(A->ws + WS_Y) + (size_t)((size_t)b * SEQ + wq0 + r32) * 2048 + ycol + 4 * hi;
#pragma unroll
        for (int d = 0; d < NDB; ++d)
#pragma unroll
            for (int g = 0; g < 4; ++g) { uint2 u = *(const uint2*)(yrow + 32 * d + 8 * g);
                u.x = pk2(o[d][4 * g] * __uint_as_float(u.x << 16), o[d][4 * g + 1] * __uint_as_float(u.x & 0xffff0000u));
                u.y = pk2(o[d][4 * g + 2] * __uint_as_float(u.y << 16), o[d][4 * g + 3] * __uint_as_float(u.y & 0xffff0000u));
                *(uint2*)(yrow + 32 * d + 8 * g) = u; }
    }
    if (MODE == M_DIFF) asm volatile("s_waitcnt lgkmcnt(0)\n\ts_barrier" ::: "memory");
#undef ATT_ISSUE
#undef ATT_KT
}

constexpr int NU_MAIN = 192, NU_Q = 448;
struct UnitD { int mode, b, h, qb; };
__device__ __forceinline__ UnitD decode_unit(int x, int k) {
    UnitD u;
    if (k < NU_MAIN) { const int jj = k / 24, r = k % 24;
        if (r < 12)      { u.mode = M_DIFF; const int bh = 8 * jj + x;          u.b = bh >> 2; u.h = bh & 3; u.qb = 15 - r; }
        else if (r < 18) { u.mode = M_FOX; const int bh = 8 * (2 * jj) + x;     u.b = bh >> 3; u.h = bh & 7; u.qb = 7 - (r - 12); }
        else             { u.mode = M_FOX; const int bh = 8 * (2 * jj + 1) + x; u.b = bh >> 3; u.h = bh & 7; u.qb = 7 - (r - 18); }
        return u; }
    int r = k - NU_MAIN;
    if (r < 128) { u.mode = M_SB; const int bh = 8 * (r >> 3) + x; u.b = bh >> 3; u.h = bh & 7; u.qb = 7 - (r & 7); return u; } r -= 128;
    if (r < 8)  { u.mode = M_DIFF; const int bh = 8 * r + x; u.b = bh >> 2; u.h = bh & 3; u.qb = 3; return u; } r -= 8;
    if (r < 16) { u.mode = M_FOX; const int bh = 8 * r + x; u.b = bh >> 3; u.h = bh & 7; u.qb = 1; return u; } r -= 16;
    if (r < 8)  { u.mode = M_DIFF; const int bh = 8 * r + x; u.b = bh >> 2; u.h = bh & 3; u.qb = 2; return u; } r -= 8;
    if (r < 8)  { u.mode = M_DIFF; const int bh = 8 * r + x; u.b = bh >> 2; u.h = bh & 3; u.qb = 1; return u; } r -= 8;
    if (r < 16) { u.mode = M_FOX; const int bh = 8 * r + x; u.b = bh >> 3; u.h = bh & 7; u.qb = 0; return u; } r -= 16;
    if (r < 64) { u.mode = M_MEM; const int bh = 8 * (r >> 3) + x; u.b = bh >> 2; u.h = bh & 3; u.qb = r & 7; return u; } r -= 64;
    { u.mode = M_DIFF; const int bh = 8 * r + x; u.b = bh >> 2; u.h = bh & 3; u.qb = 0; return u; }
}
__device__ __forceinline__ void attn_phase(Frame& F0, int layer) {
    Frame F = F0; asm volatile("" : "+v"(F.lane), "+v"(F.tid));
    LAS unsigned char* L = F.lds;
    { LAS float* tb = (LAS float*)(L + ATB_OFF); const float* relb = F.a->in[11];
      for (int i = F.tid; i < 4 * TBN; i += NWAVES * 64) { const int h = i / TBN, j = i % TBN, dist = 223 - j; float v = 0.f;
          if (dist >= 0 && dist < 113) v = (relb[t5_bucket(dist) * 4 + h] - relb[31 * 4 + h]) * LOG2E;
          tb[i] = v; } }
    float lam_init, lam;
    { const float* dl = F.a->in[9] + layer * 256; const float s1 = wave_sum(dl[F.lane] * dl[64 + F.lane]), s2 = wave_sum(dl[128 + F.lane] * dl[192 + F.lane]);
      lam_init = 0.8f - 0.6f * expf(-0.3f * (float)layer); lam = expf(s1) - expf(s2) + lam_init; }
    const int x0 = (int)(xb_xcc_id() & 7u);
    for (int xi = 0; xi < 8; ++xi) {
        const int x = (x0 + xi) & 7;
        gu32* qh = F.ctl + CW_QUEUE + 64 * (layer * 8 + x);
        for (;;) {
            if (F.tid == 0) *(volatile LAS unsigned*)(L + AQW_OFF) = __hip_atomic_fetch_add(qh, 1u, __ATOMIC_RELAXED, __HIP_MEMORY_SCOPE_AGENT);
            __syncthreads();
            const int k = __builtin_amdgcn_readfirstlane((int)*(volatile LAS unsigned*)(L + AQW_OFF));
            if (k >= NU_Q) break;
            const UnitD u = decode_unit(x, k);
            if (u.mode == M_SB) attn_unit<M_SB>(F.a, L, u.b, u.h, u.qb, layer, lam, lam_init);
            else if (u.mode == M_FOX) attn_unit<M_FOX>(F.a, L, u.b, u.h, u.qb, layer, lam, lam_init);
            else if (u.mode == M_DIFF) attn_unit<M_DIFF>(F.a, L, u.b, u.h, u.qb, layer, lam, lam_init);
            else attn_unit<M_MEM>(F.a, L, u.b, u.h, u.qb, layer, lam, lam_init);
        }
        __syncthreads();
    }
}
#undef SBAR
}


constexpr int N_PHASES = 9;
#ifndef MK_ONE_LAUNCH
#define MK_ONE_LAUNCH 1
#endif
#ifndef MK_NAIVE_ATTN
#define MK_NAIVE_ATTN 0
#endif
__global__ void __launch_bounds__(NWAVES * 64, 2) mega_fwd(Args args) {
    extern __shared__ __attribute__((aligned(16))) unsigned char lds[];
    Frame F;
    F.lds = (LAS unsigned char*)lds;
    F.MISC = (volatile LAS unsigned*)(F.lds + MISC_OFF);
    F.tid = threadIdx.x; F.lane = F.tid & 63; F.wave = __builtin_amdgcn_readfirstlane(F.tid >> 6);
    F.G = gridDim.x; { const int bx = blockIdx.x; F.vcu = (F.G % 8 == 0) ? (bx % 8) * (F.G / 8) + bx / 8 : bx; }
    F.a = &args; F.ctl = (gu32*)(args.ws + WS_CTL);
    for (int u = F.tid; u < (LDS_BYTES - LDSCTL_OFF) / 4; u += NWAVES * 64) ((LAS unsigned*)(F.lds + LDSCTL_OFF))[u] = 0u;
    __syncthreads();
    XcdBarrier bar; bar.bar = (unsigned*)(F.ctl + CW_BAR); bar.x = 0; bar.st = nullptr;
    if (MK_ONE_LAUNCH) bar = xcd_barrier_post((unsigned*)(F.ctl + CW_BAR), F.MISC + 8);
    const int lo = args.ph_lo, hi = args.ph_hi;
#define IN(k) (lo <= (k) && (k) < hi)
#define SEAM(k) do { if (IN(k) && IN((k) + 1)) xcd_barrier(bar); } while (0)
    for (int l = 0; l < 2; ++l) {
        if (IN(4 * l + 0)) { p0_weights(F, l); p0_mem_rows(F, l); p0_rows(F, l); }
        SEAM(4 * l + 0);
        if (IN(4 * l + 1)) {
            cumsum_logf(F);
            { pg8::Gemm g{(const bf16*)F_OUT(F) + 1024, (const bf16*)(F_WS(F) + WS_WIN), MROWS, NPROJ, DMODEL, 2048}; pg8::StaticOrder S; S.init(MROWS, NPROJ, F.G, (int)blockIdx.x);
              pg8::EpiProj E{(bf16*)(F_WS(F) + WS_PROJ), (bf16*)(F_WS(F) + WS_Y), SEG_BYTES / 2};
              pg8::gemm_phase<pg8::EpiProj, pg8::StaticOrder, true, true>(F.lds, g, S, E); }
            { pg8::Gemm g{(const bf16*)(F_WS(F) + WS_HM), (const bf16*)(F_WS(F) + WS_WMKV), MMEM, 1024, DMODEL, DMODEL}; pg8::StaticOrder S; S.init(MMEM, 1024, F.G, (int)blockIdx.x);
              pg8::EpiBf16 E{(bf16*)(F_WS(F) + WS_MKV), 1024};
              pg8::gemm_phase<pg8::EpiBf16, pg8::StaticOrder, true, true>(F.lds, g, S, E); }
        }
        SEAM(4 * l + 1);
        if (IN(4 * l + 2)) att::attn_phase(F, l);
        SEAM(4 * l + 2);
        if (IN(4 * l + 3)) {
            pg8::Gemm g{(const bf16*)(F_WS(F) + WS_Y), (const bf16*)(F_WS(F) + WS_WOUT), MROWS, DMODEL, DMIX, DMIX}; pg8::StaticOrder S; S.init(MROWS, DMODEL, F.G, (int)blockIdx.x);
            pg8::EpiBf16 E{(bf16*)(F_WS(F) + WS_OG), DMODEL};
            pg8::gemm_phase<pg8::EpiBf16, pg8::StaticOrder, true, true>(F.lds, g, S, E);
        }
        SEAM(4 * l + 3);
    }
    if (IN(8)) p0_rows(F, 2);
#undef IN
#undef SEAM
}

extern "C" void kernel_launch(void* const* d_in, const int* in_sizes, int n_in, void* d_out, int out_size, void* d_ws, size_t ws_size, hipStream_t stream) {
    static int grid = 0;
    if (grid == 0) {
        if (n_in != 12 || out_size != MROWS * DMODEL || ws_size < WS_END) { fprintf(stderr, "kernel_launch: unexpected shapes (n_in %d out %d ws %zu)\n", n_in, out_size, ws_size); grid = -1; return; }
        int dev = 0, cus = 0, per_cu = 0;
        if (hipGetDevice(&dev) != hipSuccess || hipDeviceGetAttribute(&cus, hipDeviceAttributeMultiprocessorCount, dev) != hipSuccess) { grid = -1; return; }
        if (hipFuncSetAttribute((const void*)mega_fwd, hipFuncAttributeMaxDynamicSharedMemorySize, LDS_BYTES) != hipSuccess) { fprintf(stderr, "kernel_launch: hipFuncSetAttribute failed\n"); grid = -1; return; }
        if (hipOccupancyMaxActiveBlocksPerMultiprocessor(&per_cu, (const void*)mega_fwd, NWAVES * 64, LDS_BYTES) != hipSuccess || per_cu < 1) fprintf(stderr, "kernel_launch: occupancy query says %d\n", per_cu);
        (void)hipGetLastError();
        grid = cus;
    }
    if (grid < 0) return;
    (void)hipMemsetAsync((char*)d_ws + WS_CTL, 0, CTL_ZERO_BYTES, stream);
    Args a{};
    for (int i = 0; i < 12; ++i) a.in[i] = (const float*)d_in[i];
    a.out = (float*)d_out; a.ws = (unsigned char*)d_ws;
#if MK_ONE_LAUNCH
    a.ph_lo = 0; a.ph_hi = N_PHASES;
    hipLaunchKernelGGL(mega_fwd, dim3(grid), dim3(NWAVES * 64), LDS_BYTES, stream, a);
#else
    for (int p = 0; p < N_PHASES; ++p) {
        if (MK_NAIVE_ATTN && (p == 2 || p == 6)) {
            NArgs na{}; na.ws = (const unsigned char*)d_ws; na.wsw = (unsigned char*)d_ws; na.diff_lambda = (const float*)d_in[9]; na.diff_head_norm = (const float*)d_in[10]; na.rel_bias = (const float*)d_in[11]; na.layer = p / 4;
            hipLaunchKernelGGL(naive_diff, dim3(BATCH * 4 * 8), dim3(256), 0, stream, na);
            hipLaunchKernelGGL(naive_sb, dim3(BATCH * 8 * 8), dim3(256), 0, stream, na);
            hipLaunchKernelGGL(naive_fox, dim3(BATCH * 8 * 8), dim3(256), 0, stream, na);
            hipLaunchKernelGGL(naive_mem, dim3(BATCH * 4 * 8), dim3(256), 0, stream, na);
            continue;
        }
        a.ph_lo = p; a.ph_hi = p + 1;
        hipLaunchKernelGGL(mega_fwd, dim3(grid), dim3(NWAVES * 64), LDS_BYTES, stream, a);
    }
#endif
}
```

```cpp
#include <hip/hip_runtime.h>
#include <cstdio>
#include <cstdint>
namespace pg8 {
#define PG8_LAS __attribute__((address_space(3)))
typedef unsigned short bf16_t;
typedef short bf16x8 __attribute__((ext_vector_type(8)));
typedef float f32x4 __attribute__((ext_vector_type(4)));
typedef unsigned u32x4 __attribute__((ext_vector_type(4)));
constexpr int BM = 256, BK = 64, HALF = 128, HTB = HALF * BK * 2  , STAGE_BYTES = 8 * HTB, NXCD = 8, WGM = 8;

__host__ __device__ __forceinline__ int lds_byte(int r, int c) { const int st = (r >> 4) * 2 + (c >> 5), rr = r & 15, cc = c & 31, ob = rr * 64 + cc * 2; return st * 1024 + (ob ^ (((ob >> 9) & 1) << 5)); }
__host__ __device__ __forceinline__ void stage_rc(int b, int& R, int& C) { const int st = b / 1024, sb = b % 1024, swz = sb ^ (((sb >> 9) & 1) << 5); R = (st >> 1) * 16 + swz / 64; C = (st & 1) * 32 + (swz % 64) / 2; }
__host__ __device__ __forceinline__ int perm32(int rho) { const int n = rho >> 4, i = rho & 15; return 8 * (i >> 2) + 4 * n + (i & 3); }

struct Unit { int pm, pn; };
struct Gemm { const bf16_t* A; const bf16_t* Bt; int M, N, K, lda; };

struct StaticOrder {
    int nM, nN, nwg, G, c;
    __host__ __device__ void init(int M, int N, int G_, int c_) { nM = M / BM; nN = N / BM; nwg = nM * nN; G = G_; c = c_; }
    __host__ __device__ bool next(int i, Unit& u) const {
        const long L = (long)i * G + c; if (L >= nwg) return false;
        int wgid = (int)L; { const int q = nwg / NXCD, r = nwg % NXCD, xcd = wgid % NXCD, off = wgid / NXCD; wgid = (xcd < r ? xcd * (q + 1) : r * (q + 1) + (xcd - r) * q) + off; }
        const int nig = WGM * nN, gid = wgid / nig, fm = gid * WGM, gsz = (nM - fm) < WGM ? (nM - fm) : WGM;
        u.pm = fm + ((wgid % nig) % gsz); u.pn = (wgid % nig) / gsz; return true;
    }
    __device__ __forceinline__ void a_ready(const Unit&) const {}
    __device__ __forceinline__ void done(const Unit&) const {}
};

__device__ __forceinline__ unsigned cvt_pk_bf16(float lo, float hi) { unsigned r; asm volatile("v_cvt_pk_bf16_f32 %0, %1, %2" : "=v"(r) : "v"(lo), "v"(hi)); return r; }

struct EpiBf16 {
    static constexpr bool PERM = true, AFTER_DRAIN = false;
    bf16_t* O; int ldc;
    __device__ __forceinline__ void operator()(const f32x4 (&acc)[2][2][4][2], const Unit& u, int wr, int wc, int fr, int fq) const {
        const int row0 = u.pm * BM + wr * 64 + fr; const int col0 = u.pn * BM + wc * 32 + 8 * fq;
#pragma unroll
        for (int ai = 0; ai < 2; ++ai)
#pragma unroll
            for (int m = 0; m < 4; ++m) { bf16_t* rowp = O + (size_t)(row0 + ai * HALF + m * 16) * ldc + col0;
#pragma unroll
                for (int bj = 0; bj < 2; ++bj) { const f32x4 v0 = acc[ai][bj][m][0], v1 = acc[ai][bj][m][1];
                    u32x4 w; w.x = cvt_pk_bf16(v0[0], v0[1]); w.y = cvt_pk_bf16(v0[2], v0[3]); w.z = cvt_pk_bf16(v1[0], v1[1]); w.w = cvt_pk_bf16(v1[2], v1[3]);
                    *(u32x4*)(rowp + bj * HALF) = w; } }
    }
};
__device__ __forceinline__ float silu_f(float v) { return v * __builtin_amdgcn_rcpf(1.0f + __builtin_amdgcn_exp2f(-1.4426950408889634f * v)); }
struct EpiProj {
    static constexpr bool PERM = true, AFTER_DRAIN = false;
    bf16_t* proj; bf16_t* y; size_t seg_stride;
    __device__ __forceinline__ void operator()(const f32x4 (&acc)[2][2][4][2], const Unit& u, int wr, int wc, int fr, int fq) const {
        const int row0 = u.pm * BM + wr * 64 + fr; const int colt = u.pn * BM; const bool gate = colt >= 5120;
        bf16_t* base; int ldc, col0;
        if (gate) { base = y; ldc = 2048; col0 = colt - 5120 + wc * 32 + 8 * fq; }
        else { base = proj + (size_t)(colt >> 9) * seg_stride; ldc = 512; col0 = (colt & 511) + wc * 32 + 8 * fq; }
#pragma unroll
        for (int ai = 0; ai < 2; ++ai)
#pragma unroll
            for (int m = 0; m < 4; ++m) { bf16_t* rowp = base + (size_t)(row0 + ai * HALF + m * 16) * ldc + col0;
#pragma unroll
                for (int bj = 0; bj < 2; ++bj) { f32x4 v0 = acc[ai][bj][m][0], v1 = acc[ai][bj][m][1];
                    if (gate) {
#pragma unroll
                        for (int e = 0; e < 4; ++e) { v0[e] = silu_f(v0[e]); v1[e] = silu_f(v1[e]); } }
                    u32x4 w; w.x = cvt_pk_bf16(v0[0], v0[1]); w.y = cvt_pk_bf16(v0[2], v0[3]); w.z = cvt_pk_bf16(v1[0], v1[1]); w.w = cvt_pk_bf16(v1[2], v1[3]);
                    *(u32x4*)(rowp + bj * HALF) = w; } }
    }
};
struct EpiF32 {
    static constexpr bool PERM = false, AFTER_DRAIN = false;
    float* O; int ldc;
    __device__ __forceinline__ void operator()(const f32x4 (&acc)[2][2][4][2], const Unit& u, int wr, int wc, int fr, int fq) const {
        const int col0 = u.pn * BM + wc * 32 + 4 * fq;
#pragma unroll
        for (int ai = 0; ai < 2; ++ai)
#pragma unroll
            for (int m = 0; m < 4; ++m) { float* rowp = O + (size_t)(u.pm * BM + ai * HALF + wr * 64 + m * 16 + fr) * ldc + col0;
#pragma unroll
                for (int bj = 0; bj < 2; ++bj)
#pragma unroll
                    for (int n = 0; n < 2; ++n) *(f32x4*)(rowp + bj * HALF + n * 16) = acc[ai][bj][m][n]; }
    }
};

template <class Epi, class Sched, bool ALIGN_EPI = false, bool SP2 = false>
__device__ __forceinline__ void gemm_phase(PG8_LAS unsigned char* lds, const Gemm g, const Sched& S, const Epi& E) {
    int tid_ = threadIdx.x; asm volatile("" : "+v"(tid_));
    const int tid = tid_, wid = __builtin_amdgcn_readfirstlane(tid >> 6), lane = tid & 63, wr = wid >> 2, wc = wid & 3, fr = lane & 15, fq = lane >> 4;
    const int K = g.K, nt = K / BK;
    unsigned voffA[2], voffB[2];
#pragma unroll
    for (int i = 0; i < 2; ++i) { int R, C; stage_rc(tid * 16 + i * 8192, R, C); const int Rb = Epi::PERM ? ((R & ~31) + perm32(R & 31)) : R;
        voffA[i] = (unsigned)(R * g.lda + C) * 2u; voffB[i] = (unsigned)(Rb * K + C) * 2u; }
    const size_t kstep = (size_t)(BK * 2);
    const size_t hstepA = (size_t)HALF * g.lda * 2, hstepB = (size_t)HALF * K * 2;
    const size_t tstepA = 2 * hstepA, tstepB = 2 * hstepB;
    const unsigned ldsw = (unsigned)wid * 1024u;
    const int aoff = lds_byte(wr * 64 + fr, fq * 8), boff = lds_byte(wc * 32 + fr, fq * 8);
#define PG8_SA(b, h) (((b) * 2 + (h)) * HTB)
#define PG8_SB(b, h) ((4 + (b) * 2 + (h)) * HTB)
#define PG8_STAGE(bufoff, gbase, voff) do { _Pragma("unroll") for (int _i = 0; _i < 2; ++_i) \
        __builtin_amdgcn_global_load_lds((const unsigned*)((const char*)(gbase) + (voff)[_i]), (PG8_LAS unsigned*)(lds + (bufoff) + ldsw + _i * 8192), 16, 0, 0); } while (0)
#define PG8_LDA(dst, b, h) do { _Pragma("unroll") for (int m = 0; m < 4; ++m) _Pragma("unroll") for (int k = 0; k < 2; ++k) dst[m][k] = *(const PG8_LAS bf16x8*)(lds + PG8_SA(b, h) + aoff + m * 2048 + k * 1024); } while (0)
#define PG8_LDB(dst, b, h) do { _Pragma("unroll") for (int n = 0; n < 2; ++n) _Pragma("unroll") for (int k = 0; k < 2; ++k) dst[n][k] = *(const PG8_LAS bf16x8*)(lds + PG8_SB(b, h) + boff + n * 2048 + k * 1024); } while (0)
#define PG8_MMA(ai, bj, At, Bt) do { __builtin_amdgcn_s_setprio(1); _Pragma("unroll") for (int m = 0; m < 4; ++m) _Pragma("unroll") for (int n = 0; n < 2; ++n) _Pragma("unroll") for (int k = 0; k < 2; ++k) \
        acc[ai][bj][m][n] = __builtin_amdgcn_mfma_f32_16x16x32_bf16(Bt[n][k], At[m][k], acc[ai][bj][m][n], 0, 0, 0); __builtin_amdgcn_s_setprio(0); } while (0)
#define PG8_WAIT_V(n) asm volatile("s_waitcnt vmcnt(" #n ")" ::: "memory")
#define PG8_WAIT_L(n) asm volatile("s_waitcnt lgkmcnt(" #n ")" ::: "memory")
#define PG8_BAR __builtin_amdgcn_s_barrier()
#define PG8_SCHED __builtin_amdgcn_sched_barrier(0)
    Unit cur, nxt; int ui = 0;
    if (!S.next(0, cur)) return;
    f32x4 acc[2][2][4][2];
#pragma unroll
    for (int a = 0; a < 2; ++a)
#pragma unroll
        for (int b = 0; b < 2; ++b)
#pragma unroll
            for (int m = 0; m < 4; ++m)
#pragma unroll
                for (int n = 0; n < 2; ++n) acc[a][b][m][n] = (f32x4){0.f, 0.f, 0.f, 0.f};
    bf16x8 At[4][2], B0[2][2], B1[2][2];
    const char* cA = (const char*)g.A + (size_t)cur.pm * tstepA; const char* cB = (const char*)g.Bt + (size_t)cur.pn * tstepB;
    S.a_ready(cur);
    if constexpr (SP2) {
        PG8_STAGE(PG8_SB(0, 0), cB, voffB); PG8_STAGE(PG8_SB(0, 1), cB + hstepB, voffB); PG8_STAGE(PG8_SA(0, 0), cA, voffA); PG8_STAGE(PG8_SA(0, 1), cA + hstepA, voffA);
        if (wr == 1) PG8_BAR;
        PG8_WAIT_V(2); PG8_BAR;
        PG8_STAGE(PG8_SB(1, 0), cB + kstep, voffB); PG8_STAGE(PG8_SA(1, 0), cA + kstep, voffA); PG8_STAGE(PG8_SB(1, 1), cB + hstepB + kstep, voffB);
        PG8_WAIT_V(6); PG8_BAR;
    } else {
        PG8_STAGE(PG8_SB(0, 0), cB, voffB); PG8_STAGE(PG8_SA(0, 0), cA, voffA); PG8_STAGE(PG8_SB(0, 1), cB + hstepB, voffB); PG8_STAGE(PG8_SA(0, 1), cA + hstepA, voffA);
        if (wr == 1) PG8_BAR;
        PG8_WAIT_V(4); PG8_BAR;
        PG8_STAGE(PG8_SB(1, 0), cB + kstep, voffB); PG8_STAGE(PG8_SA(1, 0), cA + kstep, voffA); PG8_STAGE(PG8_SB(1, 1), cB + hstepB + kstep, voffB);
        PG8_WAIT_V(6); PG8_BAR;
    }
    for (;;) {
        const bool has_next = S.next(ui + 1, nxt);
        const char* nA = has_next ? (const char*)g.A + (size_t)nxt.pm * tstepA : cA; const char* nB = has_next ? (const char*)g.Bt + (size_t)nxt.pn * tstepB : cB;
        for (int t = 0; t < nt; t += 2) {
            const bool last = (t == nt - 2);
            const char* a1 = cA + (size_t)(t + 1) * kstep;
            const char* a2 = last ? nA : cA + (size_t)(t + 2) * kstep; const char* b2 = last ? nB : cB + (size_t)(t + 2) * kstep;
            const char* a3 = a2 + kstep; const char* b3 = b2 + kstep;
            if (last && has_next) S.a_ready(nxt);
            if constexpr (SP2) {
            PG8_LDB(B0, 0, 0); PG8_LDB(B1, 0, 1); PG8_SCHED; PG8_LDA(At, 0, 0); PG8_STAGE(PG8_SA(1, 1), a1 + hstepA, voffA);
            PG8_WAIT_V(8); PG8_WAIT_L(0); PG8_BAR; PG8_MMA(0, 0, At, B0); PG8_MMA(0, 1, At, B1); PG8_BAR; PG8_SCHED;
            PG8_LDA(At, 0, 1); PG8_STAGE(PG8_SB(0, 0), b2, voffB); PG8_STAGE(PG8_SB(0, 1), b2 + hstepB, voffB); PG8_STAGE(PG8_SA(0, 0), a2, voffA);
            PG8_WAIT_V(8); PG8_WAIT_L(0); PG8_BAR; PG8_MMA(1, 0, At, B0); PG8_MMA(1, 1, At, B1); PG8_BAR; PG8_SCHED;
            PG8_LDB(B0, 1, 0); PG8_LDB(B1, 1, 1); PG8_SCHED; PG8_LDA(At, 1, 0); PG8_STAGE(PG8_SA(0, 1), a2 + hstepA, voffA);
            PG8_WAIT_V(8); PG8_WAIT_L(0); PG8_BAR; PG8_MMA(0, 0, At, B0); PG8_MMA(0, 1, At, B1); PG8_BAR; PG8_SCHED;
            PG8_LDA(At, 1, 1); PG8_STAGE(PG8_SB(1, 0), b3, voffB); PG8_STAGE(PG8_SB(1, 1), b3 + hstepB, voffB); PG8_STAGE(PG8_SA(1, 0), a3, voffA);
            PG8_WAIT_V(8); PG8_WAIT_L(0); PG8_BAR; PG8_MMA(1, 0, At, B0); PG8_MMA(1, 1, At, B1); PG8_BAR; PG8_SCHED;
            } else {
            PG8_LDB(B0, 0, 0); PG8_SCHED; PG8_LDA(At, 0, 0); PG8_STAGE(PG8_SA(1, 1), a1 + hstepA, voffA);
            PG8_WAIT_L(8); PG8_BAR; PG8_WAIT_L(0); PG8_MMA(0, 0, At, B0); PG8_BAR; PG8_SCHED;
            PG8_LDB(B1, 0, 1); PG8_STAGE(PG8_SB(0, 0), b2, voffB);
            PG8_BAR; PG8_WAIT_L(0); PG8_MMA(0, 1, At, B1); PG8_BAR;
            PG8_LDA(At, 0, 1); PG8_STAGE(PG8_SA(0, 0), a2, voffA);
            PG8_BAR; PG8_WAIT_L(0); PG8_MMA(1, 0, At, B0); PG8_BAR; PG8_SCHED;
            PG8_STAGE(PG8_SB(0, 1), b2 + hstepB, voffB);
            PG8_WAIT_V(6); PG8_BAR; PG8_MMA(1, 1, At, B1); PG8_BAR;
            PG8_LDB(B0, 1, 0); PG8_SCHED; PG8_LDA(At, 1, 0); PG8_STAGE(PG8_SA(0, 1), a2 + hstepA, voffA);
            PG8_WAIT_L(8); PG8_BAR; PG8_WAIT_L(0); PG8_MMA(0, 0, At, B0); PG8_BAR; PG8_SCHED;
            PG8_LDB(B1, 1, 1); PG8_STAGE(PG8_SB(1, 0), b3, voffB);
            PG8_BAR; PG8_WAIT_L(0); PG8_MMA(0, 1, At, B1); PG8_BAR;
            PG8_LDA(At, 1, 1); PG8_STAGE(PG8_SA(1, 0), a3, voffA);
            PG8_BAR; PG8_WAIT_L(0); PG8_MMA(1, 0, At, B0); PG8_BAR; PG8_SCHED;
            PG8_STAGE(PG8_SB(1, 1), b3 + hstepB, voffB);
            PG8_WAIT_V(6); PG8_BAR; PG8_MMA(1, 1, At, B1); PG8_BAR;
            }
        }
        if constexpr (ALIGN_EPI) { if (wr == 0) PG8_BAR; }
        if constexpr (!Epi::AFTER_DRAIN) { E(acc, cur, wr, wc, fr, fq); S.done(cur); }
        if (!has_next) break;
#pragma unroll
        for (int a = 0; a < 2; ++a)
#pragma unroll
            for (int b = 0; b < 2; ++b)
#pragma unroll
                for (int m = 0; m < 4; ++m)
#pragma unroll
                    for (int n = 0; n < 2; ++n) acc[a][b][m][n] = (f32x4){0.f, 0.f, 0.f, 0.f};
        cur = nxt; cA = nA; cB = nB; ++ui;
        if constexpr (ALIGN_EPI) { if (wr == 1) PG8_BAR; }
    }
    PG8_WAIT_V(0);
    if constexpr (!ALIGN_EPI) { if (wr == 0) PG8_BAR; }
    PG8_BAR;
    if constexpr (Epi::AFTER_DRAIN) { E.fused(acc, cur, wr, wc, fr, fq, lds, wid, lane); S.done(cur); }
#undef PG8_SA
#undef PG8_SB
#undef PG8_STAGE
#undef PG8_LDA
#undef PG8_LDB
#undef PG8_MMA
#undef PG8_WAIT_V
#undef PG8_WAIT_L
#undef PG8_BAR
#undef PG8_SCHED
}
}

constexpr int BATCH = 16, SEQ = 2048, DMODEL = 1024, MROWS = BATCH * SEQ;
constexpr int DMIX = 2048, NPROJ = 7168, DIN = 7176, NHF = 8;
constexpr int MEM_LEN = 256, MMEM = BATCH * MEM_LEN;
constexpr float EPS = 1e-6f, LOG2E = 1.4426950408889634f;
constexpr float QSCALE64 = 0.125f * LOG2E;
constexpr float QSCALE128 = 0.08838834764831845f * LOG2E;

constexpr size_t MiB = 1u << 20;
constexpr size_t WS_PROJ = 0;
constexpr size_t SEG_BYTES = 32 * MiB;
constexpr size_t WS_Y = 320 * MiB;
constexpr size_t WS_OG = 0;
constexpr size_t WS_WIN = 448 * MiB;
constexpr size_t WS_WOUT = 462 * MiB;
constexpr size_t WS_WMKV = 466 * MiB;
constexpr size_t WS_HM = 468 * MiB;
constexpr size_t WS_MKV = 476 * MiB;
constexpr size_t WS_LOGF = 484 * MiB;
constexpr size_t WS_C2 = 485 * MiB;
constexpr size_t WS_CTL = 486 * MiB, CTL_ZERO_BYTES = 1 * MiB;
constexpr size_t WS_END = 487 * MiB;
constexpr int CW_BAR = 4096;
constexpr int CW_QUEUE = 16384;

constexpr int RING_BYTES = 131072;
constexpr int LDSCTL_OFF = RING_BYTES, MISC_OFF = LDSCTL_OFF + 320;
constexpr int LDS_BYTES = 147456;
constexpr int NWAVES = 8;

#define GAS __attribute__((address_space(1)))
#define LAS __attribute__((address_space(3)))
typedef unsigned short bf16;
typedef unsigned v4u __attribute__((ext_vector_type(4)));
typedef float f32x4 __attribute__((ext_vector_type(4)));
typedef unsigned u32x4_t __attribute__((ext_vector_type(4)));
typedef short bf16x8 __attribute__((ext_vector_type(8)));
typedef GAS unsigned gu32;
typedef GAS unsigned long long gu64;
#define RLX_AGENT __ATOMIC_RELAXED, __HIP_MEMORY_SCOPE_AGENT
#define LDS_WAIT() asm volatile("s_waitcnt lgkmcnt(0)" ::: "memory")
#define VM_WAIT() asm volatile("s_waitcnt vmcnt(0)" ::: "memory")
__device__ __forceinline__ unsigned long long rt() { return __builtin_amdgcn_s_memrealtime(); }
__device__ __forceinline__ unsigned f2bf(float f) { unsigned u = __builtin_bit_cast(unsigned, f); return (u + 0x7fffu + ((u >> 16) & 1u)) >> 16; }
__device__ __forceinline__ unsigned pk2(float lo, float hi) { return f2bf(lo) | (f2bf(hi) << 16); }

#define XB_TMO      128
#define XB_XCNT(j)  (256  + 64 * (j))
#define XB_XSUB(j)  (1280 + 64 * (j))
#define XB_XGEN(j)  (2304 + 64 * (j))
#define XB_TOP      3328
#define XB_TOPGEN   3392
#define XCD_BAR_WORDS 3456
#define XB_SPIN_CAP (1u << 18)

__device__ __forceinline__ unsigned xb_ld(unsigned* p)              { return __hip_atomic_load(p, __ATOMIC_RELAXED, __HIP_MEMORY_SCOPE_AGENT); }
__device__ __forceinline__ unsigned xb_add(unsigned* p, unsigned v) { return __hip_atomic_fetch_add(p, v, __ATOMIC_RELAXED, __HIP_MEMORY_SCOPE_AGENT); }
__device__ __forceinline__ unsigned xb_xcc_id() { return (unsigned)__builtin_amdgcn_s_getreg((3 << 11) | 20) & 0xFu; }
#define XB_SPIN(cond, bar) do { unsigned _sp = 0; while (cond) { __builtin_amdgcn_s_sleep(1); \
    if ((++_sp & 255u) == 0u) { if (xb_ld(&(bar)[XB_TMO])) break; if (_sp > XB_SPIN_CAP) { atomicAdd(&(bar)[XB_TMO], 1u); break; } } } } while (0)

struct XcdBarrier {
    unsigned* bar; unsigned x;
    volatile LAS unsigned* st;
};

__device__ __forceinline__ XcdBarrier xcd_barrier_post(unsigned* bar, volatile LAS unsigned* st) {
    XcdBarrier b; b.bar = bar; b.x = xb_xcc_id(); b.st = st;
    if (threadIdx.x == 0) (void)xb_add(&bar[XB_XCNT(b.x)], 1u);
    return b;
}
__device__ __forceinline__ void xcd_barrier_complete(unsigned* bar, unsigned x, unsigned& nloc, unsigned& nx) {
    const unsigned G = gridDim.x * gridDim.y * gridDim.z;
    unsigned sum, cnt, mine, sp = 0u;
    for (;;) {
        sum = 0u; cnt = 0u; mine = 0u;
#pragma unroll
        for (unsigned j = 0; j < 16; ++j) { const unsigned c = xb_ld(&bar[XB_XCNT(j)]); sum += c; cnt += (c > 0u) ? 1u : 0u; mine = (j == x) ? c : mine; }
        if (sum == G) break;
        __builtin_amdgcn_s_sleep(1);
        if ((++sp & 255u) == 0u) { if (xb_ld(&bar[XB_TMO])) break; if (sp > XB_SPIN_CAP) { atomicAdd(&bar[XB_TMO], 1u); break; } }
    }
    nloc = mine > 0u ? mine : 1u; nx = cnt > 0u ? cnt : 1u;
}

__device__ __forceinline__ void xcd_barrier(const XcdBarrier& b) {
    asm volatile("s_waitcnt vmcnt(0)" ::: "memory");
    __syncthreads();
    if (threadIdx.x == 0) {
        unsigned* bar = b.bar;
        __builtin_amdgcn_s_waitcnt(0);
        unsigned nloc = b.st[0], nx = b.st[1];
        if (nloc == 0u) { xcd_barrier_complete(bar, b.x, nloc, nx); b.st[0] = nloc; b.st[1] = nx; }
        const unsigned old = xb_add(&bar[XB_XSUB(b.x)], 1u);
        const unsigned gen = old / nloc;
        if (old + 1u == (gen + 1u) * nloc) {
            __builtin_amdgcn_fence(__ATOMIC_RELEASE, "agent");
            asm volatile("s_waitcnt vmcnt(0)" ::: "memory");
            const unsigned og = xb_add(&bar[XB_TOP], 1u);
            const unsigned tg = og / nx;
            if (og + 1u == (tg + 1u) * nx) xb_add(&bar[XB_TOPGEN], 1u);
            else XB_SPIN(xb_ld(&bar[XB_TOPGEN]) == tg, bar);
            __builtin_amdgcn_fence(__ATOMIC_ACQUIRE, "agent");
            xb_add(&bar[XB_XGEN(b.x)], 1u);
            asm volatile("s_waitcnt vmcnt(0)" ::: "memory");
        } else {
            XB_SPIN(xb_ld(&bar[XB_XGEN(b.x)]) == gen, bar);
            __builtin_amdgcn_fence(__ATOMIC_ACQUIRE, "agent");
            asm volatile("s_waitcnt vmcnt(0)" ::: "memory");
        }
    }
    __syncthreads();
}

struct Args { const float* in[12]; float* out; unsigned char* ws; int ph_lo, ph_hi; };

struct Frame {
    LAS unsigned char* lds;
    volatile LAS unsigned* MISC;
    gu32* ctl;
    int tid, lane, wave;
    int vcu, G;
    const Args* a;
};
#define F_X(F) ((F).a->in[0])
#define F_MEM(F) ((F).a->in[1])
#define F_WIN(F) ((F).a->in[2])
#define F_BFORGET(F) ((F).a->in[3])
#define F_WMKV(F) ((F).a->in[4])
#define F_WOUT(F) ((F).a->in[5])
#define F_PRE(F) ((F).a->in[6])
#define F_POST(F) ((F).a->in[7])
#define F_MEMNORM(F) ((F).a->in[8])
#define F_DLAM(F) ((F).a->in[9])
#define F_DHN(F) ((F).a->in[10])
#define F_RELB(F) ((F).a->in[11])
#define F_OUT(F) ((F).a->out)
#define F_WS(F) ((F).a->ws)
__device__ __forceinline__ float bf2f(unsigned short u) { return __uint_as_float((unsigned)u << 16); }
__device__ __forceinline__ float wave_sum(float v) {
#pragma unroll
    for (int o = 1; o < 64; o <<= 1) v += __shfl_xor(v, o);
    return v;
}
__device__ __forceinline__ float log_sigmoid_f(float v) { return v >= 0.f ? -log1pf(expf(-v)) : v - log1pf(expf(v)); }

__device__ __forceinline__ void p0_transpose_item(const float* W, int ldw, int K, bf16* WT, int k0, int n0, int csrc0, float sc, LAS float* scr, int lane) {
#pragma unroll 8
    for (int i = 0; i < 32; ++i) { const int kk = 2 * i + (lane >> 5); scr[kk * 33 + (lane & 31)] = W[(size_t)(k0 + kk) * ldw + csrc0 + (lane & 31)]; }
    LDS_WAIT(); asm volatile("" ::: "memory");
    const int c = lane & 7;
#pragma unroll
    for (int j = 0; j < 4; ++j) { const int n = (lane >> 3) + 8 * j; const LAS float* s = scr + (8 * c) * 33 + n;
        v4u o; o.x = pk2(s[0 * 33] * sc, s[1 * 33] * sc); o.y = pk2(s[2 * 33] * sc, s[3 * 33] * sc); o.z = pk2(s[4 * 33] * sc, s[5 * 33] * sc); o.w = pk2(s[6 * 33] * sc, s[7 * 33] * sc);
        *(GAS v4u*)(WT + (size_t)(n0 + n) * K + k0 + 8 * c) = o; }
    LDS_WAIT(); asm volatile("" ::: "memory");
}
__device__ __forceinline__ void p0_weights(Frame& F0, int l) {
    Frame F = F0; asm volatile("" : "+v"(F.lane), "+v"(F.tid));
    LAS float* scr = (LAS float*)(F.lds + F.wave * 8448);
    const int gw = F.vcu * NWAVES + F.wave, NGW = F.G * NWAVES;
    constexpr int I_IN = 16 * 224, I_OUT = 32 * 32, I_MKV = 16 * 32;
    const float* win = F_WIN(F) + (size_t)l * DMODEL * DIN; const float* wout = F_WOUT(F) + (size_t)l * DMIX * DMODEL; const float* wmkv = F_WMKV(F) + (size_t)l * DMODEL * 1024;
    for (int it = gw; it < I_IN + I_OUT + I_MKV; it += NGW) {
        int r = it;
        if (r < I_IN) { const int kb = r / 224, nb = r % 224, n0 = 32 * nb; const int csrc0 = n0 + (n0 >= 4608 ? 8 : 0);
            float sc = 1.f; if (n0 < 512 || (n0 >= 1536 && n0 < 2048) || (n0 >= 3072 && n0 < 3584)) sc = QSCALE64; else if (n0 >= 4608 && n0 < 5120) sc = QSCALE128;
            p0_transpose_item(win, DIN, DMODEL, (bf16*)(F_WS(F) + WS_WIN), 64 * kb, n0, csrc0, sc, scr, F.lane); continue; }
        r -= I_IN;
        if (r < I_OUT) { const int kb = r / 32, nb = r % 32; p0_transpose_item(wout, DMODEL, DMIX, (bf16*)(F_WS(F) + WS_WOUT), 64 * kb, 32 * nb, 32 * nb, 1.f, scr, F.lane); continue; }
        r -= I_OUT;
        { const int kb = r / 32, nb = r % 32; p0_transpose_item(wmkv, 1024, DMODEL, (bf16*)(F_WS(F) + WS_WMKV), 64 * kb, 32 * nb, 32 * nb, 1.f, scr, F.lane); }
    }
}
__device__ __forceinline__ void p0_mem_rows(Frame& F0, int l) {
    Frame F = F0; asm volatile("" : "+v"(F.lane), "+v"(F.tid));
    const int gw = F.vcu * NWAVES + F.wave, NGW = F.G * NWAVES;
    const GAS f32x4* gp = (const GAS f32x4*)(F_MEMNORM(F) + l * DMODEL) + F.lane; f32x4 g[4];
#pragma unroll
    for (int j = 0; j < 4; ++j) g[j] = gp[64 * j];
    for (int m = gw; m < MMEM; m += NGW) {
        const GAS f32x4* xr = (const GAS f32x4*)(F_MEM(F) + (size_t)m * DMODEL) + F.lane; f32x4 v[4]; float s2 = 0.f;
#pragma unroll
        for (int j = 0; j < 4; ++j) { v[j] = xr[64 * j]; s2 += (v[j].x * v[j].x + v[j].y * v[j].y) + (v[j].z * v[j].z + v[j].w * v[j].w); }
        const float r = 1.0f / sqrtf(wave_sum(s2) * (1.f / DMODEL) + EPS);
        GAS unsigned long long* o8 = (GAS unsigned long long*)(F_WS(F) + WS_HM + (size_t)m * DMODEL * 2) + F.lane;
#pragma unroll
        for (int j = 0; j < 4; ++j) { const f32x4 h = v[j] * r * g[j]; o8[64 * j] = (unsigned long long)pk2(h.x, h.y) | ((unsigned long long)pk2(h.z, h.w) << 32); }
    }
}
struct RowIn { f32x4 v[4]; v4u og[2]; v4u n1[2]; };
__device__ __forceinline__ void bf8_to_f(const v4u u, f32x4& a, f32x4& b) {
    a.x = __uint_as_float(u.x << 16); a.y = __uint_as_float(u.x & 0xffff0000u); a.z = __uint_as_float(u.y << 16); a.w = __uint_as_float(u.y & 0xffff0000u);
    b.x = __uint_as_float(u.z << 16); b.y = __uint_as_float(u.z & 0xffff0000u); b.z = __uint_as_float(u.w << 16); b.w = __uint_as_float(u.w & 0xffff0000u); }
__device__ __forceinline__ v4u f_to_bf8(const f32x4 a, const f32x4 b) { v4u u; u.x = pk2(a.x, a.y); u.y = pk2(a.z, a.w); u.z = pk2(b.x, b.y); u.w = pk2(b.z, b.w); return u; }
__device__ __forceinline__ float sumsq4(const f32x4 (&v)[4]) { float s = 0.f;
#pragma unroll
    for (int j = 0; j < 4; ++j) s += (v[j].x * v[j].x + v[j].y * v[j].y) + (v[j].z * v[j].z + v[j].w * v[j].w);
    return s; }
__device__ __forceinline__ void row_load(Frame& F, int l, int m, int lane, RowIn& R) {
    const GAS f32x4* xr = (const GAS f32x4*)(F_X(F) + (size_t)m * DMODEL + 8 * lane);
    R.v[0] = xr[0]; R.v[1] = xr[1]; R.v[2] = xr[128]; R.v[3] = xr[129];
    if (l > 0) { const GAS v4u* orow = (const GAS v4u*)((const bf16*)(F_WS(F) + WS_OG) + (size_t)m * DMODEL + 8 * lane); R.og[0] = orow[0]; R.og[1] = orow[64]; }
    if (l == 2) { const GAS v4u* nr = (const GAS v4u*)((const bf16*)((unsigned char*)F_OUT(F) + (size_t)m * 4096) + 8 * lane); R.n1[0] = nr[0]; R.n1[1] = nr[64]; }
}
__device__ __forceinline__ void row_compute(Frame& F, int l, int m, int lane, RowIn& R, const f32x4 (&gpre)[4], const f32x4 (&gpost)[4], const LAS float* wf) {
    unsigned char* slot = (unsigned char*)F_OUT(F) + (size_t)m * 4096;
    f32x4 v[4];
#pragma unroll
    for (int j = 0; j < 4; ++j) v[j] = R.v[j];
    if (l > 0) {
        f32x4 o[4]; bf8_to_f(R.og[0], o[0], o[1]); bf8_to_f(R.og[1], o[2], o[3]);
        const float ro = 1.0f / sqrtf(wave_sum(sumsq4(o)) * (1.f / DMODEL) + EPS);
        if (l == 1) {
            f32x4 n[4];
#pragma unroll
            for (int j = 0; j < 4; ++j) n[j] = o[j] * ro * gpost[j];
            const v4u n0 = f_to_bf8(n[0], n[1]), n1 = f_to_bf8(n[2], n[3]);
            GAS v4u* nw = (GAS v4u*)((bf16*)slot + 8 * lane); nw[0] = n0; nw[64] = n1;
            f32x4 t[4]; bf8_to_f(n0, t[0], t[1]); bf8_to_f(n1, t[2], t[3]);
#pragma unroll
            for (int j = 0; j < 4; ++j) v[j] = v[j] + t[j];
        } else {
            f32x4 t[4]; bf8_to_f(R.n1[0], t[0], t[1]); bf8_to_f(R.n1[1], t[2], t[3]);
            GAS f32x4* outr = (GAS f32x4*)((float*)slot + 8 * lane);
            outr[0] = v[0] + t[0] + o[0] * ro * gpost[0]; outr[1] = v[1] + t[1] + o[1] * ro * gpost[1];
            outr[128] = v[2] + t[2] + o[2] * ro * gpost[2]; outr[129] = v[3] + t[3] + o[3] * ro * gpost[3];
            return;
        }
    }
    const float r = 1.0f / sqrtf(wave_sum(sumsq4(v)) * (1.f / DMODEL) + EPS);
    f32x4 h[4];
#pragma unroll
    for (int j = 0; j < 4; ++j) h[j] = v[j] * r * gpre[j];
    { GAS v4u* hw = (GAS v4u*)((bf16*)(slot + 2048) + 8 * lane); hw[0] = f_to_bf8(h[0], h[1]); hw[64] = f_to_bf8(h[2], h[3]); }
    float fl[8];
#pragma unroll
    for (int f = 0; f < 8; ++f) { const LAS f32x4* wp = (const LAS f32x4*)(wf + f * 1024 + 8 * lane); const f32x4 w0 = wp[0], w1 = wp[1], w2 = wp[128], w3 = wp[129];
        fl[f] = ((h[0].x * w0.x + h[0].y * w0.y) + (h[0].z * w0.z + h[0].w * w0.w)) + ((h[1].x * w1.x + h[1].y * w1.y) + (h[1].z * w1.z + h[1].w * w1.w))
              + ((h[2].x * w2.x + h[2].y * w2.y) + (h[2].z * w2.z + h[2].w * w2.w)) + ((h[3].x * w3.x + h[3].y * w3.y) + (h[3].z * w3.z + h[3].w * w3.w));
        if (f & 1) __builtin_amdgcn_sched_barrier(0); }
    float t4[4], t2[2];
    { const bool up = (lane & 32) != 0;
#pragma unroll
      for (int i = 0; i < 4; ++i) { const float send = up ? fl[i] : fl[4 + i], keep = up ? fl[4 + i] : fl[i]; t4[i] = keep + __shfl_xor(send, 32); } }
    { const bool up = (lane & 16) != 0;
#pragma unroll
      for (int i = 0; i < 2; ++i) { const float send = up ? t4[i] : t4[2 + i], keep = up ? t4[2 + i] : t4[i]; t2[i] = keep + __shfl_xor(send, 16); } }
    float fv; { const bool up = (lane & 8) != 0; const float send = up ? t2[0] : t2[1], keep = up ? t2[1] : t2[0]; fv = keep + __shfl_xor(send, 8); }
    fv += __shfl_xor(fv, 4); fv += __shfl_xor(fv, 2); fv += __shfl_xor(fv, 1);
    if ((lane & 7) == 0) { const int f = ((lane >> 5) & 1) * 4 + ((lane >> 4) & 1) * 2 + ((lane >> 3) & 1); const int b = m / SEQ, s = m % SEQ;
        ((float*)(F_WS(F) + WS_LOGF))[((size_t)b * NHF + f) * SEQ + s] = log_sigmoid_f(fv + F_BFORGET(F)[l * NHF + f]); }
}
__device__ __forceinline__ void p0_rows(Frame& F0, int l) {
    Frame F = F0; asm volatile("" : "+v"(F.lane), "+v"(F.tid));
    const int gw = F.vcu * NWAVES + F.wave, NGW = F.G * NWAVES, lane = F.lane;
    LAS float* wf = (LAS float*)(F.lds + 98304);
    if (l < 2) {
        const float* win = F_WIN(F) + (size_t)l * DMODEL * DIN + 4608;
        for (int idx = F.tid; idx < 8192; idx += NWAVES * 64) { const int k = idx >> 3, f = idx & 7; wf[f * 1024 + k] = win[(size_t)k * DIN + f]; }
        __syncthreads();
    }
    f32x4 gpre[4], gpost[4];
#pragma unroll
    for (int j = 0; j < 4; ++j) { gpre[j] = (f32x4){0.f, 0.f, 0.f, 0.f}; gpost[j] = gpre[j]; }
    if (l < 2) { const GAS f32x4* gp = (const GAS f32x4*)(F_PRE(F) + l * DMODEL + 8 * lane); gpre[0] = gp[0]; gpre[1] = gp[1]; gpre[2] = gp[128]; gpre[3] = gp[129]; }
    if (l > 0) { const GAS f32x4* gp = (const GAS f32x4*)(F_POST(F) + (l - 1) * DMODEL + 8 * lane); gpost[0] = gp[0]; gpost[1] = gp[1]; gpost[2] = gp[128]; gpost[3] = gp[129]; }
    for (int m = gw; m < MROWS; m += 2 * NGW) {
        const int m2 = m + NGW; const bool two = m2 < MROWS;
        RowIn A, B;
        row_load(F, l, m, lane, A);
        if (two) row_load(F, l, m2, lane, B);
        if (l == 2) asm volatile("s_waitcnt vmcnt(0)" ::: "memory");
        row_compute(F, l, m, lane, A, gpre, gpost, wf);
        if (two) row_compute(F, l, m2, lane, B, gpre, gpost, wf);
    }
}
__device__ __forceinline__ void cumsum_logf(Frame& F0) {
    Frame F = F0; asm volatile("" : "+v"(F.lane), "+v"(F.tid));
    const int bh = blockIdx.x;
    if (bh >= BATCH * NHF || F.wave != 0) return;
    const float* src = (const float*)(F_WS(F) + WS_LOGF) + (size_t)bh * SEQ + 32 * F.lane; float* dst = (float*)(F_WS(F) + WS_C2) + (size_t)bh * SEQ + 32 * F.lane;
    float v[32];
#pragma unroll
    for (int i = 0; i < 8; ++i) { const f32x4 t = *(const GAS f32x4*)(src + 4 * i); v[4 * i] = t.x; v[4 * i + 1] = t.y; v[4 * i + 2] = t.z; v[4 * i + 3] = t.w; }
#pragma unroll
    for (int i = 1; i < 32; ++i) v[i] += v[i - 1];
    float tot = v[31], inc = tot;
#pragma unroll
    for (int o = 1; o < 64; o <<= 1) { const float t = __shfl_up(inc, o); if (F.lane >= o) inc += t; }
    const float off = inc - tot;
#pragma unroll
    for (int i = 0; i < 8; ++i) { f32x4 t; t.x = (v[4 * i] + off) * -LOG2E; t.y = (v[4 * i + 1] + off) * -LOG2E; t.z = (v[4 * i + 2] + off) * -LOG2E; t.w = (v[4 * i + 3] + off) * -LOG2E; *(GAS f32x4*)(dst + 4 * i) = t; }
}

struct NArgs { const unsigned char* ws; unsigned char* wsw; const float* diff_lambda; const float* diff_head_norm; const float* rel_bias; int layer; int pad; };
__device__ __forceinline__ void ld_row64(const bf16* p, float* q) {
#pragma unroll
    for (int i = 0; i < 8; ++i) { const uint4 u = *(const uint4*)(p + 8 * i);
        q[8 * i] = __uint_as_float(u.x << 16); q[8 * i + 1] = __uint_as_float(u.x & 0xffff0000u); q[8 * i + 2] = __uint_as_float(u.y << 16); q[8 * i + 3] = __uint_as_float(u.y & 0xffff0000u);
        q[8 * i + 4] = __uint_as_float(u.z << 16); q[8 * i + 5] = __uint_as_float(u.z & 0xffff0000u); q[8 * i + 6] = __uint_as_float(u.w << 16); q[8 * i + 7] = __uint_as_float(u.w & 0xffff0000u); }
}
__device__ __forceinline__ float dot64(const bf16* p, const float* q) {
    float s = 0.f;
#pragma unroll
    for (int i = 0; i < 8; ++i) { const uint4 u = *(const uint4*)(p + 8 * i);
        s += q[8 * i] * __uint_as_float(u.x << 16) + q[8 * i + 1] * __uint_as_float(u.x & 0xffff0000u) + q[8 * i + 2] * __uint_as_float(u.y << 16) + q[8 * i + 3] * __uint_as_float(u.y & 0xffff0000u)
           + q[8 * i + 4] * __uint_as_float(u.z << 16) + q[8 * i + 5] * __uint_as_float(u.z & 0xffff0000u) + q[8 * i + 6] * __uint_as_float(u.w << 16) + q[8 * i + 7] * __uint_as_float(u.w & 0xffff0000u); }
    return s;
}
__device__ __forceinline__ void axpy64(const bf16* p, float a, float* acc) {
#pragma unroll
    for (int i = 0; i < 8; ++i) { const uint4 u = *(const uint4*)(p + 8 * i);
        acc[8 * i] += a * __uint_as_float(u.x << 16); acc[8 * i + 1] += a * __uint_as_float(u.x & 0xffff0000u); acc[8 * i + 2] += a * __uint_as_float(u.y << 16); acc[8 * i + 3] += a * __uint_as_float(u.y & 0xffff0000u);
        acc[8 * i + 4] += a * __uint_as_float(u.z << 16); acc[8 * i + 5] += a * __uint_as_float(u.z & 0xffff0000u); acc[8 * i + 6] += a * __uint_as_float(u.w << 16); acc[8 * i + 7] += a * __uint_as_float(u.w & 0xffff0000u); }
}
__device__ __forceinline__ void store_y64(bf16* yrow, const float* o) {
#pragma unroll
    for (int i = 0; i < 8; ++i) { uint4 u = *(const uint4*)(yrow + 8 * i);
        u.x = pk2(o[8 * i] * __uint_as_float(u.x << 16), o[8 * i + 1] * __uint_as_float(u.x & 0xffff0000u)); u.y = pk2(o[8 * i + 2] * __uint_as_float(u.y << 16), o[8 * i + 3] * __uint_as_float(u.y & 0xffff0000u));
        u.z = pk2(o[8 * i + 4] * __uint_as_float(u.z << 16), o[8 * i + 5] * __uint_as_float(u.z & 0xffff0000u)); u.w = pk2(o[8 * i + 6] * __uint_as_float(u.w << 16), o[8 * i + 7] * __uint_as_float(u.w & 0xffff0000u));
        *(uint4*)(yrow + 8 * i) = u; }
}
__device__ __forceinline__ int t5_bucket(int n) {
    if (n < 16) return n;
    int large = 16 + (int)(logf((float)n / 16.0f) / logf(8.0f) * 16.0f);
    return large < 31 ? large : 31;
}
__device__ __forceinline__ float diff_lam(const float* dl, int l, float& lam_init) {
    float s1 = 0.f, s2 = 0.f;
    for (int i = 0; i < 64; ++i) { s1 += dl[l * 256 + i] * dl[l * 256 + 64 + i]; s2 += dl[l * 256 + 128 + i] * dl[l * 256 + 192 + i]; }
    lam_init = 0.8f - 0.6f * expf(-0.3f * (float)l);
    return expf(s1) - expf(s2) + lam_init;
}
__global__ void __launch_bounds__(256) naive_sb(NArgs a) {
    const int qb = blockIdx.x & 7, h = (blockIdx.x >> 3) & 7, b = blockIdx.x >> 6; const int t = qb * 256 + threadIdx.x; const size_t row = (size_t)b * SEQ + t;
    const bf16* Q = (const bf16*)(a.ws + WS_PROJ + 3 * SEG_BYTES); const bf16* K = (const bf16*)(a.ws + WS_PROJ + 4 * SEG_BYTES); const bf16* V = (const bf16*)(a.ws + WS_PROJ + 5 * SEG_BYTES);
    float q[64], acc[64]; ld_row64(Q + row * 512 + h * 64, q);
#pragma unroll
    for (int d = 0; d < 64; ++d) acc[d] = 0.f;
    float tail = 0.f;
    for (int s = qb * 256 + 254; s >= 0; --s) {
        if (s < t) { const size_t kr = ((size_t)b * SEQ + s) * 512 + h * 64; const float z = dot64(K + kr, q); const float e = exp2f(z), L = log2f(1.0f + e);
            const float w = exp2f(z - L + tail); tail -= L; axpy64(V + kr, w, acc); }
    }
    store_y64((bf16*)(a.wsw + WS_Y) + row * 2048 + 512 + h * 64, acc);
}
__global__ void __launch_bounds__(256) naive_fox(NArgs a) {
    const int qb = blockIdx.x & 7, h = (blockIdx.x >> 3) & 7, b = blockIdx.x >> 6; const int t = qb * 256 + threadIdx.x; const size_t row = (size_t)b * SEQ + t;
    const bf16* Q = (const bf16*)(a.ws + WS_PROJ + 6 * SEG_BYTES); const bf16* K = (const bf16*)(a.ws + WS_PROJ + 7 * SEG_BYTES); const bf16* V = (const bf16*)(a.ws + WS_PROJ + 8 * SEG_BYTES);
    const float* c2 = (const float*)(a.ws + WS_C2) + ((size_t)b * NHF + h) * SEQ;
    float q[64], acc[64]; ld_row64(Q + row * 512 + h * 64, q);
#pragma unroll
    for (int d = 0; d < 64; ++d) acc[d] = 0.f;
    float m = -1e30f, lsum = 0.f; const float ct = c2[t];
    for (int s = 0; s <= qb * 256 + 255; ++s) {
        if (s <= t) { const size_t kr = ((size_t)b * SEQ + s) * 512 + h * 64; const float xx = dot64(K + kr, q) + (c2[s] - ct); const float mn = fmaxf(m, xx), al = exp2f(m - mn), p = exp2f(xx - mn);
            lsum = lsum * al + p; m = mn;
#pragma unroll
            for (int d = 0; d < 64; ++d) acc[d] *= al;
            axpy64(V + kr, p, acc); }
    }
    const float il = 1.0f / lsum;
#pragma unroll
    for (int d = 0; d < 64; ++d) acc[d] *= il;
    store_y64((bf16*)(a.wsw + WS_Y) + row * 2048 + 1024 + h * 64, acc);
}
__global__ void __launch_bounds__(256) naive_mem(NArgs a) {
    const int qb = blockIdx.x & 7, h = (blockIdx.x >> 3) & 3, b = blockIdx.x >> 5; const int t = qb * 256 + threadIdx.x; const size_t row = (size_t)b * SEQ + t;
    const bf16* Q = (const bf16*)(a.ws + WS_PROJ + 9 * SEG_BYTES); const bf16* KV = (const bf16*)(a.ws + WS_MKV);
    float q[128]; ld_row64(Q + row * 512 + h * 128, q); ld_row64(Q + row * 512 + h * 128 + 64, q + 64);
#pragma unroll
    for (int dh = 0; dh < 2; ++dh) {
        float acc[64];
#pragma unroll
        for (int d = 0; d < 64; ++d) acc[d] = 0.f;
        float m = -1e30f, lsum = 0.f;
        for (int s = 0; s < MEM_LEN; ++s) { const size_t kr = ((size_t)b * MEM_LEN + s) * 1024 + h * 128; const float xx = dot64(KV + kr, q) + dot64(KV + kr + 64, q + 64);
            const float mn = fmaxf(m, xx), al = exp2f(m - mn), p = exp2f(xx - mn); lsum = lsum * al + p; m = mn;
#pragma unroll
            for (int d = 0; d < 64; ++d) acc[d] *= al;
            axpy64(KV + kr + 512 + dh * 64, p, acc); }
        const float il = 1.0f / lsum;
#pragma unroll
        for (int d = 0; d < 64; ++d) acc[d] *= il;
        store_y64((bf16*)(a.wsw + WS_Y) + row * 2048 + 1536 + h * 128 + dh * 64, acc);
    }
}
template <int C> __device__ __forceinline__ void naive_diff_pass(const bf16* Q, const bf16* K, const bf16* V, const float* rel_bias, int b, int h, int t, int tmax, int dh, float* res, float coef) {
    const size_t row = (size_t)b * SEQ + t; float q[64], acc[64]; ld_row64(Q + row * 512 + h * 128 + C * 64, q);
#pragma unroll
    for (int d = 0; d < 64; ++d) acc[d] = 0.f;
    float m = -1e30f, lsum = 0.f;
    for (int s = 0; s <= tmax; ++s) {
        if (s <= t) { const size_t kr = ((size_t)b * SEQ + s) * 512 + h * 128; const float xx = dot64(K + kr + C * 64, q) + rel_bias[t5_bucket(t - s) * 4 + h] * LOG2E;
            const float mn = fmaxf(m, xx), al = exp2f(m - mn), p = exp2f(xx - mn); lsum = lsum * al + p; m = mn;
#pragma unroll
            for (int d = 0; d < 64; ++d) acc[d] *= al;
            axpy64(V + kr + dh * 64, p, acc); }
    }
    const float il = coef / lsum;
#pragma unroll
    for (int d = 0; d < 64; ++d) res[d] += acc[d] * il;
}
__global__ void __launch_bounds__(256) naive_diff(NArgs a) {
    const int qb = blockIdx.x & 7, h = (blockIdx.x >> 3) & 3, b = blockIdx.x >> 5; const int t = qb * 256 + threadIdx.x; const size_t row = (size_t)b * SEQ + t;
    const bf16* Q = (const bf16*)(a.ws + WS_PROJ); const bf16* K = (const bf16*)(a.ws + WS_PROJ + 1 * SEG_BYTES); const bf16* V = (const bf16*)(a.ws + WS_PROJ + 2 * SEG_BYTES);
    float lam_init; const float lam = diff_lam(a.diff_lambda, a.layer, lam_init);
    float o0[64], o1[64];
#pragma unroll
    for (int d = 0; d < 64; ++d) { o0[d] = 0.f; o1[d] = 0.f; }
    const int tmax = qb * 256 + 255;
    naive_diff_pass<0>(Q, K, V, a.rel_bias, b, h, t, tmax, 0, o0, 1.0f); naive_diff_pass<1>(Q, K, V, a.rel_bias, b, h, t, tmax, 0, o0, -lam);
    naive_diff_pass<0>(Q, K, V, a.rel_bias, b, h, t, tmax, 1, o1, 1.0f); naive_diff_pass<1>(Q, K, V, a.rel_bias, b, h, t, tmax, 1, o1, -lam);
    float ss = 0.f;
#pragma unroll
    for (int d = 0; d < 64; ++d) ss += o0[d] * o0[d] + o1[d] * o1[d];
    const float r = (1.0f / sqrtf(ss * (1.0f / 128.0f) + EPS)) * (1.0f - lam_init); const float* g = a.diff_head_norm + a.layer * 128;
#pragma unroll
    for (int d = 0; d < 64; ++d) { o0[d] *= r * g[d]; o1[d] *= r * g[64 + d]; }
    bf16* yrow = (bf16*)(a.wsw + WS_Y) + row * 2048 + h * 128; store_y64(yrow, o0); store_y64(yrow + 64, o1);
}

namespace att {
typedef float f32x16 __attribute__((ext_vector_type(16)));
typedef short s16x4 __attribute__((ext_vector_type(4)));
typedef short v4i16_t __attribute__((ext_vector_type(4)));
typedef LAS const char* lds_cptr;
typedef float f32x2_t __attribute__((ext_vector_type(2))); typedef __bf16 bf16x2_t __attribute__((ext_vector_type(2)));
constexpr int AK_OFF = 0, AV_OFF = 49152, SLOT = 16384, AC2_OFF = 98304, ATB_OFF = 106496, AQW_OFF = 111616, AFL_OFF = 111616 + 64, AX_OFF = 0;
constexpr int TBN = 320;
enum { M_SB = 0, M_FOX = 1, M_DIFF = 2, M_MEM = 3 };
constexpr float NEG = -1e30f;
#define SBAR() __builtin_amdgcn_sched_barrier(0)
__device__ __forceinline__ void glds16(const void* gsrc, unsigned lds_dst) { unsigned keep;
    asm volatile("s_mov_b32 %0, m0\n\ts_mov_b32 m0, %2\n\ts_nop 0\n\tglobal_load_lds_dwordx4 %1, off\n\ts_mov_b32 m0, %0" : "=&s"(keep) : "v"(gsrc), "s"(lds_dst) : "memory"); }
__device__ __forceinline__ s16x4 vtr(lds_cptr p) { return __builtin_bit_cast(s16x4, __builtin_amdgcn_ds_read_tr16_b64_v4i16((LAS v4i16_t*)p)); }
__device__ __forceinline__ unsigned cvtpk(float lo, float hi) { f32x2_t v = {lo, hi}; bf16x2_t b = __builtin_convertvector(v, bf16x2_t); return __builtin_bit_cast(unsigned, b); }
__device__ __forceinline__ float ex2(float v) { return __builtin_amdgcn_exp2f(v); }
__device__ __forceinline__ float lg2(float v) { return __builtin_amdgcn_logf(v); }
__device__ __forceinline__ float xsum(float v) { auto rr = __builtin_amdgcn_permlane32_swap(__float_as_uint(v), __float_as_uint(v), false, false); return __uint_as_float(rr[0]) + __uint_as_float(rr[1]); }
__device__ __forceinline__ float xmax(float v) { auto rr = __builtin_amdgcn_permlane32_swap(__float_as_uint(v), __float_as_uint(v), false, false); return fmaxf(__uint_as_float(rr[0]), __uint_as_float(rr[1])); }
__device__ __forceinline__ int kcol(int r) { return (r & 3) + 8 * (r >> 2); }

template <int MODE>
__device__ __forceinline__ void attn_unit(const Args* A, LAS unsigned char* L, int b, int h, int qb, int layer, float lam, float lam_init) {
    constexpr int DQK = (MODE == M_MEM) ? 128 : 64, DV = (MODE == M_SB || MODE == M_FOX) ? 64 : 128;
    constexpr int KCH = (MODE == M_SB || MODE == M_FOX) ? 8 : 16, VPC = DV / 8, ROWS = (MODE == M_DIFF) ? 128 : 256;
    constexpr int NQ = DQK / 16, NDB = DV / 32, NPT = KCH / 8 + VPC / 8;
    constexpr bool CAUSAL = MODE != M_MEM;
    int tid_ = threadIdx.x; asm volatile("" : "+v"(tid_));
    const int tid = tid_, lane = tid & 63, r32 = lane & 31, hi = lane >> 5, wid = __builtin_amdgcn_readfirstlane(tid >> 6);
    const int wrow = (MODE == M_DIFF) ? (wid & 3) : wid, comp = (MODE == M_DIFF) ? (wid >> 2) : 0;
    const int q0 = qb * ROWS, wq0 = q0 + wrow * 32;
    const unsigned char* ws = A->ws;
    const bf16 *Qg, *Kg, *Vg; int pitchK = 512, ycol;
    if (MODE == M_SB)   { Qg = (const bf16*)(ws + WS_PROJ + 3 * SEG_BYTES) + (size_t)b * SEQ * 512 + h * 64; Kg = (const bf16*)(ws + WS_PROJ + 4 * SEG_BYTES) + (size_t)b * SEQ * 512 + h * 64; Vg = (const bf16*)(ws + WS_PROJ + 5 * SEG_BYTES) + (size_t)b * SEQ * 512 + h * 64; ycol = 512 + h * 64; }
    if (MODE == M_FOX)  { Qg = (const bf16*)(ws + WS_PROJ + 6 * SEG_BYTES) + (size_t)b * SEQ * 512 + h * 64; Kg = (const bf16*)(ws + WS_PROJ + 7 * SEG_BYTES) + (size_t)b * SEQ * 512 + h * 64; Vg = (const bf16*)(ws + WS_PROJ + 8 * SEG_BYTES) + (size_t)b * SEQ * 512 + h * 64; ycol = 1024 + h * 64; }
    if (MODE == M_DIFF) { Qg = (const bf16*)(ws + WS_PROJ) + (size_t)b * SEQ * 512 + h * 128 + comp * 64; Kg = (const bf16*)(ws + WS_PROJ + 1 * SEG_BYTES) + (size_t)b * SEQ * 512 + h * 128; Vg = (const bf16*)(ws + WS_PROJ + 2 * SEG_BYTES) + (size_t)b * SEQ * 512 + h * 128; ycol = h * 128; }
    if (MODE == M_MEM)  { Qg = (const bf16*)(ws + WS_PROJ + 9 * SEG_BYTES) + (size_t)b * SEQ * 512 + h * 128; Kg = (const bf16*)(ws + WS_MKV) + (size_t)b * MEM_LEN * 1024 + h * 128; Vg = Kg + 512; pitchK = 1024; ycol = 1536 + h * 128; }
    const int NT = (MODE == M_MEM) ? 4 : (q0 + ROWS) / 64;
    const unsigned lds0 = (unsigned)(uintptr_t)L;
    const bf16* ksrc = Kg + (size_t)lane * pitchK + wid * 8;
    const bf16* vsrc = Vg + (size_t)(16 * (wid & 3) + (lane >> 2)) * pitchK + (wid >> 2) * 32 + (lane & 3) * 8;
#define ATT_ISSUE(kt, sl) do { const size_t toff_ = (size_t)(kt) * 64 * pitchK; \
        _Pragma("unroll") for (int i_ = 0; i_ < KCH / 8; ++i_) glds16(ksrc + toff_ + i_ * 64, (unsigned)__builtin_amdgcn_readfirstlane(lds0 + AK_OFF + (sl) * SLOT + (wid + 8 * i_) * 1024)); \
        _Pragma("unroll") for (int i_ = 0; i_ < VPC / 8; ++i_) glds16(vsrc + toff_ + i_ * 64, (unsigned)__builtin_amdgcn_readfirstlane(lds0 + AV_OFF + (sl) * SLOT + (wid + 8 * i_) * 1024)); } while (0)
#define ATT_KT(i) (CAUSAL ? (NT - 1 - (i)) : (i))
    if (MODE == M_FOX) { const float* c2 = (const float*)(ws + WS_C2) + ((size_t)b * NHF + h) * SEQ; glds16(c2 + wid * 256 + lane * 4, (unsigned)__builtin_amdgcn_readfirstlane(lds0 + AC2_OFF + wid * 1024)); }
    ATT_ISSUE(ATT_KT(0), 0);
    if (NT > 1) ATT_ISSUE(ATT_KT(1), 1);
    bf16x8 qr[NQ];
    { const bf16* qp = Qg + (size_t)(wq0 + r32) * 512 + hi * 8;
#pragma unroll
      for (int d0 = 0; d0 < NQ; ++d0) qr[d0] = *(const bf16x8*)(qp + d0 * 16);
#pragma unroll
      for (int d0 = 0; d0 < NQ; ++d0) asm volatile("" : "+v"(qr[d0])); }
    f32x16 o[NDB];
#pragma unroll
    for (int d = 0; d < NDB; ++d)
#pragma unroll
        for (int r = 0; r < 16; ++r) o[d][r] = 0.f;
    float m_run = NEG, l_run = 0.f, s_run = 1.0f;
    const int qabs = wq0 + r32;
    const lds_cptr L3 = (lds_cptr)L;
    const lds_cptr kp0 = L3 + AK_OFF + (comp * 8 + hi) * 1024 + r32 * 16;
    const lds_cptr vp0 = L3 + AV_OFF + ((lane >> 4) & 1) * 32 + (lane & 3) * 8 + (4 * hi + ((lane & 15) >> 2)) * 64;
    int sl = 0;
    for (int i = 0; i < NT; ++i) {
        if (i + 1 < NT) asm volatile("s_waitcnt vmcnt(%0) lgkmcnt(0)\n\ts_barrier" :: "n"(NPT) : "memory");
        else asm volatile("s_waitcnt vmcnt(0) lgkmcnt(0)\n\ts_barrier" ::: "memory");
        if (MODE == M_SB) { if (i > 0) {
            const LAS u32x4_t* fp = (const LAS u32x4_t*)(L + AFL_OFF + ((i - 1) & 1) * 32); const u32x4_t f0 = fp[0], f1 = fp[1];
            if (__builtin_amdgcn_readfirstlane((int)((f0.x | f0.y) | (f0.z | f0.w) | (f1.x | f1.y) | (f1.z | f1.w))) == 0) break; } }
        if (i + 2 < NT) { const int sl2 = (sl >= 1) ? sl - 1 : 2; ATT_ISSUE(ATT_KT(i + 2), sl2); }
        const int kt = ATT_KT(i);
        const bool active = !CAUSAL || (kt * 64 <= wq0 + 31);
        if (active) {
            f32x16 p0, p1;
            bf16x8 kf[8];
            const lds_cptr kp = kp0 + sl * SLOT;
#pragma unroll
            for (int d0 = 0; d0 < 4; ++d0) { kf[2 * d0] = *(const LAS bf16x8*)(kp + d0 * 2048); kf[2 * d0 + 1] = *(const LAS bf16x8*)(kp + d0 * 2048 + 512); }
            if (MODE == M_FOX) { const LAS float* cp = (const LAS float*)(L + AC2_OFF) + kt * 64 + 4 * hi;
#pragma unroll
                for (int g = 0; g < 4; ++g) { const f32x4 c0 = *(const LAS f32x4*)(cp + 8 * g), c1 = *(const LAS f32x4*)(cp + 32 + 8 * g);
#pragma unroll
                    for (int j = 0; j < 4; ++j) { p0[4 * g + j] = c0[j]; p1[4 * g + j] = c1[j]; } } }
            else {
#pragma unroll
                for (int r = 0; r < 16; ++r) { p0[r] = 0.f; p1[r] = 0.f; } }
            const bool near = (MODE == M_DIFF) && (kt * 64 > wq0 - 176);
            SBAR();
#pragma unroll
            for (int d0 = 0; d0 < 4; ++d0) { p0 = __builtin_amdgcn_mfma_f32_32x32x16_bf16(kf[2 * d0], qr[d0], p0, 0, 0, 0); p1 = __builtin_amdgcn_mfma_f32_32x32x16_bf16(kf[2 * d0 + 1], qr[d0], p1, 0, 0, 0); }
            if (NQ > 4) { SBAR();
#pragma unroll
                for (int d0 = 0; d0 < 4; ++d0) { kf[2 * d0] = *(const LAS bf16x8*)(kp + (d0 + 4) * 2048); kf[2 * d0 + 1] = *(const LAS bf16x8*)(kp + (d0 + 4) * 2048 + 512); }
                SBAR();
#pragma unroll
                for (int d0 = 0; d0 < 4; ++d0) { p0 = __builtin_amdgcn_mfma_f32_32x32x16_bf16(kf[2 * d0], qr[NQ > 4 ? d0 + 4 : d0], p0, 0, 0, 0); p1 = __builtin_amdgcn_mfma_f32_32x32x16_bf16(kf[2 * d0 + 1], qr[NQ > 4 ? d0 + 4 : d0], p1, 0, 0, 0); } }
            SBAR();
            s16x4 vlo[4 * NDB], vhi[4 * NDB];
            { const lds_cptr vp = vp0 + sl * SLOT;
#pragma unroll
              for (int d = 0; d < NDB; ++d)
#pragma unroll
                for (int ks = 0; ks < 4; ++ks) { vlo[4 * d + ks] = vtr(vp + d * 4096 + ks * 1024); vhi[4 * d + ks] = vtr(vp + d * 4096 + ks * 1024 + 512); } }
            SBAR();
            unsigned pw[16];
            if (MODE == M_SB) {
                if (kt * 64 + 63 >= wq0) { const int kb = kt * 64 + 4 * hi;
#pragma unroll
                    for (int r = 0; r < 16; ++r) { const int kv = kb + kcol(r); if (kv >= qabs) p0[r] = NEG; if (kv + 32 >= qabs) p1[r] = NEG; } }
                f32x16 l0, l1;
#pragma unroll
                for (int r = 0; r < 16; ++r) { l0[r] = __builtin_amdgcn_rcpf(1.0f + ex2(p0[r])); l1[r] = __builtin_amdgcn_rcpf(1.0f + ex2(p1[r])); }
#pragma unroll
                for (int hf = 1; hf >= 0; --hf)
#pragma unroll
                    for (int g = 3; g >= 0; --g) {
                        const float a0 = hf ? l1[4 * g] : l0[4 * g], a1 = hf ? l1[4 * g + 1] : l0[4 * g + 1], a2 = hf ? l1[4 * g + 2] : l0[4 * g + 2], a3 = hf ? l1[4 * g + 3] : l0[4 * g + 3];
                        const float town = (a0 * a1) * (a2 * a3);
                        const auto sw = __builtin_amdgcn_permlane32_swap(__float_as_uint(town), __float_as_uint(town), false, false);
                        const float v0 = __uint_as_float(sw[0]), v1 = __uint_as_float(sw[1]);
                        const float t3 = s_run * (hi ? 1.0f : v1), t2 = t3 * a3, t1 = t2 * a2, t0 = t1 * a1;
                        const float w0 = (1.0f - a0) * t0, w1 = (1.0f - a1) * t1, w2 = (1.0f - a2) * t2, w3 = (1.0f - a3) * t3;
                        pw[hf * 8 + g * 2] = cvtpk(w0, w1); pw[hf * 8 + g * 2 + 1] = cvtpk(w2, w3);
                        s_run *= v0 * v1;
                    }
            } else {
                if (MODE == M_DIFF) { if (near) { const LAS float* tp = (const LAS float*)(L + ATB_OFF) + h * TBN + (223 - (wq0 - kt * 64 + r32 - 4 * hi));
#pragma unroll
                    for (int r = 0; r < 16; ++r) { p0[r] += tp[kcol(r)]; p1[r] += tp[32 + kcol(r)]; } } }
                if (CAUSAL) { if (kt * 64 + 63 > wq0) { const int kb = kt * 64 + 4 * hi;
#pragma unroll
                    for (int r = 0; r < 16; ++r) { const int kv = kb + kcol(r); if (kv > qabs) p0[r] = NEG; if (kv + 32 > qabs) p1[r] = NEG; } } }
                float ra = fmaxf(fmaxf(p0[0], p0[1]), p1[0]), rb = fmaxf(fmaxf(p0[2], p0[3]), p1[1]); ra = fmaxf(fmaxf(ra, p1[2]), p1[3]);
#pragma unroll
                for (int r = 4; r < 16; r += 4) { ra = fmaxf(fmaxf(ra, p0[r]), p0[r + 1]); rb = fmaxf(fmaxf(rb, p0[r + 2]), p0[r + 3]); ra = fmaxf(fmaxf(ra, p1[r]), p1[r + 1]); rb = fmaxf(fmaxf(rb, p1[r + 2]), p1[r + 3]); }
                const float rm = xmax(fmaxf(ra, rb));
                const float mn = fmaxf(m_run, rm);
                if (__any(mn > m_run)) { const float al = ex2(m_run - mn); l_run *= al; m_run = mn;
#pragma unroll
                    for (int d = 0; d < NDB; ++d)
#pragma unroll
                        for (int r = 0; r < 16; ++r) o[d][r] *= al; }
                float sa = 0.f, sb = 0.f;
#pragma unroll
                for (int r = 0; r < 16; ++r) { p0[r] = ex2(p0[r] - m_run); p1[r] = ex2(p1[r] - m_run); sa += p0[r]; sb += p1[r]; }
                l_run += sa + sb;
#pragma unroll
                for (int w = 0; w < 8; ++w) { pw[w] = cvtpk(p0[2 * w], p0[2 * w + 1]); pw[8 + w] = cvtpk(p1[2 * w], p1[2 * w + 1]); }
            }
            SBAR();
#pragma unroll
            for (int ks = 0; ks < 4; ++ks) { const u32x4_t pf = (u32x4_t){pw[4 * ks], pw[4 * ks + 1], pw[4 * ks + 2], pw[4 * ks + 3]};
#pragma unroll
                for (int d = 0; d < NDB; ++d) { const s16x4 lo = vlo[4 * d + ks], hh = vhi[4 * d + ks];
                    const bf16x8 vf = (bf16x8){lo[0], lo[1], lo[2], lo[3], hh[0], hh[1], hh[2], hh[3]};
                    o[d] = __builtin_amdgcn_mfma_f32_32x32x16_bf16(vf, __builtin_bit_cast(bf16x8, pf), o[d], 0, 0, 0); } }
        }
        if (MODE == M_SB) { const bool alive = !active || __any(s_run != 0.0f);
            if (lane == 0) ((LAS unsigned*)(L + AFL_OFF + (i & 1) * 32))[wid] = alive ? 1u : 0u; }
        sl = (sl == 2) ? 0 : sl + 1;
    }
    if (MODE == M_SB) asm volatile("s_waitcnt vmcnt(0)" ::: "memory");
    if (MODE != M_SB) { const float il = 1.0f / xsum(l_run);
#pragma unroll
        for (int d = 0; d < NDB; ++d)
#pragma unroll
            for (int r = 0; r < 16; ++r) o[d][r] *= il; }
    if (MODE == M_DIFF) {
        asm volatile("s_waitcnt lgkmcnt(0)\n\ts_barrier" ::: "memory");
        LAS float* X = (LAS float*)(L + AX_OFF) + wrow * 4096 + lane;
        if (comp == 1) {
#pragma unroll
            for (int d = 0; d < NDB; ++d)
#pragma unroll
                for (int r = 0; r < 16; ++r) X[(d * 16 + r) * 64] = o[d][r] * lam; }
        asm volatile("s_waitcnt lgkmcnt(0)\n\ts_barrier" ::: "memory");
        if (comp == 0) { float ss = 0.f;
#pragma unroll
            for (int d = 0; d < NDB; ++d)
#pragma unroll
                for (int r = 0; r < 16; ++r) { o[d][r] -= X[(d * 16 + r) * 64]; ss += o[d][r] * o[d][r]; }
            ss = xsum(ss);
            const float rn = (1.0f / sqrtf(ss * (1.0f / 128.0f) + EPS)) * (1.0f - lam_init);
            const float* gn = A->in[10] + layer * 128 + 4 * hi;
#pragma unroll
            for (int d = 0; d < NDB; ++d)
#pragma unroll
                for (int g = 0; g < 4; ++g) { const f32x4 gv = *(const f32x4*)(gn + 32 * d + 8 * g);
#pragma unroll
                    for (int j = 0; j < 4; ++j) o[d][4 * g + j] *= rn * gv[j]; } }
    }
    if (MODE != M_DIFF || comp == 0) {
        bf16* yrow = (bf16*)(A->ws + WS_Y) + (size_t)((size_t)b * SEQ + wq0 + r32) * 2048 + ycol + 4 * hi;
#pragma unroll
        for (int d = 0; d < NDB; ++d)
#pragma unroll
            for (int g = 0; g < 4; ++g) { uint2 u = *(const uint2*)(yrow + 32 * d + 8 * g);
                u.x = pk2(o[d][4 * g] * __uint_as_float(u.x << 16), o[d][4 * g + 1] * __uint_as_float(u.x & 0xffff0000u));
                u.y = pk2(o[d][4 * g + 2] * __uint_as_float(u.y << 16), o[d][4 * g + 3] * __uint_as_float(u.y & 0xffff0000u));
                *(uint2*)(yrow + 32 * d + 8 * g) = u; }
    }
    if (MODE == M_DIFF) asm volatile("s_waitcnt lgkmcnt(0)\n\ts_barrier" ::: "memory");
#undef ATT_ISSUE
#undef ATT_KT
}

constexpr int NU_MAIN = 192, NU_Q = 448;
struct UnitD { int mode, b, h, qb; };
__device__ __forceinline__ UnitD decode_unit(int x, int k) {
    UnitD u;
    if (k < NU_MAIN) { const int jj = k / 24, r = k % 24;
        if (r < 12)      { u.mode = M_DIFF; const int bh = 8 * jj + x;          u.b = bh >> 2; u.h = bh & 3; u.qb = 15 - r; }
        else if (r < 18) { u.mode = M_FOX; const int bh = 8 * (2 * jj) + x;     u.b = bh >> 3; u.h = bh & 7; u.qb = 7 - (r - 12); }
        else             { u.mode = M_FOX; const int bh = 8 * (2 * jj + 1) + x; u.b = bh >> 3; u.h = bh & 7; u.qb = 7 - (r - 18); }
        return u; }
    int r = k - NU_MAIN;
    if (r < 128) { u.mode = M_SB; const int bh = 8 * (r >> 3) + x; u.b = bh >> 3; u.h = bh & 7; u.qb = 7 - (r & 7); return u; } r -= 128;
    if (r < 8)  { u.mode = M_DIFF; const int bh = 8 * r + x; u.b = bh >> 2; u.h = bh & 3; u.qb = 3; return u; } r -= 8;
    if (r < 16) { u.mode = M_FOX; const int bh = 8 * r + x; u.b = bh >> 3; u.h = bh & 7; u.qb = 1; return u; } r -= 16;
    if (r < 8)  { u.mode = M_DIFF; const int bh = 8 * r + x; u.b = bh >> 2; u.h = bh & 3; u.qb = 2; return u; } r -= 8;
    if (r < 8)  { u.mode = M_DIFF; const int bh = 8 * r + x; u.b = bh >> 2; u.h = bh & 3; u.qb = 1; return u; } r -= 8;
    if (r < 16) { u.mode = M_FOX; const int bh = 8 * r + x; u.b = bh >> 3; u.h = bh & 7; u.qb = 0; return u; } r -= 16;
    if (r < 64) { u.mode = M_MEM; const int bh = 8 * (r >> 3) + x; u.b = bh >> 2; u.h = bh & 3; u.qb = r & 7; return u; } r -= 64;
    { u.mode = M_DIFF; const int bh = 8 * r + x; u.b = bh >> 2; u.h = bh & 3; u.qb = 0; return u; }
}
__device__ __forceinline__ void attn_phase(Frame& F0, int layer) {
    Frame F = F0; asm volatile("" : "+v"(F.lane), "+v"(F.tid));
    LAS unsigned char* L = F.lds;
    { LAS float* tb = (LAS float*)(L + ATB_OFF); const float* relb = F.a->in[11];
      for (int i = F.tid; i < 4 * TBN; i += NWAVES * 64) { const int h = i / TBN, j = i % TBN, dist = 223 - j; float v = 0.f;
          if (dist >= 0 && dist < 113) v = (relb[t5_bucket(dist) * 4 + h] - relb[31 * 4 + h]) * LOG2E;
          tb[i] = v; } }
    float lam_init, lam;
    { const float* dl = F.a->in[9] + layer * 256; const float s1 = wave_sum(dl[F.lane] * dl[64 + F.lane]), s2 = wave_sum(dl[128 + F.lane] * dl[192 + F.lane]);
      lam_init = 0.8f - 0.6f * expf(-0.3f * (float)layer); lam = expf(s1) - expf(s2) + lam_init; }
    if (F.wave >= 4) __builtin_amdgcn_s_setprio(1);
    const int x0 = (int)(xb_xcc_id() & 7u);
    for (int xi = 0; xi < 8; ++xi) {
        const int x = (x0 + xi) & 7;
        gu32* qh = F.ctl + CW_QUEUE + 64 * (layer * 8 + x);
        for (;;) {
            if (F.tid == 0) *(volatile LAS unsigned*)(L + AQW_OFF) = __hip_atomic_fetch_add(qh, 1u, __ATOMIC_RELAXED, __HIP_MEMORY_SCOPE_AGENT);
            __syncthreads();
            const int k = __builtin_amdgcn_readfirstlane((int)*(volatile LAS unsigned*)(L + AQW_OFF));
            if (k >= NU_Q) break;
            const UnitD u = decode_unit(x, k);
            if (u.mode == M_SB) attn_unit<M_SB>(F.a, L, u.b, u.h, u.qb, layer, lam, lam_init);
            else if (u.mode == M_FOX) attn_unit<M_FOX>(F.a, L, u.b, u.h, u.qb, layer, lam, lam_init);
            else if (u.mode == M_DIFF) attn_unit<M_DIFF>(F.a, L, u.b, u.h, u.qb, layer, lam, lam_init);
            else attn_unit<M_MEM>(F.a, L, u.b, u.h, u.qb, layer, lam, lam_init);
        }
        __syncthreads();
    }
    __builtin_amdgcn_s_setprio(0);
}
#undef SBAR
}


constexpr int N_PHASES = 9;
#ifndef MK_ONE_LAUNCH
#define MK_ONE_LAUNCH 1
#endif
#ifndef MK_NAIVE_ATTN
#define MK_NAIVE_ATTN 0
#endif
__global__ void __launch_bounds__(NWAVES * 64, 2) mega_fwd(Args args) {
    extern __shared__ __attribute__((aligned(16))) unsigned char lds[];
    Frame F;
    F.lds = (LAS unsigned char*)lds;
    F.MISC = (volatile LAS unsigned*)(F.lds + MISC_OFF);
    F.tid = threadIdx.x; F.lane = F.tid & 63; F.wave = __builtin_amdgcn_readfirstlane(F.tid >> 6);
    F.G = gridDim.x; { const int bx = blockIdx.x; F.vcu = (F.G % 8 == 0) ? (bx % 8) * (F.G / 8) + bx / 8 : bx; }
    F.a = &args; F.ctl = (gu32*)(args.ws + WS_CTL);
    for (int u = F.tid; u < (LDS_BYTES - LDSCTL_OFF) / 4; u += NWAVES * 64) ((LAS unsigned*)(F.lds + LDSCTL_OFF))[u] = 0u;
    __syncthreads();
    XcdBarrier bar; bar.bar = (unsigned*)(F.ctl + CW_BAR); bar.x = 0; bar.st = nullptr;
    if (MK_ONE_LAUNCH) bar = xcd_barrier_post((unsigned*)(F.ctl + CW_BAR), F.MISC + 8);
    const int lo = args.ph_lo, hi = args.ph_hi;
#define IN(k) (lo <= (k) && (k) < hi)
#define SEAM(k) do { if (IN(k) && IN((k) + 1)) xcd_barrier(bar); } while (0)
    for (int l = 0; l < 2; ++l) {
        if (IN(4 * l + 0)) { p0_weights(F, l); p0_mem_rows(F, l); p0_rows(F, l); }
        SEAM(4 * l + 0);
        if (IN(4 * l + 1)) {
            cumsum_logf(F);
            { pg8::Gemm g{(const bf16*)F_OUT(F) + 1024, (const bf16*)(F_WS(F) + WS_WIN), MROWS, NPROJ, DMODEL, 2048}; pg8::StaticOrder S; S.init(MROWS, NPROJ, F.G, (int)blockIdx.x);
              pg8::EpiProj E{(bf16*)(F_WS(F) + WS_PROJ), (bf16*)(F_WS(F) + WS_Y), SEG_BYTES / 2};
              pg8::gemm_phase<pg8::EpiProj, pg8::StaticOrder, true, true>(F.lds, g, S, E); }
            { pg8::Gemm g{(const bf16*)(F_WS(F) + WS_HM), (const bf16*)(F_WS(F) + WS_WMKV), MMEM, 1024, DMODEL, DMODEL}; pg8::StaticOrder S; S.init(MMEM, 1024, F.G, (int)blockIdx.x);
              pg8::EpiBf16 E{(bf16*)(F_WS(F) + WS_MKV), 1024};
              pg8::gemm_phase<pg8::EpiBf16, pg8::StaticOrder, true, true>(F.lds, g, S, E); }
        }
        SEAM(4 * l + 1);
        if (IN(4 * l + 2)) att::attn_phase(F, l);
        SEAM(4 * l + 2);
        if (IN(4 * l + 3)) {
            pg8::Gemm g{(const bf16*)(F_WS(F) + WS_Y), (const bf16*)(F_WS(F) + WS_WOUT), MROWS, DMODEL, DMIX, DMIX}; pg8::StaticOrder S; S.init(MROWS, DMODEL, F.G, (int)blockIdx.x);
            pg8::EpiBf16 E{(bf16*)(F_WS(F) + WS_OG), DMODEL};
            pg8::gemm_phase<pg8::EpiBf16, pg8::StaticOrder, true, true>(F.lds, g, S, E);
        }
        SEAM(4 * l + 3);
    }
    if (IN(8)) p0_rows(F, 2);
#undef IN
#undef SEAM
}

extern "C" void kernel_launch(void* const* d_in, const int* in_sizes, int n_in, void* d_out, int out_size, void* d_ws, size_t ws_size, hipStream_t stream) {
    static int grid = 0;
    if (grid == 0) {
        if (n_in != 12 || out_size != MROWS * DMODEL || ws_size < WS_END) { fprintf(stderr, "kernel_launch: unexpected shapes (n_in %d out %d ws %zu)\n", n_in, out_size, ws_size); grid = -1; return; }
        int dev = 0, cus = 0, per_cu = 0;
        if (hipGetDevice(&dev) != hipSuccess || hipDeviceGetAttribute(&cus, hipDeviceAttributeMultiprocessorCount, dev) != hipSuccess) { grid = -1; return; }
        if (hipFuncSetAttribute((const void*)mega_fwd, hipFuncAttributeMaxDynamicSharedMemorySize, LDS_BYTES) != hipSuccess) { fprintf(stderr, "kernel_launch: hipFuncSetAttribute failed\n"); grid = -1; return; }
        if (hipOccupancyMaxActiveBlocksPerMultiprocessor(&per_cu, (const void*)mega_fwd, NWAVES * 64, LDS_BYTES) != hipSuccess || per_cu < 1) fprintf(stderr, "kernel_launch: occupancy query says %d\n", per_cu);
        (void)hipGetLastError();
        grid = cus;
    }
    if (grid < 0) return;
    (void)hipMemsetAsync((char*)d_ws + WS_CTL, 0, CTL_ZERO_BYTES, stream);
    Args a{};
    for (int i = 0; i < 12; ++i) a.in[i] = (const float*)d_in[i];
    a.out = (float*)d_out; a.ws = (unsigned char*)d_ws;
#if MK_ONE_LAUNCH
    a.ph_lo = 0; a.ph_hi = N_PHASES;
    hipLaunchKernelGGL(mega_fwd, dim3(grid), dim3(NWAVES * 64), LDS_BYTES, stream, a);
#else
    for (int p = 0; p < N_PHASES; ++p) {
        if (MK_NAIVE_ATTN && (p == 2 || p == 6)) {
            NArgs na{}; na.ws = (const unsigned char*)d_ws; na.wsw = (unsigned char*)d_ws; na.diff_lambda = (const float*)d_in[9]; na.diff_head_norm = (const float*)d_in[10]; na.rel_bias = (const float*)d_in[11]; na.layer = p / 4;
            hipLaunchKernelGGL(naive_diff, dim3(BATCH * 4 * 8), dim3(256), 0, stream, na);
            hipLaunchKernelGGL(naive_sb, dim3(BATCH * 8 * 8), dim3(256), 0, stream, na);
            hipLaunchKernelGGL(naive_fox, dim3(BATCH * 8 * 8), dim3(256), 0, stream, na);
            hipLaunchKernelGGL(naive_mem, dim3(BATCH * 4 * 8), dim3(256), 0, stream, na);
            continue;
        }
        a.ph_lo = p; a.ph_hi = p + 1;
        hipLaunchKernelGGL(mega_fwd, dim3(grid), dim3(NWAVES * 64), LDS_BYTES, stream, a);
    }
#endif
}
```

```cpp
#include <hip/hip_runtime.h>
#include <cstdio>
#include <cstdint>
#define PG8_TRANSPOSED 1
namespace pg8 {
#define PG8_LAS __attribute__((address_space(3)))
typedef unsigned short bf16_t;
typedef short bf16x8 __attribute__((ext_vector_type(8)));
typedef float f32x4 __attribute__((ext_vector_type(4)));
typedef unsigned u32x4 __attribute__((ext_vector_type(4)));
constexpr int BM = 256, BK = 64, HALF = 128, HTB = HALF * BK * 2  , STAGE_BYTES = 8 * HTB, NXCD = 8, WGM = 4;

__host__ __device__ __forceinline__ int lds_byte(int r, int c) { const int st = (r >> 4) * 2 + (c >> 5), rr = r & 15, cc = c & 31, ob = rr * 64 + cc * 2; return st * 1024 + (ob ^ (((ob >> 9) & 1) << 5)); }
__host__ __device__ __forceinline__ void stage_rc(int b, int& R, int& C) { const int st = b / 1024, sb = b % 1024, swz = sb ^ (((sb >> 9) & 1) << 5); R = (st >> 1) * 16 + swz / 64; C = (st & 1) * 32 + (swz % 64) / 2; }
__host__ __device__ __forceinline__ int perm32(int rho) { const int n = rho >> 4, i = rho & 15; return 8 * (i >> 2) + 4 * n + (i & 3); }

struct Unit { int pm, pn; };
struct Gemm { const bf16_t* A; const bf16_t* Bt; int M, N, K, lda; };

struct StaticOrder {
    int nM, nN, nwg, G, c;
    __host__ __device__ void init(int M, int N, int G_, int c_) { nM = M / BM; nN = N / BM; nwg = nM * nN; G = G_; c = c_; }
    __host__ __device__ bool next(int i, Unit& u) const {
        const long L = (long)i * G + c; if (L >= nwg) return false;
        int wgid = (int)L; { const int q = nwg / NXCD, r = nwg % NXCD, xcd = wgid % NXCD, off = wgid / NXCD; wgid = (xcd < r ? xcd * (q + 1) : r * (q + 1) + (xcd - r) * q) + off; }
#if PG8_TRANSPOSED
        const int nig = WGM * nM, gid = wgid / nig, fn = gid * WGM, gsz = (nN - fn) < WGM ? (nN - fn) : WGM;
        u.pn = fn + ((wgid % nig) % gsz); u.pm = (wgid % nig) / gsz; return true;
#else
        const int nig = WGM * nN, gid = wgid / nig, fm = gid * WGM, gsz = (nM - fm) < WGM ? (nM - fm) : WGM;
        u.pm = fm + ((wgid % nig) % gsz); u.pn = (wgid % nig) / gsz; return true;
#endif
    }
    __device__ __forceinline__ void a_ready(const Unit&) const {}
    __device__ __forceinline__ void done(const Unit&) const {}
};

__device__ __forceinline__ unsigned cvt_pk_bf16(float lo, float hi) { unsigned r; asm volatile("v_cvt_pk_bf16_f32 %0, %1, %2" : "=v"(r) : "v"(lo), "v"(hi)); return r; }

struct EpiBf16 {
    static constexpr bool PERM = true, AFTER_DRAIN = false;
    bf16_t* O; int ldc;
    __device__ __forceinline__ void operator()(const f32x4 (&acc)[2][2][4][2], const Unit& u, int wr, int wc, int fr, int fq) const {
        const int row0 = u.pm * BM + wr * 64 + fr; const int col0 = u.pn * BM + wc * 32 + 8 * fq;
#pragma unroll
        for (int ai = 0; ai < 2; ++ai)
#pragma unroll
            for (int m = 0; m < 4; ++m) { bf16_t* rowp = O + (size_t)(row0 + ai * HALF + m * 16) * ldc + col0;
#pragma unroll
                for (int bj = 0; bj < 2; ++bj) { const f32x4 v0 = acc[ai][bj][m][0], v1 = acc[ai][bj][m][1];
                    u32x4 w; w.x = cvt_pk_bf16(v0[0], v0[1]); w.y = cvt_pk_bf16(v0[2], v0[3]); w.z = cvt_pk_bf16(v1[0], v1[1]); w.w = cvt_pk_bf16(v1[2], v1[3]);
                    *(u32x4*)(rowp + bj * HALF) = w; } }
    }
};
__device__ __forceinline__ float silu_f(float v) { return v * __builtin_amdgcn_rcpf(1.0f + __builtin_amdgcn_exp2f(-1.4426950408889634f * v)); }
struct EpiProj {
    static constexpr bool PERM = true, AFTER_DRAIN = false;
    bf16_t* proj; bf16_t* y; size_t seg_stride;
    __device__ __forceinline__ void operator()(const f32x4 (&acc)[2][2][4][2], const Unit& u, int wr, int wc, int fr, int fq) const {
        const int row0 = u.pm * BM + wr * 64 + fr; const int colt = u.pn * BM; const bool gate = colt >= 5120;
        bf16_t* base; int ldc, col0;
        if (gate) { base = y; ldc = 2048; col0 = colt - 5120 + wc * 32 + 8 * fq; }
        else { base = proj + (size_t)(colt >> 9) * seg_stride; ldc = 512; col0 = (colt & 511) + wc * 32 + 8 * fq; }
#pragma unroll
        for (int ai = 0; ai < 2; ++ai)
#pragma unroll
            for (int m = 0; m < 4; ++m) { bf16_t* rowp = base + (size_t)(row0 + ai * HALF + m * 16) * ldc + col0;
#pragma unroll
                for (int bj = 0; bj < 2; ++bj) { f32x4 v0 = acc[ai][bj][m][0], v1 = acc[ai][bj][m][1];
                    if (gate) {
#pragma unroll
                        for (int e = 0; e < 4; ++e) { v0[e] = silu_f(v0[e]); v1[e] = silu_f(v1[e]); } }
                    u32x4 w; w.x = cvt_pk_bf16(v0[0], v0[1]); w.y = cvt_pk_bf16(v0[2], v0[3]); w.z = cvt_pk_bf16(v1[0], v1[1]); w.w = cvt_pk_bf16(v1[2], v1[3]);
                    *(u32x4*)(rowp + bj * HALF) = w; } }
    }
};
struct EpiF32 {
    static constexpr bool PERM = false, AFTER_DRAIN = false;
    float* O; int ldc;
    __device__ __forceinline__ void operator()(const f32x4 (&acc)[2][2][4][2], const Unit& u, int wr, int wc, int fr, int fq) const {
        const int col0 = u.pn * BM + wc * 32 + 4 * fq;
#pragma unroll
        for (int ai = 0; ai < 2; ++ai)
#pragma unroll
            for (int m = 0; m < 4; ++m) { float* rowp = O + (size_t)(u.pm * BM + ai * HALF + wr * 64 + m * 16 + fr) * ldc + col0;
#pragma unroll
                for (int bj = 0; bj < 2; ++bj)
#pragma unroll
                    for (int n = 0; n < 2; ++n) *(f32x4*)(rowp + bj * HALF + n * 16) = acc[ai][bj][m][n]; }
    }
};

template <class Epi, class Sched, bool ALIGN_EPI = false, bool SP2 = false>
__device__ __forceinline__ void gemm_phase(PG8_LAS unsigned char* lds, const Gemm g, const Sched& S, const Epi& E) {
    int tid_ = threadIdx.x; asm volatile("" : "+v"(tid_));
    const int tid = tid_, wid = __builtin_amdgcn_readfirstlane(tid >> 6), lane = tid & 63, wr = wid >> 2, wc = wid & 3, fr = lane & 15, fq = lane >> 4;
    const int K = g.K, nt = K / BK;
    unsigned voffA[2], voffB[2];
#pragma unroll
    for (int i = 0; i < 2; ++i) { int R, C; stage_rc(tid * 16 + i * 8192, R, C); const int Rb = Epi::PERM ? ((R & ~31) + perm32(R & 31)) : R;
        voffA[i] = (unsigned)(R * g.lda + C) * 2u; voffB[i] = (unsigned)(Rb * K + C) * 2u; }
    const size_t kstep = (size_t)(BK * 2);
    const size_t hstepA = (size_t)HALF * g.lda * 2, hstepB = (size_t)HALF * K * 2;
    const size_t tstepA = 2 * hstepA, tstepB = 2 * hstepB;
    const unsigned ldsw = (unsigned)wid * 1024u;
    const int aoff = lds_byte(wr * 64 + fr, fq * 8), boff = lds_byte(wc * 32 + fr, fq * 8);
#define PG8_SA(b, h) (((b) * 2 + (h)) * HTB)
#define PG8_SB(b, h) ((4 + (b) * 2 + (h)) * HTB)
#define PG8_STAGE(bufoff, gbase, voff) do { _Pragma("unroll") for (int _i = 0; _i < 2; ++_i) \
        __builtin_amdgcn_global_load_lds((const unsigned*)((const char*)(gbase) + (voff)[_i]), (PG8_LAS unsigned*)(lds + (bufoff) + ldsw + _i * 8192), 16, 0, 0); } while (0)
#define PG8_LDA(dst, b, h) do { _Pragma("unroll") for (int m = 0; m < 4; ++m) _Pragma("unroll") for (int k = 0; k < 2; ++k) dst[m][k] = *(const PG8_LAS bf16x8*)(lds + PG8_SA(b, h) + aoff + m * 2048 + k * 1024); } while (0)
#define PG8_LDB(dst, b, h) do { _Pragma("unroll") for (int n = 0; n < 2; ++n) _Pragma("unroll") for (int k = 0; k < 2; ++k) dst[n][k] = *(const PG8_LAS bf16x8*)(lds + PG8_SB(b, h) + boff + n * 2048 + k * 1024); } while (0)
#define PG8_MMA(ai, bj, At, Bt) do { __builtin_amdgcn_s_setprio(1); _Pragma("unroll") for (int m = 0; m < 4; ++m) _Pragma("unroll") for (int n = 0; n < 2; ++n) _Pragma("unroll") for (int k = 0; k < 2; ++k) \
        acc[ai][bj][m][n] = __builtin_amdgcn_mfma_f32_16x16x32_bf16(Bt[n][k], At[m][k], acc[ai][bj][m][n], 0, 0, 0); __builtin_amdgcn_s_setprio(0); } while (0)
#define PG8_WAIT_V(n) asm volatile("s_waitcnt vmcnt(" #n ")" ::: "memory")
#define PG8_WAIT_L(n) asm volatile("s_waitcnt lgkmcnt(" #n ")" ::: "memory")
#define PG8_BAR __builtin_amdgcn_s_barrier()
#define PG8_SCHED __builtin_amdgcn_sched_barrier(0)
    Unit cur, nxt; int ui = 0;
    if (!S.next(0, cur)) return;
    f32x4 acc[2][2][4][2];
#pragma unroll
    for (int a = 0; a < 2; ++a)
#pragma unroll
        for (int b = 0; b < 2; ++b)
#pragma unroll
            for (int m = 0; m < 4; ++m)
#pragma unroll
                for (int n = 0; n < 2; ++n) acc[a][b][m][n] = (f32x4){0.f, 0.f, 0.f, 0.f};
    bf16x8 At[4][2], B0[2][2], B1[2][2];
    const char* cA = (const char*)g.A + (size_t)cur.pm * tstepA; const char* cB = (const char*)g.Bt + (size_t)cur.pn * tstepB;
    S.a_ready(cur);
    if constexpr (SP2) {
        PG8_STAGE(PG8_SB(0, 0), cB, voffB); PG8_STAGE(PG8_SB(0, 1), cB + hstepB, voffB); PG8_STAGE(PG8_SA(0, 0), cA, voffA); PG8_STAGE(PG8_SA(0, 1), cA + hstepA, voffA);
        if (wr == 1) PG8_BAR;
        PG8_WAIT_V(2); PG8_BAR;
        PG8_STAGE(PG8_SB(1, 0), cB + kstep, voffB); PG8_STAGE(PG8_SA(1, 0), cA + kstep, voffA); PG8_STAGE(PG8_SB(1, 1), cB + hstepB + kstep, voffB);
        PG8_WAIT_V(6); PG8_BAR;
    } else {
        PG8_STAGE(PG8_SB(0, 0), cB, voffB); PG8_STAGE(PG8_SA(0, 0), cA, voffA); PG8_STAGE(PG8_SB(0, 1), cB + hstepB, voffB); PG8_STAGE(PG8_SA(0, 1), cA + hstepA, voffA);
        if (wr == 1) PG8_BAR;
        PG8_WAIT_V(4); PG8_BAR;
        PG8_STAGE(PG8_SB(1, 0), cB + kstep, voffB); PG8_STAGE(PG8_SA(1, 0), cA + kstep, voffA); PG8_STAGE(PG8_SB(1, 1), cB + hstepB + kstep, voffB);
        PG8_WAIT_V(6); PG8_BAR;
    }
    for (;;) {
        const bool has_next = S.next(ui + 1, nxt);
        const char* nA = has_next ? (const char*)g.A + (size_t)nxt.pm * tstepA : cA; const char* nB = has_next ? (const char*)g.Bt + (size_t)nxt.pn * tstepB : cB;
        for (int t = 0; t < nt; t += 2) {
            const bool last = (t == nt - 2);
            const char* a1 = cA + (size_t)(t + 1) * kstep;
            const char* a2 = last ? nA : cA + (size_t)(t + 2) * kstep; const char* b2 = last ? nB : cB + (size_t)(t + 2) * kstep;
            const char* a3 = a2 + kstep; const char* b3 = b2 + kstep;
            if (last && has_next) S.a_ready(nxt);
            if constexpr (SP2) {
            PG8_LDB(B0, 0, 0); PG8_LDB(B1, 0, 1); PG8_SCHED; PG8_LDA(At, 0, 0); PG8_STAGE(PG8_SA(1, 1), a1 + hstepA, voffA);
            PG8_WAIT_V(8); PG8_WAIT_L(0); PG8_BAR; PG8_MMA(0, 0, At, B0); PG8_MMA(0, 1, At, B1); PG8_BAR; PG8_SCHED;
            PG8_LDA(At, 0, 1); PG8_STAGE(PG8_SB(0, 0), b2, voffB); PG8_STAGE(PG8_SB(0, 1), b2 + hstepB, voffB); PG8_STAGE(PG8_SA(0, 0), a2, voffA);
            PG8_WAIT_V(8); PG8_WAIT_L(0); PG8_BAR; PG8_MMA(1, 0, At, B0); PG8_MMA(1, 1, At, B1); PG8_BAR; PG8_SCHED;
            PG8_LDB(B0, 1, 0); PG8_LDB(B1, 1, 1); PG8_SCHED; PG8_LDA(At, 1, 0); PG8_STAGE(PG8_SA(0, 1), a2 + hstepA, voffA);
            PG8_WAIT_V(8); PG8_WAIT_L(0); PG8_BAR; PG8_MMA(0, 0, At, B0); PG8_MMA(0, 1, At, B1); PG8_BAR; PG8_SCHED;
            PG8_LDA(At, 1, 1); PG8_STAGE(PG8_SB(1, 0), b3, voffB); PG8_STAGE(PG8_SB(1, 1), b3 + hstepB, voffB); PG8_STAGE(PG8_SA(1, 0), a3, voffA);
            PG8_WAIT_V(8); PG8_WAIT_L(0); PG8_BAR; PG8_MMA(1, 0, At, B0); PG8_MMA(1, 1, At, B1); PG8_BAR; PG8_SCHED;
            } else {
            PG8_LDB(B0, 0, 0); PG8_SCHED; PG8_LDA(At, 0, 0); PG8_STAGE(PG8_SA(1, 1), a1 + hstepA, voffA);
            PG8_WAIT_L(8); PG8_BAR; PG8_WAIT_L(0); PG8_MMA(0, 0, At, B0); PG8_BAR; PG8_SCHED;
            PG8_LDB(B1, 0, 1); PG8_STAGE(PG8_SB(0, 0), b2, voffB);
            PG8_BAR; PG8_WAIT_L(0); PG8_MMA(0, 1, At, B1); PG8_BAR;
            PG8_LDA(At, 0, 1); PG8_STAGE(PG8_SA(0, 0), a2, voffA);
            PG8_BAR; PG8_WAIT_L(0); PG8_MMA(1, 0, At, B0); PG8_BAR; PG8_SCHED;
            PG8_STAGE(PG8_SB(0, 1), b2 + hstepB, voffB);
            PG8_WAIT_V(6); PG8_BAR; PG8_MMA(1, 1, At, B1); PG8_BAR;
            PG8_LDB(B0, 1, 0); PG8_SCHED; PG8_LDA(At, 1, 0); PG8_STAGE(PG8_SA(0, 1), a2 + hstepA, voffA);
            PG8_WAIT_L(8); PG8_BAR; PG8_WAIT_L(0); PG8_MMA(0, 0, At, B0); PG8_BAR; PG8_SCHED;
            PG8_LDB(B1, 1, 1); PG8_STAGE(PG8_SB(1, 0), b3, voffB);
            PG8_BAR; PG8_WAIT_L(0); PG8_MMA(0, 1, At, B1); PG8_BAR;
            PG8_LDA(At, 1, 1); PG8_STAGE(PG8_SA(1, 0), a3, voffA);
            PG8_BAR; PG8_WAIT_L(0); PG8_MMA(1, 0, At, B0); PG8_BAR; PG8_SCHED;
            PG8_STAGE(PG8_SB(1, 1), b3 + hstepB, voffB);
            PG8_WAIT_V(6); PG8_BAR; PG8_MMA(1, 1, At, B1); PG8_BAR;
            }
        }
        if constexpr (ALIGN_EPI) { if (wr == 0) PG8_BAR; }
        if constexpr (!Epi::AFTER_DRAIN) { E(acc, cur, wr, wc, fr, fq); S.done(cur); }
        if (!has_next) break;
#pragma unroll
        for (int a = 0; a < 2; ++a)
#pragma unroll
            for (int b = 0; b < 2; ++b)
#pragma unroll
                for (int m = 0; m < 4; ++m)
#pragma unroll
                    for (int n = 0; n < 2; ++n) acc[a][b][m][n] = (f32x4){0.f, 0.f, 0.f, 0.f};
        cur = nxt; cA = nA; cB = nB; ++ui;
        if constexpr (ALIGN_EPI) { if (wr == 1) PG8_BAR; }
    }
    PG8_WAIT_V(0);
    if constexpr (!ALIGN_EPI) { if (wr == 0) PG8_BAR; }
    PG8_BAR;
    if constexpr (Epi::AFTER_DRAIN) { E.fused(acc, cur, wr, wc, fr, fq, lds, wid, lane); S.done(cur); }
#undef PG8_SA
#undef PG8_SB
#undef PG8_STAGE
#undef PG8_LDA
#undef PG8_LDB
#undef PG8_MMA
#undef PG8_WAIT_V
#undef PG8_WAIT_L
#undef PG8_BAR
#undef PG8_SCHED
}
}

constexpr int BATCH = 16, SEQ = 2048, DMODEL = 1024, MROWS = BATCH * SEQ;
constexpr int DMIX = 2048, NPROJ = 7168, DIN = 7176, NHF = 8;
constexpr int MEM_LEN = 256, MMEM = BATCH * MEM_LEN;
constexpr float EPS = 1e-6f, LOG2E = 1.4426950408889634f;
constexpr float QSCALE64 = 0.125f * LOG2E;
constexpr float QSCALE128 = 0.08838834764831845f * LOG2E;

constexpr size_t MiB = 1u << 20;
constexpr size_t WS_PROJ = 0;
constexpr size_t SEG_BYTES = 32 * MiB;
constexpr size_t WS_Y = 320 * MiB;
constexpr size_t WS_OG = 0;
constexpr size_t WS_WIN = 448 * MiB;
constexpr size_t WS_WOUT = 462 * MiB;
constexpr size_t WS_WMKV = 466 * MiB;
constexpr size_t WS_HM = 468 * MiB;
constexpr size_t WS_MKV = 476 * MiB;
constexpr size_t WS_LOGF = 484 * MiB;
constexpr size_t WS_C2 = 485 * MiB;
constexpr size_t WS_CTL = 486 * MiB, CTL_ZERO_BYTES = 1 * MiB;
constexpr size_t WS_END = 487 * MiB;
constexpr int CW_BAR = 4096;
constexpr int CW_QUEUE = 16384;

constexpr int RING_BYTES = 131072;
constexpr int LDSCTL_OFF = RING_BYTES, MISC_OFF = LDSCTL_OFF + 320;
constexpr int LDS_BYTES = 147456;
constexpr int NWAVES = 8;

#define GAS __attribute__((address_space(1)))
#define LAS __attribute__((address_space(3)))
typedef unsigned short bf16;
typedef unsigned v4u __attribute__((ext_vector_type(4)));
typedef float f32x4 __attribute__((ext_vector_type(4)));
typedef unsigned u32x4_t __attribute__((ext_vector_type(4)));
typedef short bf16x8 __attribute__((ext_vector_type(8)));
typedef GAS unsigned gu32;
typedef GAS unsigned long long gu64;
#define RLX_AGENT __ATOMIC_RELAXED, __HIP_MEMORY_SCOPE_AGENT
#define LDS_WAIT() asm volatile("s_waitcnt lgkmcnt(0)" ::: "memory")
#define VM_WAIT() asm volatile("s_waitcnt vmcnt(0)" ::: "memory")
__device__ __forceinline__ unsigned long long rt() { return __builtin_amdgcn_s_memrealtime(); }
__device__ __forceinline__ unsigned f2bf(float f) { unsigned u = __builtin_bit_cast(unsigned, f); return (u + 0x7fffu + ((u >> 16) & 1u)) >> 16; }
__device__ __forceinline__ unsigned pk2(float lo, float hi) { return f2bf(lo) | (f2bf(hi) << 16); }

#define XB_TMO      128
#define XB_XCNT(j)  (256  + 64 * (j))
#define XB_XSUB(j)  (1280 + 64 * (j))
#define XB_XGEN(j)  (2304 + 64 * (j))
#define XB_TOP      3328
#define XB_TOPGEN   3392
#define XCD_BAR_WORDS 3456
#define XB_SPIN_CAP (1u << 18)

__device__ __forceinline__ unsigned xb_ld(unsigned* p)              { return __hip_atomic_load(p, __ATOMIC_RELAXED, __HIP_MEMORY_SCOPE_AGENT); }
__device__ __forceinline__ unsigned xb_add(unsigned* p, unsigned v) { return __hip_atomic_fetch_add(p, v, __ATOMIC_RELAXED, __HIP_MEMORY_SCOPE_AGENT); }
__device__ __forceinline__ unsigned xb_xcc_id() { return (unsigned)__builtin_amdgcn_s_getreg((3 << 11) | 20) & 0xFu; }
#define XB_SPIN(cond, bar) do { unsigned _sp = 0; while (cond) { __builtin_amdgcn_s_sleep(1); \
    if ((++_sp & 255u) == 0u) { if (xb_ld(&(bar)[XB_TMO])) break; if (_sp > XB_SPIN_CAP) { atomicAdd(&(bar)[XB_TMO], 1u); break; } } } } while (0)

struct XcdBarrier {
    unsigned* bar; unsigned x;
    volatile LAS unsigned* st;
};

__device__ __forceinline__ XcdBarrier xcd_barrier_post(unsigned* bar, volatile LAS unsigned* st) {
    XcdBarrier b; b.bar = bar; b.x = xb_xcc_id(); b.st = st;
    if (threadIdx.x == 0) (void)xb_add(&bar[XB_XCNT(b.x)], 1u);
    return b;
}
__device__ __forceinline__ void xcd_barrier_complete(unsigned* bar, unsigned x, unsigned& nloc, unsigned& nx) {
    const unsigned G = gridDim.x * gridDim.y * gridDim.z;
    unsigned sum, cnt, mine, sp = 0u;
    for (;;) {
        sum = 0u; cnt = 0u; mine = 0u;
#pragma unroll
        for (unsigned j = 0; j < 16; ++j) { const unsigned c = xb_ld(&bar[XB_XCNT(j)]); sum += c; cnt += (c > 0u) ? 1u : 0u; mine = (j == x) ? c : mine; }
        if (sum == G) break;
        __builtin_amdgcn_s_sleep(1);
        if ((++sp & 255u) == 0u) { if (xb_ld(&bar[XB_TMO])) break; if (sp > XB_SPIN_CAP) { atomicAdd(&bar[XB_TMO], 1u); break; } }
    }
    nloc = mine > 0u ? mine : 1u; nx = cnt > 0u ? cnt : 1u;
}

__device__ __forceinline__ void xcd_barrier(const XcdBarrier& b) {
    asm volatile("s_waitcnt vmcnt(0)" ::: "memory");
    __syncthreads();
    if (threadIdx.x == 0) {
        unsigned* bar = b.bar;
        __builtin_amdgcn_s_waitcnt(0);
        unsigned nloc = b.st[0], nx = b.st[1];
        if (nloc == 0u) { xcd_barrier_complete(bar, b.x, nloc, nx); b.st[0] = nloc; b.st[1] = nx; }
        const unsigned old = xb_add(&bar[XB_XSUB(b.x)], 1u);
        const unsigned gen = old / nloc;
        if (old + 1u == (gen + 1u) * nloc) {
            __builtin_amdgcn_fence(__ATOMIC_RELEASE, "agent");
            asm volatile("s_waitcnt vmcnt(0)" ::: "memory");
            const unsigned og = xb_add(&bar[XB_TOP], 1u);
            const unsigned tg = og / nx;
            if (og + 1u == (tg + 1u) * nx) xb_add(&bar[XB_TOPGEN], 1u);
            else XB_SPIN(xb_ld(&bar[XB_TOPGEN]) == tg, bar);
            __builtin_amdgcn_fence(__ATOMIC_ACQUIRE, "agent");
            xb_add(&bar[XB_XGEN(b.x)], 1u);
            asm volatile("s_waitcnt vmcnt(0)" ::: "memory");
        } else {
            XB_SPIN(xb_ld(&bar[XB_XGEN(b.x)]) == gen, bar);
            __builtin_amdgcn_fence(__ATOMIC_ACQUIRE, "agent");
            asm volatile("s_waitcnt vmcnt(0)" ::: "memory");
        }
    }
    __syncthreads();
}

struct Args { const float* in[12]; float* out; unsigned char* ws; int ph_lo, ph_hi; };

struct Frame {
    LAS unsigned char* lds;
    volatile LAS unsigned* MISC;
    gu32* ctl;
    int tid, lane, wave;
    int vcu, G;
    const Args* a;
};
#define F_X(F) ((F).a->in[0])
#define F_MEM(F) ((F).a->in[1])
#define F_WIN(F) ((F).a->in[2])
#define F_BFORGET(F) ((F).a->in[3])
#define F_WMKV(F) ((F).a->in[4])
#define F_WOUT(F) ((F).a->in[5])
#define F_PRE(F) ((F).a->in[6])
#define F_POST(F) ((F).a->in[7])
#define F_MEMNORM(F) ((F).a->in[8])
#define F_DLAM(F) ((F).a->in[9])
#define F_DHN(F) ((F).a->in[10])
#define F_RELB(F) ((F).a->in[11])
#define F_OUT(F) ((F).a->out)
#define F_WS(F) ((F).a->ws)
__device__ __forceinline__ float bf2f(unsigned short u) { return __uint_as_float((unsigned)u << 16); }
__device__ __forceinline__ float wave_sum(float v) {
#pragma unroll
    for (int o = 1; o < 64; o <<= 1) v += __shfl_xor(v, o);
    return v;
}
__device__ __forceinline__ float log_sigmoid_f(float v) { return v >= 0.f ? -log1pf(expf(-v)) : v - log1pf(expf(v)); }

__device__ __forceinline__ void p0_transpose_item(const float* W, int ldw, int K, bf16* WT, int k0, int n0, int csrc0, float sc, LAS float* scr, int lane) {
#pragma unroll 8
    for (int i = 0; i < 32; ++i) { const int kk = 2 * i + (lane >> 5); scr[kk * 33 + (lane & 31)] = W[(size_t)(k0 + kk) * ldw + csrc0 + (lane & 31)]; }
    LDS_WAIT(); asm volatile("" ::: "memory");
    const int c = lane & 7;
#pragma unroll
    for (int j = 0; j < 4; ++j) { const int n = (lane >> 3) + 8 * j; const LAS float* s = scr + (8 * c) * 33 + n;
        v4u o; o.x = pk2(s[0 * 33] * sc, s[1 * 33] * sc); o.y = pk2(s[2 * 33] * sc, s[3 * 33] * sc); o.z = pk2(s[4 * 33] * sc, s[5 * 33] * sc); o.w = pk2(s[6 * 33] * sc, s[7 * 33] * sc);
        *(GAS v4u*)(WT + (size_t)(n0 + n) * K + k0 + 8 * c) = o; }
    LDS_WAIT(); asm volatile("" ::: "memory");
}
__device__ __forceinline__ void p0_weights(Frame& F0, int l) {
    Frame F = F0; asm volatile("" : "+v"(F.lane), "+v"(F.tid));
    LAS float* scr = (LAS float*)(F.lds + F.wave * 8448);
    const int gw = F.vcu * NWAVES + F.wave, NGW = F.G * NWAVES;
    constexpr int I_IN = 16 * 224, I_OUT = 32 * 32, I_MKV = 16 * 32;
    const float* win = F_WIN(F) + (size_t)l * DMODEL * DIN; const float* wout = F_WOUT(F) + (size_t)l * DMIX * DMODEL; const float* wmkv = F_WMKV(F) + (size_t)l * DMODEL * 1024;
    for (int it = gw; it < I_IN + I_OUT + I_MKV; it += NGW) {
        int r = it;
        if (r < I_IN) { const int kb = r / 224, nb = r % 224, n0 = 32 * nb; const int csrc0 = n0 + (n0 >= 4608 ? 8 : 0);
            float sc = 1.f; if (n0 < 512 || (n0 >= 1536 && n0 < 2048) || (n0 >= 3072 && n0 < 3584)) sc = QSCALE64; else if (n0 >= 4608 && n0 < 5120) sc = QSCALE128;
            p0_transpose_item(win, DIN, DMODEL, (bf16*)(F_WS(F) + WS_WIN), 64 * kb, n0, csrc0, sc, scr, F.lane); continue; }
        r -= I_IN;
        if (r < I_OUT) { const int kb = r / 32, nb = r % 32; p0_transpose_item(wout, DMODEL, DMIX, (bf16*)(F_WS(F) + WS_WOUT), 64 * kb, 32 * nb, 32 * nb, 1.f, scr, F.lane); continue; }
        r -= I_OUT;
        { const int kb = r / 32, nb = r % 32; p0_transpose_item(wmkv, 1024, DMODEL, (bf16*)(F_WS(F) + WS_WMKV), 64 * kb, 32 * nb, 32 * nb, 1.f, scr, F.lane); }
    }
}
__device__ __forceinline__ void p0_mem_rows(Frame& F0, int l) {
    Frame F = F0; asm volatile("" : "+v"(F.lane), "+v"(F.tid));
    const int gw = F.vcu * NWAVES + F.wave, NGW = F.G * NWAVES;
    const GAS f32x4* gp = (const GAS f32x4*)(F_MEMNORM(F) + l * DMODEL) + F.lane; f32x4 g[4];
#pragma unroll
    for (int j = 0; j < 4; ++j) g[j] = gp[64 * j];
    for (int m = gw; m < MMEM; m += NGW) {
        const GAS f32x4* xr = (const GAS f32x4*)(F_MEM(F) + (size_t)m * DMODEL) + F.lane; f32x4 v[4]; float s2 = 0.f;
#pragma unroll
        for (int j = 0; j < 4; ++j) { v[j] = xr[64 * j]; s2 += (v[j].x * v[j].x + v[j].y * v[j].y) + (v[j].z * v[j].z + v[j].w * v[j].w); }
        const float r = 1.0f / sqrtf(wave_sum(s2) * (1.f / DMODEL) + EPS);
        GAS unsigned long long* o8 = (GAS unsigned long long*)(F_WS(F) + WS_HM + (size_t)m * DMODEL * 2) + F.lane;
#pragma unroll
        for (int j = 0; j < 4; ++j) { const f32x4 h = v[j] * r * g[j]; o8[64 * j] = (unsigned long long)pk2(h.x, h.y) | ((unsigned long long)pk2(h.z, h.w) << 32); }
    }
}
struct RowIn { f32x4 v[4]; v4u og[2]; v4u n1[2]; };
__device__ __forceinline__ void bf8_to_f(const v4u u, f32x4& a, f32x4& b) {
    a.x = __uint_as_float(u.x << 16); a.y = __uint_as_float(u.x & 0xffff0000u); a.z = __uint_as_float(u.y << 16); a.w = __uint_as_float(u.y & 0xffff0000u);
    b.x = __uint_as_float(u.z << 16); b.y = __uint_as_float(u.z & 0xffff0000u); b.z = __uint_as_float(u.w << 16); b.w = __uint_as_float(u.w & 0xffff0000u); }
__device__ __forceinline__ v4u f_to_bf8(const f32x4 a, const f32x4 b) { v4u u; u.x = pk2(a.x, a.y); u.y = pk2(a.z, a.w); u.z = pk2(b.x, b.y); u.w = pk2(b.z, b.w); return u; }
__device__ __forceinline__ float sumsq4(const f32x4 (&v)[4]) { float s = 0.f;
#pragma unroll
    for (int j = 0; j < 4; ++j) s += (v[j].x * v[j].x + v[j].y * v[j].y) + (v[j].z * v[j].z + v[j].w * v[j].w);
    return s; }
__device__ __forceinline__ void row_load(Frame& F, int l, int m, int lane, RowIn& R) {
    const GAS f32x4* xr = (const GAS f32x4*)(F_X(F) + (size_t)m * DMODEL + 8 * lane);
    R.v[0] = xr[0]; R.v[1] = xr[1]; R.v[2] = xr[128]; R.v[3] = xr[129];
    if (l > 0) { const GAS v4u* orow = (const GAS v4u*)((const bf16*)(F_WS(F) + WS_OG) + (size_t)m * DMODEL + 8 * lane); R.og[0] = orow[0]; R.og[1] = orow[64]; }
    if (l == 2) { const GAS v4u* nr = (const GAS v4u*)((const bf16*)((unsigned char*)F_OUT(F) + (size_t)m * 4096) + 8 * lane); R.n1[0] = nr[0]; R.n1[1] = nr[64]; }
}
__device__ __forceinline__ void row_compute(Frame& F, int l, int m, int lane, RowIn& R, const f32x4 (&gpre)[4], const f32x4 (&gpost)[4], const LAS float* wf) {
    unsigned char* slot = (unsigned char*)F_OUT(F) + (size_t)m * 4096;
    f32x4 v[4];
#pragma unroll
    for (int j = 0; j < 4; ++j) v[j] = R.v[j];
    if (l > 0) {
        f32x4 o[4]; bf8_to_f(R.og[0], o[0], o[1]); bf8_to_f(R.og[1], o[2], o[3]);
        const float ro = 1.0f / sqrtf(wave_sum(sumsq4(o)) * (1.f / DMODEL) + EPS);
        if (l == 1) {
            f32x4 n[4];
#pragma unroll
            for (int j = 0; j < 4; ++j) n[j] = o[j] * ro * gpost[j];
            const v4u n0 = f_to_bf8(n[0], n[1]), n1 = f_to_bf8(n[2], n[3]);
            GAS v4u* nw = (GAS v4u*)((bf16*)slot + 8 * lane); nw[0] = n0; nw[64] = n1;
            f32x4 t[4]; bf8_to_f(n0, t[0], t[1]); bf8_to_f(n1, t[2], t[3]);
#pragma unroll
            for (int j = 0; j < 4; ++j) v[j] = v[j] + t[j];
        } else {
            f32x4 t[4]; bf8_to_f(R.n1[0], t[0], t[1]); bf8_to_f(R.n1[1], t[2], t[3]);
            GAS f32x4* outr = (GAS f32x4*)((float*)slot + 8 * lane);
            outr[0] = v[0] + t[0] + o[0] * ro * gpost[0]; outr[1] = v[1] + t[1] + o[1] * ro * gpost[1];
            outr[128] = v[2] + t[2] + o[2] * ro * gpost[2]; outr[129] = v[3] + t[3] + o[3] * ro * gpost[3];
            return;
        }
    }
    const float r = 1.0f / sqrtf(wave_sum(sumsq4(v)) * (1.f / DMODEL) + EPS);
    f32x4 h[4];
#pragma unroll
    for (int j = 0; j < 4; ++j) h[j] = v[j] * r * gpre[j];
    { GAS v4u* hw = (GAS v4u*)((bf16*)(slot + 2048) + 8 * lane); hw[0] = f_to_bf8(h[0], h[1]); hw[64] = f_to_bf8(h[2], h[3]); }
    float fl[8];
#pragma unroll
    for (int f = 0; f < 8; ++f) { const LAS f32x4* wp = (const LAS f32x4*)(wf + f * 1024 + 8 * lane); const f32x4 w0 = wp[0], w1 = wp[1], w2 = wp[128], w3 = wp[129];
        fl[f] = ((h[0].x * w0.x + h[0].y * w0.y) + (h[0].z * w0.z + h[0].w * w0.w)) + ((h[1].x * w1.x + h[1].y * w1.y) + (h[1].z * w1.z + h[1].w * w1.w))
              + ((h[2].x * w2.x + h[2].y * w2.y) + (h[2].z * w2.z + h[2].w * w2.w)) + ((h[3].x * w3.x + h[3].y * w3.y) + (h[3].z * w3.z + h[3].w * w3.w));
        if (f & 1) __builtin_amdgcn_sched_barrier(0); }
    float t4[4], t2[2];
    { const bool up = (lane & 32) != 0;
#pragma unroll
      for (int i = 0; i < 4; ++i) { const float send = up ? fl[i] : fl[4 + i], keep = up ? fl[4 + i] : fl[i]; t4[i] = keep + __shfl_xor(send, 32); } }
    { const bool up = (lane & 16) != 0;
#pragma unroll
      for (int i = 0; i < 2; ++i) { const float send = up ? t4[i] : t4[2 + i], keep = up ? t4[2 + i] : t4[i]; t2[i] = keep + __shfl_xor(send, 16); } }
    float fv; { const bool up = (lane & 8) != 0; const float send = up ? t2[0] : t2[1], keep = up ? t2[1] : t2[0]; fv = keep + __shfl_xor(send, 8); }
    fv += __shfl_xor(fv, 4); fv += __shfl_xor(fv, 2); fv += __shfl_xor(fv, 1);
    if ((lane & 7) == 0) { const int f = ((lane >> 5) & 1) * 4 + ((lane >> 4) & 1) * 2 + ((lane >> 3) & 1); const int b = m / SEQ, s = m % SEQ;
        ((float*)(F_WS(F) + WS_LOGF))[((size_t)b * NHF + f) * SEQ + s] = log_sigmoid_f(fv + F_BFORGET(F)[l * NHF + f]); }
}
__device__ __forceinline__ void p0_rows(Frame& F0, int l) {
    Frame F = F0; asm volatile("" : "+v"(F.lane), "+v"(F.tid));
    const int gw = F.vcu * NWAVES + F.wave, NGW = F.G * NWAVES, lane = F.lane;
    LAS float* wf = (LAS float*)(F.lds + 98304);
    if (l < 2) {
        const float* win = F_WIN(F) + (size_t)l * DMODEL * DIN + 4608;
        for (int idx = F.tid; idx < 8192; idx += NWAVES * 64) { const int k = idx >> 3, f = idx & 7; wf[f * 1024 + k] = win[(size_t)k * DIN + f]; }
        __syncthreads();
    }
    f32x4 gpre[4], gpost[4];
#pragma unroll
    for (int j = 0; j < 4; ++j) { gpre[j] = (f32x4){0.f, 0.f, 0.f, 0.f}; gpost[j] = gpre[j]; }
    if (l < 2) { const GAS f32x4* gp = (const GAS f32x4*)(F_PRE(F) + l * DMODEL + 8 * lane); gpre[0] = gp[0]; gpre[1] = gp[1]; gpre[2] = gp[128]; gpre[3] = gp[129]; }
    if (l > 0) { const GAS f32x4* gp = (const GAS f32x4*)(F_POST(F) + (l - 1) * DMODEL + 8 * lane); gpost[0] = gp[0]; gpost[1] = gp[1]; gpost[2] = gp[128]; gpost[3] = gp[129]; }
    for (int m = gw; m < MROWS; m += 2 * NGW) {
        const int m2 = m + NGW; const bool two = m2 < MROWS;
        RowIn A, B;
        row_load(F, l, m, lane, A);
        if (two) row_load(F, l, m2, lane, B);
        if (l == 2) asm volatile("s_waitcnt vmcnt(0)" ::: "memory");
        row_compute(F, l, m, lane, A, gpre, gpost, wf);
        if (two) row_compute(F, l, m2, lane, B, gpre, gpost, wf);
    }
}
__device__ __forceinline__ void cumsum_logf(Frame& F0) {
    Frame F = F0; asm volatile("" : "+v"(F.lane), "+v"(F.tid));
    const int bh = blockIdx.x;
    if (bh >= BATCH * NHF || F.wave != 0) return;
    const float* src = (const float*)(F_WS(F) + WS_LOGF) + (size_t)bh * SEQ + 32 * F.lane; float* dst = (float*)(F_WS(F) + WS_C2) + (size_t)bh * SEQ + 32 * F.lane;
    float v[32];
#pragma unroll
    for (int i = 0; i < 8; ++i) { const f32x4 t = *(const GAS f32x4*)(src + 4 * i); v[4 * i] = t.x; v[4 * i + 1] = t.y; v[4 * i + 2] = t.z; v[4 * i + 3] = t.w; }
#pragma unroll
    for (int i = 1; i < 32; ++i) v[i] += v[i - 1];
    float tot = v[31], inc = tot;
#pragma unroll
    for (int o = 1; o < 64; o <<= 1) { const float t = __shfl_up(inc, o); if (F.lane >= o) inc += t; }
    const float off = inc - tot;
#pragma unroll
    for (int i = 0; i < 8; ++i) { f32x4 t; t.x = (v[4 * i] + off) * -LOG2E; t.y = (v[4 * i + 1] + off) * -LOG2E; t.z = (v[4 * i + 2] + off) * -LOG2E; t.w = (v[4 * i + 3] + off) * -LOG2E; *(GAS f32x4*)(dst + 4 * i) = t; }
}

struct NArgs { const unsigned char* ws; unsigned char* wsw; const float* diff_lambda; const float* diff_head_norm; const float* rel_bias; int layer; int pad; };
__device__ __forceinline__ void ld_row64(const bf16* p, float* q) {
#pragma unroll
    for (int i = 0; i < 8; ++i) { const uint4 u = *(const uint4*)(p + 8 * i);
        q[8 * i] = __uint_as_float(u.x << 16); q[8 * i + 1] = __uint_as_float(u.x & 0xffff0000u); q[8 * i + 2] = __uint_as_float(u.y << 16); q[8 * i + 3] = __uint_as_float(u.y & 0xffff0000u);
        q[8 * i + 4] = __uint_as_float(u.z << 16); q[8 * i + 5] = __uint_as_float(u.z & 0xffff0000u); q[8 * i + 6] = __uint_as_float(u.w << 16); q[8 * i + 7] = __uint_as_float(u.w & 0xffff0000u); }
}
__device__ __forceinline__ float dot64(const bf16* p, const float* q) {
    float s = 0.f;
#pragma unroll
    for (int i = 0; i < 8; ++i) { const uint4 u = *(const uint4*)(p + 8 * i);
        s += q[8 * i] * __uint_as_float(u.x << 16) + q[8 * i + 1] * __uint_as_float(u.x & 0xffff0000u) + q[8 * i + 2] * __uint_as_float(u.y << 16) + q[8 * i + 3] * __uint_as_float(u.y & 0xffff0000u)
           + q[8 * i + 4] * __uint_as_float(u.z << 16) + q[8 * i + 5] * __uint_as_float(u.z & 0xffff0000u) + q[8 * i + 6] * __uint_as_float(u.w << 16) + q[8 * i + 7] * __uint_as_float(u.w & 0xffff0000u); }
    return s;
}
__device__ __forceinline__ void axpy64(const bf16* p, float a, float* acc) {
#pragma unroll
    for (int i = 0; i < 8; ++i) { const uint4 u = *(const uint4*)(p + 8 * i);
        acc[8 * i] += a * __uint_as_float(u.x << 16); acc[8 * i + 1] += a * __uint_as_float(u.x & 0xffff0000u); acc[8 * i + 2] += a * __uint_as_float(u.y << 16); acc[8 * i + 3] += a * __uint_as_float(u.y & 0xffff0000u);
        acc[8 * i + 4] += a * __uint_as_float(u.z << 16); acc[8 * i + 5] += a * __uint_as_float(u.z & 0xffff0000u); acc[8 * i + 6] += a * __uint_as_float(u.w << 16); acc[8 * i + 7] += a * __uint_as_float(u.w & 0xffff0000u); }
}
__device__ __forceinline__ void store_y64(bf16* yrow, const float* o) {
#pragma unroll
    for (int i = 0; i < 8; ++i) { uint4 u = *(const uint4*)(yrow + 8 * i);
        u.x = pk2(o[8 * i] * __uint_as_float(u.x << 16), o[8 * i + 1] * __uint_as_float(u.x & 0xffff0000u)); u.y = pk2(o[8 * i + 2] * __uint_as_float(u.y << 16), o[8 * i + 3] * __uint_as_float(u.y & 0xffff0000u));
        u.z = pk2(o[8 * i + 4] * __uint_as_float(u.z << 16), o[8 * i + 5] * __uint_as_float(u.z & 0xffff0000u)); u.w = pk2(o[8 * i + 6] * __uint_as_float(u.w << 16), o[8 * i + 7] * __uint_as_float(u.w & 0xffff0000u));
        *(uint4*)(yrow + 8 * i) = u; }
}
__device__ __forceinline__ int t5_bucket(int n) {
    if (n < 16) return n;
    int large = 16 + (int)(logf((float)n / 16.0f) / logf(8.0f) * 16.0f);
    return large < 31 ? large : 31;
}
__device__ __forceinline__ float diff_lam(const float* dl, int l, float& lam_init) {
    float s1 = 0.f, s2 = 0.f;
    for (int i = 0; i < 64; ++i) { s1 += dl[l * 256 + i] * dl[l * 256 + 64 + i]; s2 += dl[l * 256 + 128 + i] * dl[l * 256 + 192 + i]; }
    lam_init = 0.8f - 0.6f * expf(-0.3f * (float)l);
    return expf(s1) - expf(s2) + lam_init;
}
__global__ void __launch_bounds__(256) naive_sb(NArgs a) {
    const int qb = blockIdx.x & 7, h = (blockIdx.x >> 3) & 7, b = blockIdx.x >> 6; const int t = qb * 256 + threadIdx.x; const size_t row = (size_t)b * SEQ + t;
    const bf16* Q = (const bf16*)(a.ws + WS_PROJ + 3 * SEG_BYTES); const bf16* K = (const bf16*)(a.ws + WS_PROJ + 4 * SEG_BYTES); const bf16* V = (const bf16*)(a.ws + WS_PROJ + 5 * SEG_BYTES);
    float q[64], acc[64]; ld_row64(Q + row * 512 + h * 64, q);
#pragma unroll
    for (int d = 0; d < 64; ++d) acc[d] = 0.f;
    float tail = 0.f;
    for (int s = qb * 256 + 254; s >= 0; --s) {
        if (s < t) { const size_t kr = ((size_t)b * SEQ + s) * 512 + h * 64; const float z = dot64(K + kr, q); const float e = exp2f(z), L = log2f(1.0f + e);
            const float w = exp2f(z - L + tail); tail -= L; axpy64(V + kr, w, acc); }
    }
    store_y64((bf16*)(a.wsw + WS_Y) + row * 2048 + 512 + h * 64, acc);
}
__global__ void __launch_bounds__(256) naive_fox(NArgs a) {
    const int qb = blockIdx.x & 7, h = (blockIdx.x >> 3) & 7, b = blockIdx.x >> 6; const int t = qb * 256 + threadIdx.x; const size_t row = (size_t)b * SEQ + t;
    const bf16* Q = (const bf16*)(a.ws + WS_PROJ + 6 * SEG_BYTES); const bf16* K = (const bf16*)(a.ws + WS_PROJ + 7 * SEG_BYTES); const bf16* V = (const bf16*)(a.ws + WS_PROJ + 8 * SEG_BYTES);
    const float* c2 = (const float*)(a.ws + WS_C2) + ((size_t)b * NHF + h) * SEQ;
    float q[64], acc[64]; ld_row64(Q + row * 512 + h * 64, q);
#pragma unroll
    for (int d = 0; d < 64; ++d) acc[d] = 0.f;
    float m = -1e30f, lsum = 0.f; const float ct = c2[t];
    for (int s = 0; s <= qb * 256 + 255; ++s) {
        if (s <= t) { const size_t kr = ((size_t)b * SEQ + s) * 512 + h * 64; const float xx = dot64(K + kr, q) + (c2[s] - ct); const float mn = fmaxf(m, xx), al = exp2f(m - mn), p = exp2f(xx - mn);
            lsum = lsum * al + p; m = mn;
#pragma unroll
            for (int d = 0; d < 64; ++d) acc[d] *= al;
            axpy64(V + kr, p, acc); }
    }
    const float il = 1.0f / lsum;
#pragma unroll
    for (int d = 0; d < 64; ++d) acc[d] *= il;
    store_y64((bf16*)(a.wsw + WS_Y) + row * 2048 + 1024 + h * 64, acc);
}
__global__ void __launch_bounds__(256) naive_mem(NArgs a) {
    const int qb = blockIdx.x & 7, h = (blockIdx.x >> 3) & 3, b = blockIdx.x >> 5; const int t = qb * 256 + threadIdx.x; const size_t row = (size_t)b * SEQ + t;
    const bf16* Q = (const bf16*)(a.ws + WS_PROJ + 9 * SEG_BYTES); const bf16* KV = (const bf16*)(a.ws + WS_MKV);
    float q[128]; ld_row64(Q + row * 512 + h * 128, q); ld_row64(Q + row * 512 + h * 128 + 64, q + 64);
#pragma unroll
    for (int dh = 0; dh < 2; ++dh) {
        float acc[64];
#pragma unroll
        for (int d = 0; d < 64; ++d) acc[d] = 0.f;
        float m = -1e30f, lsum = 0.f;
        for (int s = 0; s < MEM_LEN; ++s) { const size_t kr = ((size_t)b * MEM_LEN + s) * 1024 + h * 128; const float xx = dot64(KV + kr, q) + dot64(KV + kr + 64, q + 64);
            const float mn = fmaxf(m, xx), al = exp2f(m - mn), p = exp2f(xx - mn); lsum = lsum * al + p; m = mn;
#pragma unroll
            for (int d = 0; d < 64; ++d) acc[d] *= al;
            axpy64(KV + kr + 512 + dh * 64, p, acc); }
        const float il = 1.0f / lsum;
#pragma unroll
        for (int d = 0; d < 64; ++d) acc[d] *= il;
        store_y64((bf16*)(a.wsw + WS_Y) + row * 2048 + 1536 + h * 128 + dh * 64, acc);
    }
}
template <int C> __device__ __forceinline__ void naive_diff_pass(const bf16* Q, const bf16* K, const bf16* V, const float* rel_bias, int b, int h, int t, int tmax, int dh, float* res, float coef) {
    const size_t row = (size_t)b * SEQ + t; float q[64], acc[64]; ld_row64(Q + row * 512 + h * 128 + C * 64, q);
#pragma unroll
    for (int d = 0; d < 64; ++d) acc[d] = 0.f;
    float m = -1e30f, lsum = 0.f;
    for (int s = 0; s <= tmax; ++s) {
        if (s <= t) { const size_t kr = ((size_t)b * SEQ + s) * 512 + h * 128; const float xx = dot64(K + kr + C * 64, q) + rel_bias[t5_bucket(t - s) * 4 + h] * LOG2E;
            const float mn = fmaxf(m, xx), al = exp2f(m - mn), p = exp2f(xx - mn); lsum = lsum * al + p; m = mn;
#pragma unroll
            for (int d = 0; d < 64; ++d) acc[d] *= al;
            axpy64(V + kr + dh * 64, p, acc); }
    }
    const float il = coef / lsum;
#pragma unroll
    for (int d = 0; d < 64; ++d) res[d] += acc[d] * il;
}
__global__ void __launch_bounds__(256) naive_diff(NArgs a) {
    const int qb = blockIdx.x & 7, h = (blockIdx.x >> 3) & 3, b = blockIdx.x >> 5; const int t = qb * 256 + threadIdx.x; const size_t row = (size_t)b * SEQ + t;
    const bf16* Q = (const bf16*)(a.ws + WS_PROJ); const bf16* K = (const bf16*)(a.ws + WS_PROJ + 1 * SEG_BYTES); const bf16* V = (const bf16*)(a.ws + WS_PROJ + 2 * SEG_BYTES);
    float lam_init; const float lam = diff_lam(a.diff_lambda, a.layer, lam_init);
    float o0[64], o1[64];
#pragma unroll
    for (int d = 0; d < 64; ++d) { o0[d] = 0.f; o1[d] = 0.f; }
    const int tmax = qb * 256 + 255;
    naive_diff_pass<0>(Q, K, V, a.rel_bias, b, h, t, tmax, 0, o0, 1.0f); naive_diff_pass<1>(Q, K, V, a.rel_bias, b, h, t, tmax, 0, o0, -lam);
    naive_diff_pass<0>(Q, K, V, a.rel_bias, b, h, t, tmax, 1, o1, 1.0f); naive_diff_pass<1>(Q, K, V, a.rel_bias, b, h, t, tmax, 1, o1, -lam);
    float ss = 0.f;
#pragma unroll
    for (int d = 0; d < 64; ++d) ss += o0[d] * o0[d] + o1[d] * o1[d];
    const float r = (1.0f / sqrtf(ss * (1.0f / 128.0f) + EPS)) * (1.0f - lam_init); const float* g = a.diff_head_norm + a.layer * 128;
#pragma unroll
    for (int d = 0; d < 64; ++d) { o0[d] *= r * g[d]; o1[d] *= r * g[64 + d]; }
    bf16* yrow = (bf16*)(a.wsw + WS_Y) + row * 2048 + h * 128; store_y64(yrow, o0); store_y64(yrow + 64, o1);
}

namespace att {
typedef float f32x16 __attribute__((ext_vector_type(16)));
typedef short s16x4 __attribute__((ext_vector_type(4)));
typedef short v4i16_t __attribute__((ext_vector_type(4)));
typedef LAS const char* lds_cptr;
typedef float f32x2_t __attribute__((ext_vector_type(2))); typedef __bf16 bf16x2_t __attribute__((ext_vector_type(2)));
constexpr int AK_OFF = 0, AV_OFF = 49152, SLOT = 16384, AC2_OFF = 98304, ATB_OFF = 106496, AQW_OFF = 111616, AFL_OFF = 111616 + 64, AX_OFF = 0;
constexpr int TBN = 320;
enum { M_SB = 0, M_FOX = 1, M_DIFF = 2, M_MEM = 3 };
constexpr float NEG = -1e30f;
#define SBAR() __builtin_amdgcn_sched_barrier(0)
__device__ __forceinline__ void glds16(const void* gsrc, unsigned lds_dst) { unsigned keep;
    asm volatile("s_mov_b32 %0, m0\n\ts_mov_b32 m0, %2\n\ts_nop 0\n\tglobal_load_lds_dwordx4 %1, off\n\ts_mov_b32 m0, %0" : "=&s"(keep) : "v"(gsrc), "s"(lds_dst) : "memory"); }
__device__ __forceinline__ s16x4 vtr(lds_cptr p) { return __builtin_bit_cast(s16x4, __builtin_amdgcn_ds_read_tr16_b64_v4i16((LAS v4i16_t*)p)); }
__device__ __forceinline__ unsigned cvtpk(float lo, float hi) { f32x2_t v = {lo, hi}; bf16x2_t b = __builtin_convertvector(v, bf16x2_t); return __builtin_bit_cast(unsigned, b); }
__device__ __forceinline__ float ex2(float v) { return __builtin_amdgcn_exp2f(v); }
__device__ __forceinline__ float lg2(float v) { return __builtin_amdgcn_logf(v); }
__device__ __forceinline__ float xsum(float v) { auto rr = __builtin_amdgcn_permlane32_swap(__float_as_uint(v), __float_as_uint(v), false, false); return __uint_as_float(rr[0]) + __uint_as_float(rr[1]); }
__device__ __forceinline__ float xmax(float v) { auto rr = __builtin_amdgcn_permlane32_swap(__float_as_uint(v), __float_as_uint(v), false, false); return fmaxf(__uint_as_float(rr[0]), __uint_as_float(rr[1])); }
__device__ __forceinline__ int kcol(int r) { return (r & 3) + 8 * (r >> 2); }

template <int MODE>
__device__ __forceinline__ void attn_unit(const Args* A, LAS unsigned char* L, int b, int h, int qb, int layer, float lam, float lam_init) {
    constexpr int DQK = (MODE == M_MEM) ? 128 : 64, DV = (MODE == M_SB || MODE == M_FOX) ? 64 : 128;
    constexpr int KCH = (MODE == M_SB || MODE == M_FOX) ? 8 : 16, VPC = DV / 8, ROWS = (MODE == M_DIFF) ? 128 : 256;
    constexpr int NQ = DQK / 16, NDB = DV / 32, NPT = KCH / 8 + VPC / 8;
    constexpr bool CAUSAL = MODE != M_MEM;
    int tid_ = threadIdx.x; asm volatile("" : "+v"(tid_));
    const int tid = tid_, lane = tid & 63, r32 = lane & 31, hi = lane >> 5, wid = __builtin_amdgcn_readfirstlane(tid >> 6);
    const int wrow = (MODE == M_DIFF) ? (wid & 3) : wid, comp = (MODE == M_DIFF) ? (wid >> 2) : 0;
    const int q0 = qb * ROWS, wq0 = q0 + wrow * 32;
    const unsigned char* ws = A->ws;
    const bf16 *Qg, *Kg, *Vg; int pitchK = 512, ycol;
    if (MODE == M_SB)   { Qg = (const bf16*)(ws + WS_PROJ + 3 * SEG_BYTES) + (size_t)b * SEQ * 512 + h * 64; Kg = (const bf16*)(ws + WS_PROJ + 4 * SEG_BYTES) + (size_t)b * SEQ * 512 + h * 64; Vg = (const bf16*)(ws + WS_PROJ + 5 * SEG_BYTES) + (size_t)b * SEQ * 512 + h * 64; ycol = 512 + h * 64; }
    if (MODE == M_FOX)  { Qg = (const bf16*)(ws + WS_PROJ + 6 * SEG_BYTES) + (size_t)b * SEQ * 512 + h * 64; Kg = (const bf16*)(ws + WS_PROJ + 7 * SEG_BYTES) + (size_t)b * SEQ * 512 + h * 64; Vg = (const bf16*)(ws + WS_PROJ + 8 * SEG_BYTES) + (size_t)b * SEQ * 512 + h * 64; ycol = 1024 + h * 64; }
    if (MODE == M_DIFF) { Qg = (const bf16*)(ws + WS_PROJ) + (size_t)b * SEQ * 512 + h * 128 + comp * 64; Kg = (const bf16*)(ws + WS_PROJ + 1 * SEG_BYTES) + (size_t)b * SEQ * 512 + h * 128; Vg = (const bf16*)(ws + WS_PROJ + 2 * SEG_BYTES) + (size_t)b * SEQ * 512 + h * 128; ycol = h * 128; }
    if (MODE == M_MEM)  { Qg = (const bf16*)(ws + WS_PROJ + 9 * SEG_BYTES) + (size_t)b * SEQ * 512 + h * 128; Kg = (const bf16*)(ws + WS_MKV) + (size_t)b * MEM_LEN * 1024 + h * 128; Vg = Kg + 512; pitchK = 1024; ycol = 1536 + h * 128; }
    const int NT = (MODE == M_MEM) ? 4 : (q0 + ROWS) / 64;
    const unsigned lds0 = (unsigned)(uintptr_t)L;
    const bf16* ksrc = Kg + (size_t)lane * pitchK + wid * 8;
    const bf16* vsrc = Vg + (size_t)(16 * (wid & 3) + (lane >> 2)) * pitchK + (wid >> 2) * 32 + (lane & 3) * 8;
#define ATT_ISSUE(kt, sl) do { const size_t toff_ = (size_t)(kt) * 64 * pitchK; \
        _Pragma("unroll") for (int i_ = 0; i_ < KCH / 8; ++i_) glds16(ksrc + toff_ + i_ * 64, (unsigned)__builtin_amdgcn_readfirstlane(lds0 + AK_OFF + (sl) * SLOT + (wid + 8 * i_) * 1024)); \
        _Pragma("unroll") for (int i_ = 0; i_ < VPC / 8; ++i_) glds16(vsrc + toff_ + i_ * 64, (unsigned)__builtin_amdgcn_readfirstlane(lds0 + AV_OFF + (sl) * SLOT + (wid + 8 * i_) * 1024)); } while (0)
#define ATT_KT(i) (CAUSAL ? (NT - 1 - (i)) : (i))
    if (MODE == M_FOX) { const float* c2 = (const float*)(ws + WS_C2) + ((size_t)b * NHF + h) * SEQ; glds16(c2 + wid * 256 + lane * 4, (unsigned)__builtin_amdgcn_readfirstlane(lds0 + AC2_OFF + wid * 1024)); }
    ATT_ISSUE(ATT_KT(0), 0);
    if (NT > 1) ATT_ISSUE(ATT_KT(1), 1);
    bf16x8 qr[NQ];
    { const bf16* qp = Qg + (size_t)(wq0 + r32) * 512 + hi * 8;
#pragma unroll
      for (int d0 = 0; d0 < NQ; ++d0) qr[d0] = *(const bf16x8*)(qp + d0 * 16);
#pragma unroll
      for (int d0 = 0; d0 < NQ; ++d0) asm volatile("" : "+v"(qr[d0])); }
    f32x16 o[NDB];
#pragma unroll
    for (int d = 0; d < NDB; ++d)
#pragma unroll
        for (int r = 0; r < 16; ++r) o[d][r] = 0.f;
    float m_run = NEG, l_run = 0.f, s_run = 1.0f;
    const int qabs = wq0 + r32;
    const lds_cptr L3 = (lds_cptr)L;
    const lds_cptr kp0 = L3 + AK_OFF + (comp * 8 + hi) * 1024 + r32 * 16;
    const lds_cptr vp0 = L3 + AV_OFF + ((lane >> 4) & 1) * 32 + (lane & 3) * 8 + (4 * hi + ((lane & 15) >> 2)) * 64;
    int sl = 0;
    for (int i = 0; i < NT; ++i) {
        if (i + 1 < NT) asm volatile("s_waitcnt vmcnt(%0) lgkmcnt(0)\n\ts_barrier" :: "n"(NPT) : "memory");
        else asm volatile("s_waitcnt vmcnt(0) lgkmcnt(0)\n\ts_barrier" ::: "memory");
        if (MODE == M_SB) { if (i > 0) {
            const LAS u32x4_t* fp = (const LAS u32x4_t*)(L + AFL_OFF + ((i - 1) & 1) * 32); const u32x4_t f0 = fp[0], f1 = fp[1];
            if (__builtin_amdgcn_readfirstlane((int)((f0.x | f0.y) | (f0.z | f0.w) | (f1.x | f1.y) | (f1.z | f1.w))) == 0) break; } }
        if (i + 2 < NT) { const int sl2 = (sl >= 1) ? sl - 1 : 2; ATT_ISSUE(ATT_KT(i + 2), sl2); }
        const int kt = ATT_KT(i);
        const bool active = !CAUSAL || (kt * 64 <= wq0 + 31);
        if (active) {
            f32x16 p0, p1;
            bf16x8 kf[8];
            const lds_cptr kp = kp0 + sl * SLOT;
#pragma unroll
            for (int d0 = 0; d0 < 4; ++d0) { kf[2 * d0] = *(const LAS bf16x8*)(kp + d0 * 2048); kf[2 * d0 + 1] = *(const LAS bf16x8*)(kp + d0 * 2048 + 512); }
            if (MODE == M_FOX) { const LAS float* cp = (const LAS float*)(L + AC2_OFF) + kt * 64 + 4 * hi;
#pragma unroll
                for (int g = 0; g < 4; ++g) { const f32x4 c0 = *(const LAS f32x4*)(cp + 8 * g), c1 = *(const LAS f32x4*)(cp + 32 + 8 * g);
#pragma unroll
                    for (int j = 0; j < 4; ++j) { p0[4 * g + j] = c0[j]; p1[4 * g + j] = c1[j]; } } }
            else {
#pragma unroll
                for (int r = 0; r < 16; ++r) { p0[r] = 0.f; p1[r] = 0.f; } }
            const bool near = (MODE == M_DIFF) && (kt * 64 > wq0 - 176);
            SBAR();
#pragma unroll
            for (int d0 = 0; d0 < 4; ++d0) { p0 = __builtin_amdgcn_mfma_f32_32x32x16_bf16(kf[2 * d0], qr[d0], p0, 0, 0, 0); p1 = __builtin_amdgcn_mfma_f32_32x32x16_bf16(kf[2 * d0 + 1], qr[d0], p1, 0, 0, 0); }
            if (NQ > 4) { SBAR();
#pragma unroll
                for (int d0 = 0; d0 < 4; ++d0) { kf[2 * d0] = *(const LAS bf16x8*)(kp + (d0 + 4) * 2048); kf[2 * d0 + 1] = *(const LAS bf16x8*)(kp + (d0 + 4) * 2048 + 512); }
                SBAR();
#pragma unroll
                for (int d0 = 0; d0 < 4; ++d0) { p0 = __builtin_amdgcn_mfma_f32_32x32x16_bf16(kf[2 * d0], qr[NQ > 4 ? d0 + 4 : d0], p0, 0, 0, 0); p1 = __builtin_amdgcn_mfma_f32_32x32x16_bf16(kf[2 * d0 + 1], qr[NQ > 4 ? d0 + 4 : d0], p1, 0, 0, 0); } }
            SBAR();
            s16x4 vlo[4 * NDB], vhi[4 * NDB];
            { const lds_cptr vp = vp0 + sl * SLOT;
#pragma unroll
              for (int d = 0; d < NDB; ++d)
#pragma unroll
                for (int ks = 0; ks < 4; ++ks) { vlo[4 * d + ks] = vtr(vp + d * 4096 + ks * 1024); vhi[4 * d + ks] = vtr(vp + d * 4096 + ks * 1024 + 512); } }
            SBAR();
            unsigned pw[16];
            if (MODE == M_SB) {
                if (kt * 64 + 63 >= wq0) { const int kb = kt * 64 + 4 * hi;
#pragma unroll
                    for (int r = 0; r < 16; ++r) { const int kv = kb + kcol(r); if (kv >= qabs) p0[r] = NEG; if (kv + 32 >= qabs) p1[r] = NEG; } }
                f32x16 l0, l1;
#pragma unroll
                for (int r = 0; r < 16; ++r) { l0[r] = __builtin_amdgcn_rcpf(1.0f + ex2(p0[r])); l1[r] = __builtin_amdgcn_rcpf(1.0f + ex2(p1[r])); }
#pragma unroll
                for (int hf = 1; hf >= 0; --hf)
#pragma unroll
                    for (int g = 3; g >= 0; --g) {
                        const float a0 = hf ? l1[4 * g] : l0[4 * g], a1 = hf ? l1[4 * g + 1] : l0[4 * g + 1], a2 = hf ? l1[4 * g + 2] : l0[4 * g + 2], a3 = hf ? l1[4 * g + 3] : l0[4 * g + 3];
                        const float town = (a0 * a1) * (a2 * a3);
                        const auto sw = __builtin_amdgcn_permlane32_swap(__float_as_uint(town), __float_as_uint(town), false, false);
                        const float v0 = __uint_as_float(sw[0]), v1 = __uint_as_float(sw[1]);
                        const float t3 = s_run * (hi ? 1.0f : v1), t2 = t3 * a3, t1 = t2 * a2, t0 = t1 * a1;
                        const float w0 = (1.0f - a0) * t0, w1 = (1.0f - a1) * t1, w2 = (1.0f - a2) * t2, w3 = (1.0f - a3) * t3;
                        pw[hf * 8 + g * 2] = cvtpk(w0, w1); pw[hf * 8 + g * 2 + 1] = cvtpk(w2, w3);
                        s_run *= v0 * v1;
                    }
            } else {
                if (MODE == M_DIFF) { if (near) { const LAS float* tp = (const LAS float*)(L + ATB_OFF) + h * TBN + (223 - (wq0 - kt * 64 + r32 - 4 * hi));
#pragma unroll
                    for (int r = 0; r < 16; ++r) { p0[r] += tp[kcol(r)]; p1[r] += tp[32 + kcol(r)]; } } }
                if (CAUSAL) { if (kt * 64 + 63 > wq0) { const int kb = kt * 64 + 4 * hi;
#pragma unroll
                    for (int r = 0; r < 16; ++r) { const int kv = kb + kcol(r); if (kv > qabs) p0[r] = NEG; if (kv + 32 > qabs) p1[r] = NEG; } } }
                float ra = fmaxf(fmaxf(p0[0], p0[1]), p1[0]), rb = fmaxf(fmaxf(p0[2], p0[3]), p1[1]); ra = fmaxf(fmaxf(ra, p1[2]), p1[3]);
#pragma unroll
                for (int r = 4; r < 16; r += 4) { ra = fmaxf(fmaxf(ra, p0[r]), p0[r + 1]); rb = fmaxf(fmaxf(rb, p0[r + 2]), p0[r + 3]); ra = fmaxf(fmaxf(ra, p1[r]), p1[r + 1]); rb = fmaxf(fmaxf(rb, p1[r + 2]), p1[r + 3]); }
                const float rm = xmax(fmaxf(ra, rb));
                const float mn = fmaxf(m_run, rm);
                if (__any(mn > m_run)) { const float al = ex2(m_run - mn); l_run *= al; m_run = mn;
#pragma unroll
                    for (int d = 0; d < NDB; ++d)
#pragma unroll
                        for (int r = 0; r < 16; ++r) o[d][r] *= al; }
                float sa = 0.f, sb = 0.f;
#pragma unroll
                for (int r = 0; r < 16; ++r) { p0[r] = ex2(p0[r] - m_run); p1[r] = ex2(p1[r] - m_run); sa += p0[r]; sb += p1[r]; }
                l_run += sa + sb;
#pragma unroll
                for (int w = 0; w < 8; ++w) { pw[w] = cvtpk(p0[2 * w], p0[2 * w + 1]); pw[8 + w] = cvtpk(p1[2 * w], p1[2 * w + 1]); }
            }
            SBAR();
#pragma unroll
            for (int ks = 0; ks < 4; ++ks) { const u32x4_t pf = (u32x4_t){pw[4 * ks], pw[4 * ks + 1], pw[4 * ks + 2], pw[4 * ks + 3]};
#pragma unroll
                for (int d = 0; d < NDB; ++d) { const s16x4 lo = vlo[4 * d + ks], hh = vhi[4 * d + ks];
                    const bf16x8 vf = (bf16x8){lo[0], lo[1], lo[2], lo[3], hh[0], hh[1], hh[2], hh[3]};
                    o[d] = __builtin_amdgcn_mfma_f32_32x32x16_bf16(vf, __builtin_bit_cast(bf16x8, pf), o[d], 0, 0, 0); } }
        }
        if (MODE == M_SB) { const bool alive = !active || __any(s_run != 0.0f);
            if (lane == 0) ((LAS unsigned*)(L + AFL_OFF + (i & 1) * 32))[wid] = alive ? 1u : 0u; }
        sl = (sl == 2) ? 0 : sl + 1;
    }
    if (MODE == M_SB) asm volatile("s_waitcnt vmcnt(0)" ::: "memory");
    if (MODE != M_SB) { const float il = 1.0f / xsum(l_run);
#pragma unroll
        for (int d = 0; d < NDB; ++d)
#pragma unroll
            for (int r = 0; r < 16; ++r) o[d][r] *= il; }
    if (MODE == M_DIFF) {
        asm volatile("s_waitcnt lgkmcnt(0)\n\ts_barrier" ::: "memory");
        LAS float* X = (LAS float*)(L + AX_OFF) + wrow * 4096 + lane;
        if (comp == 1) {
#pragma unroll
            for (int d = 0; d < NDB; ++d)
#pragma unroll
                for (int r = 0; r < 16; ++r) X[(d * 16 + r) * 64] = o[d][r] * lam; }
        asm volatile("s_waitcnt lgkmcnt(0)\n\ts_barrier" ::: "memory");
        if (comp == 0) { float ss = 0.f;
#pragma unroll
            for (int d = 0; d < NDB; ++d)
#pragma unroll
                for (int r = 0; r < 16; ++r) { o[d][r] -= X[(d * 16 + r) * 64]; ss += o[d][r] * o[d][r]; }
            ss = xsum(ss);
            const float rn = (1.0f / sqrtf(ss * (1.0f / 128.0f) + EPS)) * (1.0f - lam_init);
            const float* gn = A->in[10] + layer * 128 + 4 * hi;
#pragma unroll
            for (int d = 0; d < NDB; ++d)
#pragma unroll
                for (int g = 0; g < 4; ++g) { const f32x4 gv = *(const f32x4*)(gn + 32 * d + 8 * g);
#pragma unroll
                    for (int j = 0; j < 4; ++j) o[d][4 * g + j] *= rn * gv[j]; } }
    }
    if (MODE != M_DIFF || comp == 0) {
        bf16* yrow = (bf16*)(A->ws + WS_Y) + (size_t)((size_t)b * SEQ + wq0 + r32) * 2048 + ycol + 4 * hi;
#pragma unroll
        for (int d = 0; d < NDB; ++d)
#pragma unroll
            for (int g = 0; g < 4; ++g) { uint2 u = *(const uint2*)(yrow + 32 * d + 8 * g);
                u.x = pk2(o[d][4 * g] * __uint_as_float(u.x << 16), o[d][4 * g + 1] * __uint_as_float(u.x & 0xffff0000u));
                u.y = pk2(o[d][4 * g + 2] * __uint_as_float(u.y << 16), o[d][4 * g + 3] * __uint_as_float(u.y & 0xffff0000u));
                *(uint2*)(yrow + 32 * d + 8 * g) = u; }
    }
    if (MODE == M_DIFF) asm volatile("s_waitcnt lgkmcnt(0)\n\ts_barrier" ::: "memory");
#undef ATT_ISSUE
#undef ATT_KT
}

constexpr int NU_MAIN = 192, NU_Q = 448;
struct UnitD { int mode, b, h, qb; };
__device__ __forceinline__ UnitD decode_unit(int x, int k) {
    UnitD u;
    if (k < NU_MAIN) { const int jj = k / 24, r = k % 24;
        if (r < 12)      { u.mode = M_DIFF; const int bh = 8 * jj + x;          u.b = bh >> 2; u.h = bh & 3; u.qb = 15 - r; }
        else if (r < 18) { u.mode = M_FOX; const int bh = 8 * (2 * jj) + x;     u.b = bh >> 3; u.h = bh & 7; u.qb = 7 - (r - 12); }
        else             { u.mode = M_FOX; const int bh = 8 * (2 * jj + 1) + x; u.b = bh >> 3; u.h = bh & 7; u.qb = 7 - (r - 18); }
        return u; }
    int r = k - NU_MAIN;
    if (r < 128) { u.mode = M_SB; const int bh = 8 * (r >> 3) + x; u.b = bh >> 3; u.h = bh & 7; u.qb = 7 - (r & 7); return u; } r -= 128;
    if (r < 8)  { u.mode = M_DIFF; const int bh = 8 * r + x; u.b = bh >> 2; u.h = bh & 3; u.qb = 3; return u; } r -= 8;
    if (r < 16) { u.mode = M_FOX; const int bh = 8 * r + x; u.b = bh >> 3; u.h = bh & 7; u.qb = 1; return u; } r -= 16;
    if (r < 8)  { u.mode = M_DIFF; const int bh = 8 * r + x; u.b = bh >> 2; u.h = bh & 3; u.qb = 2; return u; } r -= 8;
    if (r < 8)  { u.mode = M_DIFF; const int bh = 8 * r + x; u.b = bh >> 2; u.h = bh & 3; u.qb = 1; return u; } r -= 8;
    if (r < 16) { u.mode = M_FOX; const int bh = 8 * r + x; u.b = bh >> 3; u.h = bh & 7; u.qb = 0; return u; } r -= 16;
    if (r < 64) { u.mode = M_MEM; const int bh = 8 * (r >> 3) + x; u.b = bh >> 2; u.h = bh & 3; u.qb = r & 7; return u; } r -= 64;
    { u.mode = M_DIFF; const int bh = 8 * r + x; u.b = bh >> 2; u.h = bh & 3; u.qb = 0; return u; }
}
__device__ __forceinline__ void attn_phase(Frame& F0, int layer) {
    Frame F = F0; asm volatile("" : "+v"(F.lane), "+v"(F.tid));
    LAS unsigned char* L = F.lds;
    { LAS float* tb = (LAS float*)(L + ATB_OFF); const float* relb = F.a->in[11];
      for (int i = F.tid; i < 4 * TBN; i += NWAVES * 64) { const int h = i / TBN, j = i % TBN, dist = 223 - j; float v = 0.f;
          if (dist >= 0 && dist < 113) v = (relb[t5_bucket(dist) * 4 + h] - relb[31 * 4 + h]) * LOG2E;
          tb[i] = v; } }
    float lam_init, lam;
    { const float* dl = F.a->in[9] + layer * 256; const float s1 = wave_sum(dl[F.lane] * dl[64 + F.lane]), s2 = wave_sum(dl[128 + F.lane] * dl[192 + F.lane]);
      lam_init = 0.8f - 0.6f * expf(-0.3f * (float)layer); lam = expf(s1) - expf(s2) + lam_init; }
    if (F.wave >= 4) __builtin_amdgcn_s_setprio(1);
    const int x0 = (int)(xb_xcc_id() & 7u);
    for (int xi = 0; xi < 8; ++xi) {
        const int x = (x0 + xi) & 7;
        gu32* qh = F.ctl + CW_QUEUE + 64 * (layer * 8 + x);
        for (;;) {
            if (F.tid == 0) *(volatile LAS unsigned*)(L + AQW_OFF) = __hip_atomic_fetch_add(qh, 1u, __ATOMIC_RELAXED, __HIP_MEMORY_SCOPE_AGENT);
            __syncthreads();
            const int k = __builtin_amdgcn_readfirstlane((int)*(volatile LAS unsigned*)(L + AQW_OFF));
            if (k >= NU_Q) break;
            const UnitD u = decode_unit(x, k);
            if (u.mode == M_SB) attn_unit<M_SB>(F.a, L, u.b, u.h, u.qb, layer, lam, lam_init);
            else if (u.mode == M_FOX) attn_unit<M_FOX>(F.a, L, u.b, u.h, u.qb, layer, lam, lam_init);
            else if (u.mode == M_DIFF) attn_unit<M_DIFF>(F.a, L, u.b, u.h, u.qb, layer, lam, lam_init);
            else attn_unit<M_MEM>(F.a, L, u.b, u.h, u.qb, layer, lam, lam_init);
        }
        __syncthreads();
    }
    __builtin_amdgcn_s_setprio(0);
}
#undef SBAR
}


constexpr int N_PHASES = 9;
#ifndef MK_ONE_LAUNCH
#define MK_ONE_LAUNCH 1
#endif
#ifndef MK_NAIVE_ATTN
#define MK_NAIVE_ATTN 0
#endif
__global__ void __launch_bounds__(NWAVES * 64, 2) mega_fwd(Args args) {
    extern __shared__ __attribute__((aligned(16))) unsigned char lds[];
    Frame F;
    F.lds = (LAS unsigned char*)lds;
    F.MISC = (volatile LAS unsigned*)(F.lds + MISC_OFF);
    F.tid = threadIdx.x; F.lane = F.tid & 63; F.wave = __builtin_amdgcn_readfirstlane(F.tid >> 6);
    F.G = gridDim.x; { const int bx = blockIdx.x; F.vcu = (F.G % 8 == 0) ? (bx % 8) * (F.G / 8) + bx / 8 : bx; }
    F.a = &args; F.ctl = (gu32*)(args.ws + WS_CTL);
    for (int u = F.tid; u < (LDS_BYTES - LDSCTL_OFF) / 4; u += NWAVES * 64) ((LAS unsigned*)(F.lds + LDSCTL_OFF))[u] = 0u;
    __syncthreads();
    XcdBarrier bar; bar.bar = (unsigned*)(F.ctl + CW_BAR); bar.x = 0; bar.st = nullptr;
    if (MK_ONE_LAUNCH) bar = xcd_barrier_post((unsigned*)(F.ctl + CW_BAR), F.MISC + 8);
    const int lo = args.ph_lo, hi = args.ph_hi;
#define IN(k) (lo <= (k) && (k) < hi)
#define SEAM(k) do { if (IN(k) && IN((k) + 1)) xcd_barrier(bar); } while (0)
    for (int l = 0; l < 2; ++l) {
        if (IN(4 * l + 0)) { p0_weights(F, l); p0_mem_rows(F, l); p0_rows(F, l); }
        SEAM(4 * l + 0);
        if (IN(4 * l + 1)) {
            cumsum_logf(F);
            { pg8::Gemm g{(const bf16*)F_OUT(F) + 1024, (const bf16*)(F_WS(F) + WS_WIN), MROWS, NPROJ, DMODEL, 2048}; pg8::StaticOrder S; S.init(MROWS, NPROJ, F.G, (int)blockIdx.x);
              pg8::EpiProj E{(bf16*)(F_WS(F) + WS_PROJ), (bf16*)(F_WS(F) + WS_Y), SEG_BYTES / 2};
              pg8::gemm_phase<pg8::EpiProj, pg8::StaticOrder, true, true>(F.lds, g, S, E); }
            { pg8::Gemm g{(const bf16*)(F_WS(F) + WS_HM), (const bf16*)(F_WS(F) + WS_WMKV), MMEM, 1024, DMODEL, DMODEL}; pg8::StaticOrder S; S.init(MMEM, 1024, F.G, (int)blockIdx.x);
              pg8::EpiBf16 E{(bf16*)(F_WS(F) + WS_MKV), 1024};
              pg8::gemm_phase<pg8::EpiBf16, pg8::StaticOrder, true, true>(F.lds, g, S, E); }
        }
        SEAM(4 * l + 1);
        if (IN(4 * l + 2)) att::attn_phase(F, l);
        SEAM(4 * l + 2);
        if (IN(4 * l + 3)) {
            pg8::Gemm g{(const bf16*)(F_WS(F) + WS_Y), (const bf16*)(F_WS(F) + WS_WOUT), MROWS, DMODEL, DMIX, DMIX}; pg8::StaticOrder S; S.init(MROWS, DMODEL, F.G, (int)blockIdx.x);
            pg8::EpiBf16 E{(bf16*)(F_WS(F) + WS_OG), DMODEL};
            pg8::gemm_phase<pg8::EpiBf16, pg8::StaticOrder, true, true>(F.lds, g, S, E);
        }
        SEAM(4 * l + 3);
    }
    if (IN(8)) p0_rows(F, 2);
#undef IN
#undef SEAM
}

extern "C" void kernel_launch(void* const* d_in, const int* in_sizes, int n_in, void* d_out, int out_size, void* d_ws, size_t ws_size, hipStream_t stream) {
    static int grid = 0;
    if (grid == 0) {
        if (n_in != 12 || out_size != MROWS * DMODEL || ws_size < WS_END) { fprintf(stderr, "kernel_launch: unexpected shapes (n_in %d out %d ws %zu)\n", n_in, out_size, ws_size); grid = -1; return; }
        int dev = 0, cus = 0, per_cu = 0;
        if (hipGetDevice(&dev) != hipSuccess || hipDeviceGetAttribute(&cus, hipDeviceAttributeMultiprocessorCount, dev) != hipSuccess) { grid = -1; return; }
        if (hipFuncSetAttribute((const void*)mega_fwd, hipFuncAttributeMaxDynamicSharedMemorySize, LDS_BYTES) != hipSuccess) { fprintf(stderr, "kernel_launch: hipFuncSetAttribute failed\n"); grid = -1; return; }
        if (hipOccupancyMaxActiveBlocksPerMultiprocessor(&per_cu, (const void*)mega_fwd, NWAVES * 64, LDS_BYTES) != hipSuccess || per_cu < 1) fprintf(stderr, "kernel_launch: occupancy query says %d\n", per_cu);
        (void)hipGetLastError();
        grid = cus;
    }
    if (grid < 0) return;
    (void)hipMemsetAsync((char*)d_ws + WS_CTL, 0, CTL_ZERO_BYTES, stream);
    Args a{};
    for (int i = 0; i < 12; ++i) a.in[i] = (const float*)d_in[i];
    a.out = (float*)d_out; a.ws = (unsigned char*)d_ws;
#if MK_ONE_LAUNCH
    a.ph_lo = 0; a.ph_hi = N_PHASES;
    hipLaunchKernelGGL(mega_fwd, dim3(grid), dim3(NWAVES * 64), LDS_BYTES, stream, a);
#else
    for (int p = 0; p < N_PHASES; ++p) {
        if (MK_NAIVE_ATTN && (p == 2 || p == 6)) {
            NArgs na{}; na.ws = (const unsigned char*)d_ws; na.wsw = (unsigned char*)d_ws; na.diff_lambda = (const float*)d_in[9]; na.diff_head_norm = (const float*)d_in[10]; na.rel_bias = (const float*)d_in[11]; na.layer = p / 4;
            hipLaunchKernelGGL(naive_diff, dim3(BATCH * 4 * 8), dim3(256), 0, stream, na);
            hipLaunchKernelGGL(naive_sb, dim3(BATCH * 8 * 8), dim3(256), 0, stream, na);
            hipLaunchKernelGGL(naive_fox, dim3(BATCH * 8 * 8), dim3(256), 0, stream, na);
            hipLaunchKernelGGL(naive_mem, dim3(BATCH * 4 * 8), dim3(256), 0, stream, na);
            continue;
        }
        a.ph_lo = p; a.ph_hi = p + 1;
        hipLaunchKernelGGL(mega_fwd, dim3(grid), dim3(NWAVES * 64), LDS_BYTES, stream, a);
    }
#endif
}
```

```cpp
#include <hip/hip_runtime.h>
#include <cstdio>
#include <cstdint>
#define PG8_TRANSPOSED 1
namespace pg8 {
#define PG8_LAS __attribute__((address_space(3)))
typedef unsigned short bf16_t;
typedef short bf16x8 __attribute__((ext_vector_type(8)));
typedef float f32x4 __attribute__((ext_vector_type(4)));
typedef unsigned u32x4 __attribute__((ext_vector_type(4)));
constexpr int BM = 256, BK = 64, HALF = 128, HTB = HALF * BK * 2  , STAGE_BYTES = 8 * HTB, NXCD = 8, WGM = 4;

__host__ __device__ __forceinline__ int lds_byte(int r, int c) { const int st = (r >> 4) * 2 + (c >> 5), rr = r & 15, cc = c & 31, ob = rr * 64 + cc * 2; return st * 1024 + (ob ^ (((ob >> 9) & 1) << 5)); }
__host__ __device__ __forceinline__ void stage_rc(int b, int& R, int& C) { const int st = b / 1024, sb = b % 1024, swz = sb ^ (((sb >> 9) & 1) << 5); R = (st >> 1) * 16 + swz / 64; C = (st & 1) * 32 + (swz % 64) / 2; }
__host__ __device__ __forceinline__ int perm32(int rho) { const int n = rho >> 4, i = rho & 15; return 8 * (i >> 2) + 4 * n + (i & 3); }

struct Unit { int pm, pn; };
struct Gemm { const bf16_t* A; const bf16_t* Bt; int M, N, K, lda; };

struct StaticOrder {
    int nM, nN, nwg, G, c;
    __host__ __device__ void init(int M, int N, int G_, int c_) { nM = M / BM; nN = N / BM; nwg = nM * nN; G = G_; c = c_; }
    __host__ __device__ bool next(int i, Unit& u) const {
        const long L = (long)i * G + c; if (L >= nwg) return false;
        int wgid = (int)L; { const int q = nwg / NXCD, r = nwg % NXCD, xcd = wgid % NXCD, off = wgid / NXCD; wgid = (xcd < r ? xcd * (q + 1) : r * (q + 1) + (xcd - r) * q) + off; }
#if PG8_TRANSPOSED
        const int nig = WGM * nM, gid = wgid / nig, fn = gid * WGM, gsz = (nN - fn) < WGM ? (nN - fn) : WGM;
        u.pn = fn + ((wgid % nig) % gsz); u.pm = (wgid % nig) / gsz; return true;
#else
        const int nig = WGM * nN, gid = wgid / nig, fm = gid * WGM, gsz = (nM - fm) < WGM ? (nM - fm) : WGM;
        u.pm = fm + ((wgid % nig) % gsz); u.pn = (wgid % nig) / gsz; return true;
#endif
    }
    __device__ __forceinline__ void a_ready(const Unit&) const {}
    __device__ __forceinline__ void done(const Unit&) const {}
};

__device__ __forceinline__ unsigned cvt_pk_bf16(float lo, float hi) { unsigned r; asm volatile("v_cvt_pk_bf16_f32 %0, %1, %2" : "=v"(r) : "v"(lo), "v"(hi)); return r; }

struct EpiBf16 {
    static constexpr bool PERM = true, AFTER_DRAIN = false;
    bf16_t* O; int ldc;
    __device__ __forceinline__ void operator()(const f32x4 (&acc)[2][2][4][2], const Unit& u, int wr, int wc, int fr, int fq) const {
        const int row0 = u.pm * BM + wr * 64 + fr; const int col0 = u.pn * BM + wc * 32 + 8 * fq;
#pragma unroll
        for (int ai = 0; ai < 2; ++ai)
#pragma unroll
            for (int m = 0; m < 4; ++m) { bf16_t* rowp = O + (size_t)(row0 + ai * HALF + m * 16) * ldc + col0;
#pragma unroll
                for (int bj = 0; bj < 2; ++bj) { const f32x4 v0 = acc[ai][bj][m][0], v1 = acc[ai][bj][m][1];
                    u32x4 w; w.x = cvt_pk_bf16(v0[0], v0[1]); w.y = cvt_pk_bf16(v0[2], v0[3]); w.z = cvt_pk_bf16(v1[0], v1[1]); w.w = cvt_pk_bf16(v1[2], v1[3]);
                    *(u32x4*)(rowp + bj * HALF) = w; } }
    }
};
__device__ __forceinline__ float silu_f(float v) { return v * __builtin_amdgcn_rcpf(1.0f + __builtin_amdgcn_exp2f(-1.4426950408889634f * v)); }
struct EpiProj {
    static constexpr bool PERM = true, AFTER_DRAIN = false;
    bf16_t* proj; bf16_t* y; size_t seg_stride;
    __device__ __forceinline__ void operator()(const f32x4 (&acc)[2][2][4][2], const Unit& u, int wr, int wc, int fr, int fq) const {
        const int row0 = u.pm * BM + wr * 64 + fr; const int colt = u.pn * BM; const bool gate = colt >= 5120;
        bf16_t* base; int ldc, col0;
        if (gate) { base = y; ldc = 2048; col0 = colt - 5120 + wc * 32 + 8 * fq; }
        else { base = proj + (size_t)(colt >> 9) * seg_stride; ldc = 512; col0 = (colt & 511) + wc * 32 + 8 * fq; }
#pragma unroll
        for (int ai = 0; ai < 2; ++ai)
#pragma unroll
            for (int m = 0; m < 4; ++m) { bf16_t* rowp = base + (size_t)(row0 + ai * HALF + m * 16) * ldc + col0;
#pragma unroll
                for (int bj = 0; bj < 2; ++bj) { f32x4 v0 = acc[ai][bj][m][0], v1 = acc[ai][bj][m][1];
                    if (gate) {
#pragma unroll
                        for (int e = 0; e < 4; ++e) { v0[e] = silu_f(v0[e]); v1[e] = silu_f(v1[e]); } }
                    u32x4 w; w.x = cvt_pk_bf16(v0[0], v0[1]); w.y = cvt_pk_bf16(v0[2], v0[3]); w.z = cvt_pk_bf16(v1[0], v1[1]); w.w = cvt_pk_bf16(v1[2], v1[3]);
                    *(u32x4*)(rowp + bj * HALF) = w; } }
    }
};
struct EpiF32 {
    static constexpr bool PERM = false, AFTER_DRAIN = false;
    float* O; int ldc;
    __device__ __forceinline__ void operator()(const f32x4 (&acc)[2][2][4][2], const Unit& u, int wr, int wc, int fr, int fq) const {
        const int col0 = u.pn * BM + wc * 32 + 4 * fq;
#pragma unroll
        for (int ai = 0; ai < 2; ++ai)
#pragma unroll
            for (int m = 0; m < 4; ++m) { float* rowp = O + (size_t)(u.pm * BM + ai * HALF + wr * 64 + m * 16 + fr) * ldc + col0;
#pragma unroll
                for (int bj = 0; bj < 2; ++bj)
#pragma unroll
                    for (int n = 0; n < 2; ++n) *(f32x4*)(rowp + bj * HALF + n * 16) = acc[ai][bj][m][n]; }
    }
};

template <class Epi, class Sched, bool ALIGN_EPI = false, bool SP2 = false>
__device__ __forceinline__ void gemm_phase(PG8_LAS unsigned char* lds, const Gemm g, const Sched& S, const Epi& E) {
    int tid_ = threadIdx.x; asm volatile("" : "+v"(tid_));
    const int tid = tid_, wid = __builtin_amdgcn_readfirstlane(tid >> 6), lane = tid & 63, wr = wid >> 2, wc = wid & 3, fr = lane & 15, fq = lane >> 4;
    const int K = g.K, nt = K / BK;
    unsigned voffA[2], voffB[2];
#pragma unroll
    for (int i = 0; i < 2; ++i) { int R, C; stage_rc(tid * 16 + i * 8192, R, C); const int Rb = Epi::PERM ? ((R & ~31) + perm32(R & 31)) : R;
        voffA[i] = (unsigned)(R * g.lda + C) * 2u; voffB[i] = (unsigned)(Rb * K + C) * 2u; }
    const size_t kstep = (size_t)(BK * 2);
    const size_t hstepA = (size_t)HALF * g.lda * 2, hstepB = (size_t)HALF * K * 2;
    const size_t tstepA = 2 * hstepA, tstepB = 2 * hstepB;
    const unsigned ldsw = (unsigned)wid * 1024u;
    const int aoff = lds_byte(wr * 64 + fr, fq * 8), boff = lds_byte(wc * 32 + fr, fq * 8);
#define PG8_SA(b, h) (((b) * 2 + (h)) * HTB)
#define PG8_SB(b, h) ((4 + (b) * 2 + (h)) * HTB)
#define PG8_STAGE(bufoff, gbase, voff) do { _Pragma("unroll") for (int _i = 0; _i < 2; ++_i) \
        __builtin_amdgcn_global_load_lds((const unsigned*)((const char*)(gbase) + (voff)[_i]), (PG8_LAS unsigned*)(lds + (bufoff) + ldsw + _i * 8192), 16, 0, 0); } while (0)
#define PG8_LDA(dst, b, h) do { _Pragma("unroll") for (int m = 0; m < 4; ++m) _Pragma("unroll") for (int k = 0; k < 2; ++k) dst[m][k] = *(const PG8_LAS bf16x8*)(lds + PG8_SA(b, h) + aoff + m * 2048 + k * 1024); } while (0)
#define PG8_LDB(dst, b, h) do { _Pragma("unroll") for (int n = 0; n < 2; ++n) _Pragma("unroll") for (int k = 0; k < 2; ++k) dst[n][k] = *(const PG8_LAS bf16x8*)(lds + PG8_SB(b, h) + boff + n * 2048 + k * 1024); } while (0)
#define PG8_MMA(ai, bj, At, Bt) do { __builtin_amdgcn_s_setprio(1); _Pragma("unroll") for (int m = 0; m < 4; ++m) _Pragma("unroll") for (int n = 0; n < 2; ++n) _Pragma("unroll") for (int k = 0; k < 2; ++k) \
        acc[ai][bj][m][n] = __builtin_amdgcn_mfma_f32_16x16x32_bf16(Bt[n][k], At[m][k], acc[ai][bj][m][n], 0, 0, 0); __builtin_amdgcn_s_setprio(0); } while (0)
#define PG8_WAIT_V(n) asm volatile("s_waitcnt vmcnt(" #n ")" ::: "memory")
#define PG8_WAIT_L(n) asm volatile("s_waitcnt lgkmcnt(" #n ")" ::: "memory")
#define PG8_BAR __builtin_amdgcn_s_barrier()
#define PG8_SCHED __builtin_amdgcn_sched_barrier(0)
    Unit cur, nxt; int ui = 0;
    if (!S.next(0, cur)) return;
    f32x4 acc[2][2][4][2];
#pragma unroll
    for (int a = 0; a < 2; ++a)
#pragma unroll
        for (int b = 0; b < 2; ++b)
#pragma unroll
            for (int m = 0; m < 4; ++m)
#pragma unroll
                for (int n = 0; n < 2; ++n) acc[a][b][m][n] = (f32x4){0.f, 0.f, 0.f, 0.f};
    bf16x8 At[4][2], B0[2][2], B1[2][2];
    const char* cA = (const char*)g.A + (size_t)cur.pm * tstepA; const char* cB = (const char*)g.Bt + (size_t)cur.pn * tstepB;
    S.a_ready(cur);
    if constexpr (SP2) {
        PG8_STAGE(PG8_SB(0, 0), cB, voffB); PG8_STAGE(PG8_SB(0, 1), cB + hstepB, voffB); PG8_STAGE(PG8_SA(0, 0), cA, voffA); PG8_STAGE(PG8_SA(0, 1), cA + hstepA, voffA);
        if (wr == 1) PG8_BAR;
        PG8_WAIT_V(2); PG8_BAR;
        PG8_STAGE(PG8_SB(1, 0), cB + kstep, voffB); PG8_STAGE(PG8_SA(1, 0), cA + kstep, voffA); PG8_STAGE(PG8_SB(1, 1), cB + hstepB + kstep, voffB);
        PG8_WAIT_V(6); PG8_BAR;
    } else {
        PG8_STAGE(PG8_SB(0, 0), cB, voffB); PG8_STAGE(PG8_SA(0, 0), cA, voffA); PG8_STAGE(PG8_SB(0, 1), cB + hstepB, voffB); PG8_STAGE(PG8_SA(0, 1), cA + hstepA, voffA);
        if (wr == 1) PG8_BAR;
        PG8_WAIT_V(4); PG8_BAR;
        PG8_STAGE(PG8_SB(1, 0), cB + kstep, voffB); PG8_STAGE(PG8_SA(1, 0), cA + kstep, voffA); PG8_STAGE(PG8_SB(1, 1), cB + hstepB + kstep, voffB);
        PG8_WAIT_V(6); PG8_BAR;
    }
    for (;;) {
        const bool has_next = S.next(ui + 1, nxt);
        const char* nA = has_next ? (const char*)g.A + (size_t)nxt.pm * tstepA : cA; const char* nB = has_next ? (const char*)g.Bt + (size_t)nxt.pn * tstepB : cB;
        for (int t = 0; t < nt; t += 2) {
            const bool last = (t == nt - 2);
            const char* a1 = cA + (size_t)(t + 1) * kstep;
            const char* a2 = last ? nA : cA + (size_t)(t + 2) * kstep; const char* b2 = last ? nB : cB + (size_t)(t + 2) * kstep;
            const char* a3 = a2 + kstep; const char* b3 = b2 + kstep;
            if (last && has_next) S.a_ready(nxt);
            if constexpr (SP2) {
            PG8_LDB(B0, 0, 0); PG8_LDB(B1, 0, 1); PG8_SCHED; PG8_LDA(At, 0, 0); PG8_STAGE(PG8_SA(1, 1), a1 + hstepA, voffA);
            PG8_WAIT_V(8); PG8_WAIT_L(0); PG8_BAR; PG8_MMA(0, 0, At, B0); PG8_MMA(0, 1, At, B1); PG8_BAR; PG8_SCHED;
            PG8_LDA(At, 0, 1); PG8_STAGE(PG8_SB(0, 0), b2, voffB); PG8_STAGE(PG8_SB(0, 1), b2 + hstepB, voffB); PG8_STAGE(PG8_SA(0, 0), a2, voffA);
            PG8_WAIT_V(8); PG8_WAIT_L(0); PG8_BAR; PG8_MMA(1, 0, At, B0); PG8_MMA(1, 1, At, B1); PG8_BAR; PG8_SCHED;
            PG8_LDB(B0, 1, 0); PG8_LDB(B1, 1, 1); PG8_SCHED; PG8_LDA(At, 1, 0); PG8_STAGE(PG8_SA(0, 1), a2 + hstepA, voffA);
            PG8_WAIT_V(8); PG8_WAIT_L(0); PG8_BAR; PG8_MMA(0, 0, At, B0); PG8_MMA(0, 1, At, B1); PG8_BAR; PG8_SCHED;
            PG8_LDA(At, 1, 1); PG8_STAGE(PG8_SB(1, 0), b3, voffB); PG8_STAGE(PG8_SB(1, 1), b3 + hstepB, voffB); PG8_STAGE(PG8_SA(1, 0), a3, voffA);
            PG8_WAIT_V(8); PG8_WAIT_L(0); PG8_BAR; PG8_MMA(1, 0, At, B0); PG8_MMA(1, 1, At, B1); PG8_BAR; PG8_SCHED;
            } else {
            PG8_LDB(B0, 0, 0); PG8_SCHED; PG8_LDA(At, 0, 0); PG8_STAGE(PG8_SA(1, 1), a1 + hstepA, voffA);
            PG8_WAIT_L(8); PG8_BAR; PG8_WAIT_L(0); PG8_MMA(0, 0, At, B0); PG8_BAR; PG8_SCHED;
            PG8_LDB(B1, 0, 1); PG8_STAGE(PG8_SB(0, 0), b2, voffB);
            PG8_BAR; PG8_WAIT_L(0); PG8_MMA(0, 1, At, B1); PG8_BAR;
            PG8_LDA(At, 0, 1); PG8_STAGE(PG8_SA(0, 0), a2, voffA);
            PG8_BAR; PG8_WAIT_L(0); PG8_MMA(1, 0, At, B0); PG8_BAR; PG8_SCHED;
            PG8_STAGE(PG8_SB(0, 1), b2 + hstepB, voffB);
            PG8_WAIT_V(6); PG8_BAR; PG8_MMA(1, 1, At, B1); PG8_BAR;
            PG8_LDB(B0, 1, 0); PG8_SCHED; PG8_LDA(At, 1, 0); PG8_STAGE(PG8_SA(0, 1), a2 + hstepA, voffA);
            PG8_WAIT_L(8); PG8_BAR; PG8_WAIT_L(0); PG8_MMA(0, 0, At, B0); PG8_BAR; PG8_SCHED;
            PG8_LDB(B1, 1, 1); PG8_STAGE(PG8_SB(1, 0), b3, voffB);
            PG8_BAR; PG8_WAIT_L(0); PG8_MMA(0, 1, At, B1); PG8_BAR;
            PG8_LDA(At, 1, 1); PG8_STAGE(PG8_SA(1, 0), a3, voffA);
            PG8_BAR; PG8_WAIT_L(0); PG8_MMA(1, 0, At, B0); PG8_BAR; PG8_SCHED;
            PG8_STAGE(PG8_SB(1, 1), b3 + hstepB, voffB);
            PG8_WAIT_V(6); PG8_BAR; PG8_MMA(1, 1, At, B1); PG8_BAR;
            }
        }
        if constexpr (ALIGN_EPI) { if (wr == 0) PG8_BAR; }
        if constexpr (!Epi::AFTER_DRAIN) { E(acc, cur, wr, wc, fr, fq); S.done(cur); }
        if (!has_next) break;
#pragma unroll
        for (int a = 0; a < 2; ++a)
#pragma unroll
            for (int b = 0; b < 2; ++b)
#pragma unroll
                for (int m = 0; m < 4; ++m)
#pragma unroll
                    for (int n = 0; n < 2; ++n) acc[a][b][m][n] = (f32x4){0.f, 0.f, 0.f, 0.f};
        cur = nxt; cA = nA; cB = nB; ++ui;
        if constexpr (ALIGN_EPI) { if (wr == 1) PG8_BAR; }
    }
    PG8_WAIT_V(0);
    if constexpr (!ALIGN_EPI) { if (wr == 0) PG8_BAR; }
    PG8_BAR;
    if constexpr (Epi::AFTER_DRAIN) { E.fused(acc, cur, wr, wc, fr, fq, lds, wid, lane); S.done(cur); }
#undef PG8_SA
#undef PG8_SB
#undef PG8_STAGE
#undef PG8_LDA
#undef PG8_LDB
#undef PG8_MMA
#undef PG8_WAIT_V
#undef PG8_WAIT_L
#undef PG8_BAR
#undef PG8_SCHED
}
}

constexpr int BATCH = 16, SEQ = 2048, DMODEL = 1024, MROWS = BATCH * SEQ;
constexpr int DMIX = 2048, NPROJ = 7168, DIN = 7176, NHF = 8;
constexpr int MEM_LEN = 256, MMEM = BATCH * MEM_LEN;
constexpr float EPS = 1e-6f, LOG2E = 1.4426950408889634f;
constexpr float QSCALE64 = 0.125f * LOG2E;
constexpr float QSCALE128 = 0.08838834764831845f * LOG2E;

constexpr size_t MiB = 1u << 20;
constexpr size_t WS_PROJ = 0;
constexpr size_t SEG_BYTES = 32 * MiB;
constexpr size_t WS_Y = 320 * MiB;
constexpr size_t WS_OG = 0;
constexpr size_t WS_WIN = 448 * MiB;
constexpr size_t WS_WOUT = 462 * MiB;
constexpr size_t WS_WMKV = 466 * MiB;
constexpr size_t WS_HM = 468 * MiB;
constexpr size_t WS_MKV = 476 * MiB;
constexpr size_t WS_LOGF = 484 * MiB;
constexpr size_t WS_C2 = 485 * MiB;
constexpr size_t WS_CTL = 486 * MiB, CTL_ZERO_BYTES = 1 * MiB;
constexpr size_t WS_END = 487 * MiB;
constexpr int CW_BAR = 4096;
constexpr int CW_QUEUE = 16384;

constexpr int RING_BYTES = 131072;
constexpr int LDSCTL_OFF = RING_BYTES, MISC_OFF = LDSCTL_OFF + 320;
constexpr int LDS_BYTES = 147456;
constexpr int NWAVES = 8;

#define GAS __attribute__((address_space(1)))
#define LAS __attribute__((address_space(3)))
typedef unsigned short bf16;
typedef unsigned v4u __attribute__((ext_vector_type(4)));
typedef float f32x4 __attribute__((ext_vector_type(4)));
typedef unsigned u32x4_t __attribute__((ext_vector_type(4)));
typedef short bf16x8 __attribute__((ext_vector_type(8)));
typedef GAS unsigned gu32;
typedef GAS unsigned long long gu64;
#define RLX_AGENT __ATOMIC_RELAXED, __HIP_MEMORY_SCOPE_AGENT
#define LDS_WAIT() asm volatile("s_waitcnt lgkmcnt(0)" ::: "memory")
#define VM_WAIT() asm volatile("s_waitcnt vmcnt(0)" ::: "memory")
__device__ __forceinline__ unsigned long long rt() { return __builtin_amdgcn_s_memrealtime(); }
__device__ __forceinline__ unsigned f2bf(float f) { unsigned u = __builtin_bit_cast(unsigned, f); return (u + 0x7fffu + ((u >> 16) & 1u)) >> 16; }
__device__ __forceinline__ unsigned pk2(float lo, float hi) { return f2bf(lo) | (f2bf(hi) << 16); }

#define XB_TMO      128
#define XB_XCNT(j)  (256  + 64 * (j))
#define XB_XSUB(j)  (1280 + 64 * (j))
#define XB_XGEN(j)  (2304 + 64 * (j))
#define XB_TOP      3328
#define XB_TOPGEN   3392
#define XCD_BAR_WORDS 3456
#define XB_SPIN_CAP (1u << 18)

__device__ __forceinline__ unsigned xb_ld(unsigned* p)              { return __hip_atomic_load(p, __ATOMIC_RELAXED, __HIP_MEMORY_SCOPE_AGENT); }
__device__ __forceinline__ unsigned xb_add(unsigned* p, unsigned v) { return __hip_atomic_fetch_add(p, v, __ATOMIC_RELAXED, __HIP_MEMORY_SCOPE_AGENT); }
__device__ __forceinline__ unsigned xb_xcc_id() { return (unsigned)__builtin_amdgcn_s_getreg((3 << 11) | 20) & 0xFu; }
#define XB_SPIN(cond, bar) do { unsigned _sp = 0; while (cond) { __builtin_amdgcn_s_sleep(1); \
    if ((++_sp & 255u) == 0u) { if (xb_ld(&(bar)[XB_TMO])) break; if (_sp > XB_SPIN_CAP) { atomicAdd(&(bar)[XB_TMO], 1u); break; } } } } while (0)

struct XcdBarrier {
    unsigned* bar; unsigned x;
    volatile LAS unsigned* st;
};

__device__ __forceinline__ XcdBarrier xcd_barrier_post(unsigned* bar, volatile LAS unsigned* st) {
    XcdBarrier b; b.bar = bar; b.x = xb_xcc_id(); b.st = st;
    if (threadIdx.x == 0) (void)xb_add(&bar[XB_XCNT(b.x)], 1u);
    return b;
}
__device__ __forceinline__ void xcd_barrier_complete(unsigned* bar, unsigned x, unsigned& nloc, unsigned& nx) {
    const unsigned G = gridDim.x * gridDim.y * gridDim.z;
    unsigned sum, cnt, mine, sp = 0u;
    for (;;) {
        sum = 0u; cnt = 0u; mine = 0u;
#pragma unroll
        for (unsigned j = 0; j < 16; ++j) { const unsigned c = xb_ld(&bar[XB_XCNT(j)]); sum += c; cnt += (c > 0u) ? 1u : 0u; mine = (j == x) ? c : mine; }
        if (sum == G) break;
        __builtin_amdgcn_s_sleep(1);
        if ((++sp & 255u) == 0u) { if (xb_ld(&bar[XB_TMO])) break; if (sp > XB_SPIN_CAP) { atomicAdd(&bar[XB_TMO], 1u); break; } }
    }
    nloc = mine > 0u ? mine : 1u; nx = cnt > 0u ? cnt : 1u;
}

__device__ __forceinline__ void xcd_barrier(const XcdBarrier& b) {
    asm volatile("s_waitcnt vmcnt(0)" ::: "memory");
    __syncthreads();
    if (threadIdx.x == 0) {
        unsigned* bar = b.bar;
        __builtin_amdgcn_s_waitcnt(0);
        unsigned nloc = b.st[0], nx = b.st[1];
        if (nloc == 0u) { xcd_barrier_complete(bar, b.x, nloc, nx); b.st[0] = nloc; b.st[1] = nx; }
        const unsigned old = xb_add(&bar[XB_XSUB(b.x)], 1u);
        const unsigned gen = old / nloc;
        if (old + 1u == (gen + 1u) * nloc) {
            __builtin_amdgcn_fence(__ATOMIC_RELEASE, "agent");
            asm volatile("s_waitcnt vmcnt(0)" ::: "memory");
            const unsigned og = xb_add(&bar[XB_TOP], 1u);
            const unsigned tg = og / nx;
            if (og + 1u == (tg + 1u) * nx) xb_add(&bar[XB_TOPGEN], 1u);
            else XB_SPIN(xb_ld(&bar[XB_TOPGEN]) == tg, bar);
            __builtin_amdgcn_fence(__ATOMIC_ACQUIRE, "agent");
            xb_add(&bar[XB_XGEN(b.x)], 1u);
            asm volatile("s_waitcnt vmcnt(0)" ::: "memory");
        } else {
            XB_SPIN(xb_ld(&bar[XB_XGEN(b.x)]) == gen, bar);
            __builtin_amdgcn_fence(__ATOMIC_ACQUIRE, "agent");
            asm volatile("s_waitcnt vmcnt(0)" ::: "memory");
        }
    }
    __syncthreads();
}

struct Args { const float* in[12]; float* out; unsigned char* ws; int ph_lo, ph_hi; };

struct Frame {
    LAS unsigned char* lds;
    volatile LAS unsigned* MISC;
    gu32* ctl;
    int tid, lane, wave;
    int vcu, G;
    const Args* a;
};
#define F_X(F) ((F).a->in[0])
#define F_MEM(F) ((F).a->in[1])
#define F_WIN(F) ((F).a->in[2])
#define F_BFORGET(F) ((F).a->in[3])
#define F_WMKV(F) ((F).a->in[4])
#define F_WOUT(F) ((F).a->in[5])
#define F_PRE(F) ((F).a->in[6])
#define F_POST(F) ((F).a->in[7])
#define F_MEMNORM(F) ((F).a->in[8])
#define F_DLAM(F) ((F).a->in[9])
#define F_DHN(F) ((F).a->in[10])
#define F_RELB(F) ((F).a->in[11])
#define F_OUT(F) ((F).a->out)
#define F_WS(F) ((F).a->ws)
__device__ __forceinline__ float bf2f(unsigned short u) { return __uint_as_float((unsigned)u << 16); }
__device__ __forceinline__ float wave_sum(float v) {
#pragma unroll
    for (int o = 1; o < 64; o <<= 1) v += __shfl_xor(v, o);
    return v;
}
__device__ __forceinline__ float log_sigmoid_f(float v) { return v >= 0.f ? -log1pf(expf(-v)) : v - log1pf(expf(v)); }

__device__ __forceinline__ void p0_transpose_item(const float* W, int ldw, int K, bf16* WT, int k0, int n0, int csrc0, float sc, LAS float* scr, int lane) {
#pragma unroll 8
    for (int i = 0; i < 32; ++i) { const int kk = 2 * i + (lane >> 5); scr[kk * 33 + (lane & 31)] = W[(size_t)(k0 + kk) * ldw + csrc0 + (lane & 31)]; }
    LDS_WAIT(); asm volatile("" ::: "memory");
    const int c = lane & 7;
#pragma unroll
    for (int j = 0; j < 4; ++j) { const int n = (lane >> 3) + 8 * j; const LAS float* s = scr + (8 * c) * 33 + n;
        v4u o; o.x = pk2(s[0 * 33] * sc, s[1 * 33] * sc); o.y = pk2(s[2 * 33] * sc, s[3 * 33] * sc); o.z = pk2(s[4 * 33] * sc, s[5 * 33] * sc); o.w = pk2(s[6 * 33] * sc, s[7 * 33] * sc);
        *(GAS v4u*)(WT + (size_t)(n0 + n) * K + k0 + 8 * c) = o; }
    LDS_WAIT(); asm volatile("" ::: "memory");
}
__device__ __forceinline__ void p0_weights(Frame& F0, int l) {
    Frame F = F0; asm volatile("" : "+v"(F.lane), "+v"(F.tid));
    LAS float* scr = (LAS float*)(F.lds + F.wave * 8448);
    const int gw = F.vcu * NWAVES + F.wave, NGW = F.G * NWAVES;
    constexpr int I_IN = 16 * 224, I_OUT = 32 * 32, I_MKV = 16 * 32;
    const float* win = F_WIN(F) + (size_t)l * DMODEL * DIN; const float* wout = F_WOUT(F) + (size_t)l * DMIX * DMODEL; const float* wmkv = F_WMKV(F) + (size_t)l * DMODEL * 1024;
    for (int it = gw; it < I_IN + I_OUT + I_MKV; it += NGW) {
        int r = it;
        if (r < I_IN) { const int kb = r / 224, nb = r % 224, n0 = 32 * nb; const int csrc0 = n0 + (n0 >= 4608 ? 8 : 0);
            float sc = 1.f; if (n0 < 512 || (n0 >= 1536 && n0 < 2048) || (n0 >= 3072 && n0 < 3584)) sc = QSCALE64; else if (n0 >= 4608 && n0 < 5120) sc = QSCALE128;
            p0_transpose_item(win, DIN, DMODEL, (bf16*)(F_WS(F) + WS_WIN), 64 * kb, n0, csrc0, sc, scr, F.lane); continue; }
        r -= I_IN;
        if (r < I_OUT) { const int kb = r / 32, nb = r % 32; p0_transpose_item(wout, DMODEL, DMIX, (bf16*)(F_WS(F) + WS_WOUT), 64 * kb, 32 * nb, 32 * nb, 1.f, scr, F.lane); continue; }
        r -= I_OUT;
        { const int kb = r / 32, nb = r % 32; p0_transpose_item(wmkv, 1024, DMODEL, (bf16*)(F_WS(F) + WS_WMKV), 64 * kb, 32 * nb, 32 * nb, 1.f, scr, F.lane); }
    }
}
__device__ __forceinline__ void p0_mem_rows(Frame& F0, int l) {
    Frame F = F0; asm volatile("" : "+v"(F.lane), "+v"(F.tid));
    const int gw = F.vcu * NWAVES + F.wave, NGW = F.G * NWAVES;
    const GAS f32x4* gp = (const GAS f32x4*)(F_MEMNORM(F) + l * DMODEL) + F.lane; f32x4 g[4];
#pragma unroll
    for (int j = 0; j < 4; ++j) g[j] = gp[64 * j];
    for (int m = gw; m < MMEM; m += NGW) {
        const GAS f32x4* xr = (const GAS f32x4*)(F_MEM(F) + (size_t)m * DMODEL) + F.lane; f32x4 v[4]; float s2 = 0.f;
#pragma unroll
        for (int j = 0; j < 4; ++j) { v[j] = xr[64 * j]; s2 += (v[j].x * v[j].x + v[j].y * v[j].y) + (v[j].z * v[j].z + v[j].w * v[j].w); }
        const float r = 1.0f / sqrtf(wave_sum(s2) * (1.f / DMODEL) + EPS);
        GAS unsigned long long* o8 = (GAS unsigned long long*)(F_WS(F) + WS_HM + (size_t)m * DMODEL * 2) + F.lane;
#pragma unroll
        for (int j = 0; j < 4; ++j) { const f32x4 h = v[j] * r * g[j]; o8[64 * j] = (unsigned long long)pk2(h.x, h.y) | ((unsigned long long)pk2(h.z, h.w) << 32); }
    }
}
struct RowIn { f32x4 v[4]; v4u og[2]; v4u n1[2]; };
__device__ __forceinline__ void bf8_to_f(const v4u u, f32x4& a, f32x4& b) {
    a.x = __uint_as_float(u.x << 16); a.y = __uint_as_float(u.x & 0xffff0000u); a.z = __uint_as_float(u.y << 16); a.w = __uint_as_float(u.y & 0xffff0000u);
    b.x = __uint_as_float(u.z << 16); b.y = __uint_as_float(u.z & 0xffff0000u); b.z = __uint_as_float(u.w << 16); b.w = __uint_as_float(u.w & 0xffff0000u); }
__device__ __forceinline__ v4u f_to_bf8(const f32x4 a, const f32x4 b) { v4u u; u.x = pk2(a.x, a.y); u.y = pk2(a.z, a.w); u.z = pk2(b.x, b.y); u.w = pk2(b.z, b.w); return u; }
__device__ __forceinline__ float sumsq4(const f32x4 (&v)[4]) { float s = 0.f;
#pragma unroll
    for (int j = 0; j < 4; ++j) s += (v[j].x * v[j].x + v[j].y * v[j].y) + (v[j].z * v[j].z + v[j].w * v[j].w);
    return s; }
__device__ __forceinline__ void row_load(Frame& F, int l, int m, int lane, RowIn& R) {
    const GAS f32x4* xr = (const GAS f32x4*)(F_X(F) + (size_t)m * DMODEL + 8 * lane);
    R.v[0] = xr[0]; R.v[1] = xr[1]; R.v[2] = xr[128]; R.v[3] = xr[129];
    if (l > 0) { const GAS v4u* orow = (const GAS v4u*)((const bf16*)(F_WS(F) + WS_OG) + (size_t)m * DMODEL + 8 * lane); R.og[0] = orow[0]; R.og[1] = orow[64]; }
    if (l == 2) { const GAS v4u* nr = (const GAS v4u*)((const bf16*)((unsigned char*)F_OUT(F) + (size_t)m * 4096) + 8 * lane); R.n1[0] = nr[0]; R.n1[1] = nr[64]; }
}
__device__ __forceinline__ void row_compute(Frame& F, int l, int m, int lane, RowIn& R, const f32x4 (&gpre)[4], const f32x4 (&gpost)[4], const LAS float* wf) {
    unsigned char* slot = (unsigned char*)F_OUT(F) + (size_t)m * 4096;
    f32x4 v[4];
#pragma unroll
    for (int j = 0; j < 4; ++j) v[j] = R.v[j];
    if (l > 0) {
        f32x4 o[4]; bf8_to_f(R.og[0], o[0], o[1]); bf8_to_f(R.og[1], o[2], o[3]);
        const float ro = 1.0f / sqrtf(wave_sum(sumsq4(o)) * (1.f / DMODEL) + EPS);
        if (l == 1) {
            f32x4 n[4];
#pragma unroll
            for (int j = 0; j < 4; ++j) n[j] = o[j] * ro * gpost[j];
            const v4u n0 = f_to_bf8(n[0], n[1]), n1 = f_to_bf8(n[2], n[3]);
            GAS v4u* nw = (GAS v4u*)((bf16*)slot + 8 * lane); nw[0] = n0; nw[64] = n1;
            f32x4 t[4]; bf8_to_f(n0, t[0], t[1]); bf8_to_f(n1, t[2], t[3]);
#pragma unroll
            for (int j = 0; j < 4; ++j) v[j] = v[j] + t[j];
        } else {
            f32x4 t[4]; bf8_to_f(R.n1[0], t[0], t[1]); bf8_to_f(R.n1[1], t[2], t[3]);
            GAS f32x4* outr = (GAS f32x4*)((float*)slot + 8 * lane);
            outr[0] = v[0] + t[0] + o[0] * ro * gpost[0]; outr[1] = v[1] + t[1] + o[1] * ro * gpost[1];
            outr[128] = v[2] + t[2] + o[2] * ro * gpost[2]; outr[129] = v[3] + t[3] + o[3] * ro * gpost[3];
            return;
        }
    }
    const float r = 1.0f / sqrtf(wave_sum(sumsq4(v)) * (1.f / DMODEL) + EPS);
    f32x4 h[4];
#pragma unroll
    for (int j = 0; j < 4; ++j) h[j] = v[j] * r * gpre[j];
    { GAS v4u* hw = (GAS v4u*)((bf16*)(slot + 2048) + 8 * lane); hw[0] = f_to_bf8(h[0], h[1]); hw[64] = f_to_bf8(h[2], h[3]); }
    float fl[8];
#pragma unroll
    for (int f = 0; f < 8; ++f) { const LAS f32x4* wp = (const LAS f32x4*)(wf + f * 1024 + 8 * lane); const f32x4 w0 = wp[0], w1 = wp[1], w2 = wp[128], w3 = wp[129];
        fl[f] = ((h[0].x * w0.x + h[0].y * w0.y) + (h[0].z * w0.z + h[0].w * w0.w)) + ((h[1].x * w1.x + h[1].y * w1.y) + (h[1].z * w1.z + h[1].w * w1.w))
              + ((h[2].x * w2.x + h[2].y * w2.y) + (h[2].z * w2.z + h[2].w * w2.w)) + ((h[3].x * w3.x + h[3].y * w3.y) + (h[3].z * w3.z + h[3].w * w3.w));
        if (f & 1) __builtin_amdgcn_sched_barrier(0); }
    float t4[4], t2[2];
    { const bool up = (lane & 32) != 0;
#pragma unroll
      for (int i = 0; i < 4; ++i) { const float send = up ? fl[i] : fl[4 + i], keep = up ? fl[4 + i] : fl[i]; t4[i] = keep + __shfl_xor(send, 32); } }
    { const bool up = (lane & 16) != 0;
#pragma unroll
      for (int i = 0; i < 2; ++i) { const float send = up ? t4[i] : t4[2 + i], keep = up ? t4[2 + i] : t4[i]; t2[i] = keep + __shfl_xor(send, 16); } }
    float fv; { const bool up = (lane & 8) != 0; const float send = up ? t2[0] : t2[1], keep = up ? t2[1] : t2[0]; fv = keep + __shfl_xor(send, 8); }
    fv += __shfl_xor(fv, 4); fv += __shfl_xor(fv, 2); fv += __shfl_xor(fv, 1);
    if ((lane & 7) == 0) { const int f = ((lane >> 5) & 1) * 4 + ((lane >> 4) & 1) * 2 + ((lane >> 3) & 1); const int b = m / SEQ, s = m % SEQ;
        ((float*)(F_WS(F) + WS_LOGF))[((size_t)b * NHF + f) * SEQ + s] = log_sigmoid_f(fv + F_BFORGET(F)[l * NHF + f]); }
}
__device__ __forceinline__ void p0_rows(Frame& F0, int l) {
    Frame F = F0; asm volatile("" : "+v"(F.lane), "+v"(F.tid));
    const int gw = F.vcu * NWAVES + F.wave, NGW = F.G * NWAVES, lane = F.lane;
    LAS float* wf = (LAS float*)(F.lds + 98304);
    if (l < 2) {
        const float* win = F_WIN(F) + (size_t)l * DMODEL * DIN + 4608;
        for (int idx = F.tid; idx < 8192; idx += NWAVES * 64) { const int k = idx >> 3, f = idx & 7; wf[f * 1024 + k] = win[(size_t)k * DIN + f]; }
        __syncthreads();
    }
    f32x4 gpre[4], gpost[4];
#pragma unroll
    for (int j = 0; j < 4; ++j) { gpre[j] = (f32x4){0.f, 0.f, 0.f, 0.f}; gpost[j] = gpre[j]; }
    if (l < 2) { const GAS f32x4* gp = (const GAS f32x4*)(F_PRE(F) + l * DMODEL + 8 * lane); gpre[0] = gp[0]; gpre[1] = gp[1]; gpre[2] = gp[128]; gpre[3] = gp[129]; }
    if (l > 0) { const GAS f32x4* gp = (const GAS f32x4*)(F_POST(F) + (l - 1) * DMODEL + 8 * lane); gpost[0] = gp[0]; gpost[1] = gp[1]; gpost[2] = gp[128]; gpost[3] = gp[129]; }
    for (int m = gw; m < MROWS; m += 2 * NGW) {
        const int m2 = m + NGW; const bool two = m2 < MROWS;
        RowIn A, B;
        row_load(F, l, m, lane, A);
        if (two) row_load(F, l, m2, lane, B);
        if (l == 2) asm volatile("s_waitcnt vmcnt(0)" ::: "memory");
        row_compute(F, l, m, lane, A, gpre, gpost, wf);
        if (two) row_compute(F, l, m2, lane, B, gpre, gpost, wf);
    }
}
__device__ __forceinline__ void cumsum_logf(Frame& F0) {
    Frame F = F0; asm volatile("" : "+v"(F.lane), "+v"(F.tid));
    const int bh = blockIdx.x;
    if (bh >= BATCH * NHF || F.wave != 0) return;
    const float* src = (const float*)(F_WS(F) + WS_LOGF) + (size_t)bh * SEQ + 32 * F.lane; float* dst = (float*)(F_WS(F) + WS_C2) + (size_t)bh * SEQ + 32 * F.lane;
    float v[32];
#pragma unroll
    for (int i = 0; i < 8; ++i) { const f32x4 t = *(const GAS f32x4*)(src + 4 * i); v[4 * i] = t.x; v[4 * i + 1] = t.y; v[4 * i + 2] = t.z; v[4 * i + 3] = t.w; }
#pragma unroll
    for (int i = 1; i < 32; ++i) v[i] += v[i - 1];
    float tot = v[31], inc = tot;
#pragma unroll
    for (int o = 1; o < 64; o <<= 1) { const float t = __shfl_up(inc, o); if (F.lane >= o) inc += t; }
    const float off = inc - tot;
#pragma unroll
    for (int i = 0; i < 8; ++i) { f32x4 t; t.x = (v[4 * i] + off) * -LOG2E; t.y = (v[4 * i + 1] + off) * -LOG2E; t.z = (v[4 * i + 2] + off) * -LOG2E; t.w = (v[4 * i + 3] + off) * -LOG2E; *(GAS f32x4*)(dst + 4 * i) = t; }
}

struct NArgs { const unsigned char* ws; unsigned char* wsw; const float* diff_lambda; const float* diff_head_norm; const float* rel_bias; int layer; int pad; };
__device__ __forceinline__ void ld_row64(const bf16* p, float* q) {
#pragma unroll
    for (int i = 0; i < 8; ++i) { const uint4 u = *(const uint4*)(p + 8 * i);
        q[8 * i] = __uint_as_float(u.x << 16); q[8 * i + 1] = __uint_as_float(u.x & 0xffff0000u); q[8 * i + 2] = __uint_as_float(u.y << 16); q[8 * i + 3] = __uint_as_float(u.y & 0xffff0000u);
        q[8 * i + 4] = __uint_as_float(u.z << 16); q[8 * i + 5] = __uint_as_float(u.z & 0xffff0000u); q[8 * i + 6] = __uint_as_float(u.w << 16); q[8 * i + 7] = __uint_as_float(u.w & 0xffff0000u); }
}
__device__ __forceinline__ float dot64(const bf16* p, const float* q) {
    float s = 0.f;
#pragma unroll
    for (int i = 0; i < 8; ++i) { const uint4 u = *(const uint4*)(p + 8 * i);
        s += q[8 * i] * __uint_as_float(u.x << 16) + q[8 * i + 1] * __uint_as_float(u.x & 0xffff0000u) + q[8 * i + 2] * __uint_as_float(u.y << 16) + q[8 * i + 3] * __uint_as_float(u.y & 0xffff0000u)
           + q[8 * i + 4] * __uint_as_float(u.z << 16) + q[8 * i + 5] * __uint_as_float(u.z & 0xffff0000u) + q[8 * i + 6] * __uint_as_float(u.w << 16) + q[8 * i + 7] * __uint_as_float(u.w & 0xffff0000u); }
    return s;
}
__device__ __forceinline__ void axpy64(const bf16* p, float a, float* acc) {
#pragma unroll
    for (int i = 0; i < 8; ++i) { const uint4 u = *(const uint4*)(p + 8 * i);
        acc[8 * i] += a * __uint_as_float(u.x << 16); acc[8 * i + 1] += a * __uint_as_float(u.x & 0xffff0000u); acc[8 * i + 2] += a * __uint_as_float(u.y << 16); acc[8 * i + 3] += a * __uint_as_float(u.y & 0xffff0000u);
        acc[8 * i + 4] += a * __uint_as_float(u.z << 16); acc[8 * i + 5] += a * __uint_as_float(u.z & 0xffff0000u); acc[8 * i + 6] += a * __uint_as_float(u.w << 16); acc[8 * i + 7] += a * __uint_as_float(u.w & 0xffff0000u); }
}
__device__ __forceinline__ void store_y64(bf16* yrow, const float* o) {
#pragma unroll
    for (int i = 0; i < 8; ++i) { uint4 u = *(const uint4*)(yrow + 8 * i);
        u.x = pk2(o[8 * i] * __uint_as_float(u.x << 16), o[8 * i + 1] * __uint_as_float(u.x & 0xffff0000u)); u.y = pk2(o[8 * i + 2] * __uint_as_float(u.y << 16), o[8 * i + 3] * __uint_as_float(u.y & 0xffff0000u));
        u.z = pk2(o[8 * i + 4] * __uint_as_float(u.z << 16), o[8 * i + 5] * __uint_as_float(u.z & 0xffff0000u)); u.w = pk2(o[8 * i + 6] * __uint_as_float(u.w << 16), o[8 * i + 7] * __uint_as_float(u.w & 0xffff0000u));
        *(uint4*)(yrow + 8 * i) = u; }
}
__device__ __forceinline__ int t5_bucket(int n) {
    if (n < 16) return n;
    int large = 16 + (int)(logf((float)n / 16.0f) / logf(8.0f) * 16.0f);
    return large < 31 ? large : 31;
}
__device__ __forceinline__ float diff_lam(const float* dl, int l, float& lam_init) {
    float s1 = 0.f, s2 = 0.f;
    for (int i = 0; i < 64; ++i) { s1 += dl[l * 256 + i] * dl[l * 256 + 64 + i]; s2 += dl[l * 256 + 128 + i] * dl[l * 256 + 192 + i]; }
    lam_init = 0.8f - 0.6f * expf(-0.3f * (float)l);
    return expf(s1) - expf(s2) + lam_init;
}
__global__ void __launch_bounds__(256) naive_sb(NArgs a) {
    const int qb = blockIdx.x & 7, h = (blockIdx.x >> 3) & 7, b = blockIdx.x >> 6; const int t = qb * 256 + threadIdx.x; const size_t row = (size_t)b * SEQ + t;
    const bf16* Q = (const bf16*)(a.ws + WS_PROJ + 3 * SEG_BYTES); const bf16* K = (const bf16*)(a.ws + WS_PROJ + 4 * SEG_BYTES); const bf16* V = (const bf16*)(a.ws + WS_PROJ + 5 * SEG_BYTES);
    float q[64], acc[64]; ld_row64(Q + row * 512 + h * 64, q);
#pragma unroll
    for (int d = 0; d < 64; ++d) acc[d] = 0.f;
    float tail = 0.f;
    for (int s = qb * 256 + 254; s >= 0; --s) {
        if (s < t) { const size_t kr = ((size_t)b * SEQ + s) * 512 + h * 64; const float z = dot64(K + kr, q); const float e = exp2f(z), L = log2f(1.0f + e);
            const float w = exp2f(z - L + tail); tail -= L; axpy64(V + kr, w, acc); }
    }
    store_y64((bf16*)(a.wsw + WS_Y) + row * 2048 + 512 + h * 64, acc);
}
__global__ void __launch_bounds__(256) naive_fox(NArgs a) {
    const int qb = blockIdx.x & 7, h = (blockIdx.x >> 3) & 7, b = blockIdx.x >> 6; const int t = qb * 256 + threadIdx.x; const size_t row = (size_t)b * SEQ + t;
    const bf16* Q = (const bf16*)(a.ws + WS_PROJ + 6 * SEG_BYTES); const bf16* K = (const bf16*)(a.ws + WS_PROJ + 7 * SEG_BYTES); const bf16* V = (const bf16*)(a.ws + WS_PROJ + 8 * SEG_BYTES);
    const float* c2 = (const float*)(a.ws + WS_C2) + ((size_t)b * NHF + h) * SEQ;
    float q[64], acc[64]; ld_row64(Q + row * 512 + h * 64, q);
#pragma unroll
    for (int d = 0; d < 64; ++d) acc[d] = 0.f;
    float m = -1e30f, lsum = 0.f; const float ct = c2[t];
    for (int s = 0; s <= qb * 256 + 255; ++s) {
        if (s <= t) { const size_t kr = ((size_t)b * SEQ + s) * 512 + h * 64; const float xx = dot64(K + kr, q) + (c2[s] - ct); const float mn = fmaxf(m, xx), al = exp2f(m - mn), p = exp2f(xx - mn);
            lsum = lsum * al + p; m = mn;
#pragma unroll
            for (int d = 0; d < 64; ++d) acc[d] *= al;
            axpy64(V + kr, p, acc); }
    }
    const float il = 1.0f / lsum;
#pragma unroll
    for (int d = 0; d < 64; ++d) acc[d] *= il;
    store_y64((bf16*)(a.wsw + WS_Y) + row * 2048 + 1024 + h * 64, acc);
}
__global__ void __launch_bounds__(256) naive_mem(NArgs a) {
    const int qb = blockIdx.x & 7, h = (blockIdx.x >> 3) & 3, b = blockIdx.x >> 5; const int t = qb * 256 + threadIdx.x; const size_t row = (size_t)b * SEQ + t;
    const bf16* Q = (const bf16*)(a.ws + WS_PROJ + 9 * SEG_BYTES); const bf16* KV = (const bf16*)(a.ws + WS_MKV);
    float q[128]; ld_row64(Q + row * 512 + h * 128, q); ld_row64(Q + row * 512 + h * 128 + 64, q + 64);
#pragma unroll
    for (int dh = 0; dh < 2; ++dh) {
        float acc[64];
#pragma unroll
        for (int d = 0; d < 64; ++d) acc[d] = 0.f;
        float m = -1e30f, lsum = 0.f;
        for (int s = 0; s < MEM_LEN; ++s) { const size_t kr = ((size_t)b * MEM_LEN + s) * 1024 + h * 128; const float xx = dot64(KV + kr, q) + dot64(KV + kr + 64, q + 64);
            const float mn = fmaxf(m, xx), al = exp2f(m - mn), p = exp2f(xx - mn); lsum = lsum * al + p; m = mn;
#pragma unroll
            for (int d = 0; d < 64; ++d) acc[d] *= al;
            axpy64(KV + kr + 512 + dh * 64, p, acc); }
        const float il = 1.0f / lsum;
#pragma unroll
        for (int d = 0; d < 64; ++d) acc[d] *= il;
        store_y64((bf16*)(a.wsw + WS_Y) + row * 2048 + 1536 + h * 128 + dh * 64, acc);
    }
}
template <int C> __device__ __forceinline__ void naive_diff_pass(const bf16* Q, const bf16* K, const bf16* V, const float* rel_bias, int b, int h, int t, int tmax, int dh, float* res, float coef) {
    const size_t row = (size_t)b * SEQ + t; float q[64], acc[64]; ld_row64(Q + row * 512 + h * 128 + C * 64, q);
#pragma unroll
    for (int d = 0; d < 64; ++d) acc[d] = 0.f;
    float m = -1e30f, lsum = 0.f;
    for (int s = 0; s <= tmax; ++s) {
        if (s <= t) { const size_t kr = ((size_t)b * SEQ + s) * 512 + h * 128; const float xx = dot64(K + kr + C * 64, q) + rel_bias[t5_bucket(t - s) * 4 + h] * LOG2E;
            const float mn = fmaxf(m, xx), al = exp2f(m - mn), p = exp2f(xx - mn); lsum = lsum * al + p; m = mn;
#pragma unroll
            for (int d = 0; d < 64; ++d) acc[d] *= al;
            axpy64(V + kr + dh * 64, p, acc); }
    }
    const float il = coef / lsum;
#pragma unroll
    for (int d = 0; d < 64; ++d) res[d] += acc[d] * il;
}
__global__ void __launch_bounds__(256) naive_diff(NArgs a) {
    const int qb = blockIdx.x & 7, h = (blockIdx.x >> 3) & 3, b = blockIdx.x >> 5; const int t = qb * 256 + threadIdx.x; const size_t row = (size_t)b * SEQ + t;
    const bf16* Q = (const bf16*)(a.ws + WS_PROJ); const bf16* K = (const bf16*)(a.ws + WS_PROJ + 1 * SEG_BYTES); const bf16* V = (const bf16*)(a.ws + WS_PROJ + 2 * SEG_BYTES);
    float lam_init; const float lam = diff_lam(a.diff_lambda, a.layer, lam_init);
    float o0[64], o1[64];
#pragma unroll
    for (int d = 0; d < 64; ++d) { o0[d] = 0.f; o1[d] = 0.f; }
    const int tmax = qb * 256 + 255;
    naive_diff_pass<0>(Q, K, V, a.rel_bias, b, h, t, tmax, 0, o0, 1.0f); naive_diff_pass<1>(Q, K, V, a.rel_bias, b, h, t, tmax, 0, o0, -lam);
    naive_diff_pass<0>(Q, K, V, a.rel_bias, b, h, t, tmax, 1, o1, 1.0f); naive_diff_pass<1>(Q, K, V, a.rel_bias, b, h, t, tmax, 1, o1, -lam);
    float ss = 0.f;
#pragma unroll
    for (int d = 0; d < 64; ++d) ss += o0[d] * o0[d] + o1[d] * o1[d];
    const float r = (1.0f / sqrtf(ss * (1.0f / 128.0f) + EPS)) * (1.0f - lam_init); const float* g = a.diff_head_norm + a.layer * 128;
#pragma unroll
    for (int d = 0; d < 64; ++d) { o0[d] *= r * g[d]; o1[d] *= r * g[64 + d]; }
    bf16* yrow = (bf16*)(a.wsw + WS_Y) + row * 2048 + h * 128; store_y64(yrow, o0); store_y64(yrow + 64, o1);
}

namespace att {
typedef float f32x16 __attribute__((ext_vector_type(16)));
typedef short s16x4 __attribute__((ext_vector_type(4)));
typedef short v4i16_t __attribute__((ext_vector_type(4)));
typedef LAS const char* lds_cptr;
typedef float f32x2_t __attribute__((ext_vector_type(2))); typedef __bf16 bf16x2_t __attribute__((ext_vector_type(2)));
constexpr int AK_OFF = 0, AV_OFF = 49152, SLOT = 16384, AC2_OFF = 98304, ATB_OFF = 106496, AQW_OFF = 111616, AFL_OFF = 111616 + 64, AX_OFF = 0;
constexpr int TBN = 320;
enum { M_SB = 0, M_FOX = 1, M_DIFF = 2, M_MEM = 3 };
constexpr float NEG = -1e30f;
#define SBAR() __builtin_amdgcn_sched_barrier(0)
__device__ __forceinline__ void glds16(const void* gsrc, unsigned lds_dst) { unsigned keep;
    asm volatile("s_mov_b32 %0, m0\n\ts_mov_b32 m0, %2\n\ts_nop 0\n\tglobal_load_lds_dwordx4 %1, off\n\ts_mov_b32 m0, %0" : "=&s"(keep) : "v"(gsrc), "s"(lds_dst) : "memory"); }
__device__ __forceinline__ s16x4 vtr(lds_cptr p) { return __builtin_bit_cast(s16x4, __builtin_amdgcn_ds_read_tr16_b64_v4i16((LAS v4i16_t*)p)); }
__device__ __forceinline__ unsigned cvtpk(float lo, float hi) { f32x2_t v = {lo, hi}; bf16x2_t b = __builtin_convertvector(v, bf16x2_t); return __builtin_bit_cast(unsigned, b); }
__device__ __forceinline__ float ex2(float v) { return __builtin_amdgcn_exp2f(v); }
__device__ __forceinline__ float lg2(float v) { return __builtin_amdgcn_logf(v); }
__device__ __forceinline__ float xsum(float v) { auto rr = __builtin_amdgcn_permlane32_swap(__float_as_uint(v), __float_as_uint(v), false, false); return __uint_as_float(rr[0]) + __uint_as_float(rr[1]); }
__device__ __forceinline__ float xmax(float v) { auto rr = __builtin_amdgcn_permlane32_swap(__float_as_uint(v), __float_as_uint(v), false, false); return fmaxf(__uint_as_float(rr[0]), __uint_as_float(rr[1])); }
__device__ __forceinline__ int kcol(int r) { return (r & 3) + 8 * (r >> 2); }

template <int MODE>
__device__ __forceinline__ void attn_unit(const Args* A, LAS unsigned char* L, int b, int h, int qb, int layer, float lam, float lam_init) {
    constexpr int DQK = (MODE == M_MEM) ? 128 : 64, DV = (MODE == M_SB || MODE == M_FOX) ? 64 : 128;
    constexpr int KCH = (MODE == M_SB || MODE == M_FOX) ? 8 : 16, VPC = DV / 8, ROWS = (MODE == M_DIFF) ? 128 : 256;
    constexpr int NQ = DQK / 16, NDB = DV / 32, NPT = KCH / 8 + VPC / 8;
    constexpr bool CAUSAL = MODE != M_MEM;
    int tid_ = threadIdx.x; asm volatile("" : "+v"(tid_));
    const int tid = tid_, lane = tid & 63, r32 = lane & 31, hi = lane >> 5, wid = __builtin_amdgcn_readfirstlane(tid >> 6);
    const int wrow = (MODE == M_DIFF) ? (wid & 3) : wid, comp = (MODE == M_DIFF) ? (wid >> 2) : 0;
    const int q0 = qb * ROWS, wq0 = q0 + wrow * 32;
    const unsigned char* ws = A->ws;
    const bf16 *Qg, *Kg, *Vg; int pitchK = 512, ycol;
    if (MODE == M_SB)   { Qg = (const bf16*)(ws + WS_PROJ + 3 * SEG_BYTES) + (size_t)b * SEQ * 512 + h * 64; Kg = (const bf16*)(ws + WS_PROJ + 4 * SEG_BYTES) + (size_t)b * SEQ * 512 + h * 64; Vg = (const bf16*)(ws + WS_PROJ + 5 * SEG_BYTES) + (size_t)b * SEQ * 512 + h * 64; ycol = 512 + h * 64; }
    if (MODE == M_FOX)  { Qg = (const bf16*)(ws + WS_PROJ + 6 * SEG_BYTES) + (size_t)b * SEQ * 512 + h * 64; Kg = (const bf16*)(ws + WS_PROJ + 7 * SEG_BYTES) + (size_t)b * SEQ * 512 + h * 64; Vg = (const bf16*)(ws + WS_PROJ + 8 * SEG_BYTES) + (size_t)b * SEQ * 512 + h * 64; ycol = 1024 + h * 64; }
    if (MODE == M_DIFF) { Qg = (const bf16*)(ws + WS_PROJ) + (size_t)b * SEQ * 512 + h * 128 + comp * 64; Kg = (const bf16*)(ws + WS_PROJ + 1 * SEG_BYTES) + (size_t)b * SEQ * 512 + h * 128; Vg = (const bf16*)(ws + WS_PROJ + 2 * SEG_BYTES) + (size_t)b * SEQ * 512 + h * 128; ycol = h * 128; }
    if (MODE == M_MEM)  { Qg = (const bf16*)(ws + WS_PROJ + 9 * SEG_BYTES) + (size_t)b * SEQ * 512 + h * 128; Kg = (const bf16*)(ws + WS_MKV) + (size_t)b * MEM_LEN * 1024 + h * 128; Vg = Kg + 512; pitchK = 1024; ycol = 1536 + h * 128; }
    const int NT = (MODE == M_MEM) ? 4 : (q0 + ROWS) / 64;
    const unsigned lds0 = (unsigned)(uintptr_t)L;
    const bf16* ksrc = Kg + (size_t)lane * pitchK + wid * 8;
    const bf16* vsrc = Vg + (size_t)(16 * (wid & 3) + (lane >> 2)) * pitchK + (wid >> 2) * 32 + (lane & 3) * 8;
#define ATT_ISSUE(kt, sl) do { const size_t toff_ = (size_t)(kt) * 64 * pitchK; \
        _Pragma("unroll") for (int i_ = 0; i_ < KCH / 8; ++i_) glds16(ksrc + toff_ + i_ * 64, (unsigned)__builtin_amdgcn_readfirstlane(lds0 + AK_OFF + (sl) * SLOT + (wid + 8 * i_) * 1024)); \
        _Pragma("unroll") for (int i_ = 0; i_ < VPC / 8; ++i_) glds16(vsrc + toff_ + i_ * 64, (unsigned)__builtin_amdgcn_readfirstlane(lds0 + AV_OFF + (sl) * SLOT + (wid + 8 * i_) * 1024)); } while (0)
#define ATT_KT(i) (CAUSAL ? (NT - 1 - (i)) : (i))
    if (MODE == M_FOX) { const float* c2 = (const float*)(ws + WS_C2) + ((size_t)b * NHF + h) * SEQ; glds16(c2 + wid * 256 + lane * 4, (unsigned)__builtin_amdgcn_readfirstlane(lds0 + AC2_OFF + wid * 1024)); }
    ATT_ISSUE(ATT_KT(0), 0);
    if (NT > 1) ATT_ISSUE(ATT_KT(1), 1);
    bf16x8 qr[NQ];
    { const bf16* qp = Qg + (size_t)(wq0 + r32) * 512 + hi * 8;
#pragma unroll
      for (int d0 = 0; d0 < NQ; ++d0) qr[d0] = *(const bf16x8*)(qp + d0 * 16);
#pragma unroll
      for (int d0 = 0; d0 < NQ; ++d0) asm volatile("" : "+v"(qr[d0])); }
    f32x16 o[NDB];
#pragma unroll
    for (int d = 0; d < NDB; ++d)
#pragma unroll
        for (int r = 0; r < 16; ++r) o[d][r] = 0.f;
    constexpr bool FIXREF = (MODE == M_FOX || MODE == M_DIFF);
    bool have_ref = false;
    float m_run = NEG, l_run = 0.f, s_run = 1.0f;
    const int qabs = wq0 + r32;
    const lds_cptr L3 = (lds_cptr)L;
    const lds_cptr kp0 = L3 + AK_OFF + (comp * 8 + hi) * 1024 + r32 * 16;
    const lds_cptr vp0 = L3 + AV_OFF + ((lane >> 4) & 1) * 32 + (lane & 3) * 8 + (4 * hi + ((lane & 15) >> 2)) * 64;
    int sl = 0;
    for (int i = 0; i < NT; ++i) {
        if (i + 1 < NT) asm volatile("s_waitcnt vmcnt(%0) lgkmcnt(0)\n\ts_barrier" :: "n"(NPT) : "memory");
        else asm volatile("s_waitcnt vmcnt(0) lgkmcnt(0)\n\ts_barrier" ::: "memory");
        if (MODE == M_SB) { if (i > 0) {
            const LAS u32x4_t* fp = (const LAS u32x4_t*)(L + AFL_OFF + ((i - 1) & 1) * 32); const u32x4_t f0 = fp[0], f1 = fp[1];
            if (__builtin_amdgcn_readfirstlane((int)((f0.x | f0.y) | (f0.z | f0.w) | (f1.x | f1.y) | (f1.z | f1.w))) == 0) break; } }
        if (i + 2 < NT) { const int sl2 = (sl >= 1) ? sl - 1 : 2; ATT_ISSUE(ATT_KT(i + 2), sl2); }
        const int kt = ATT_KT(i);
        const bool active = !CAUSAL || (kt * 64 <= wq0 + 31);
        if (active) {
            f32x16 p0, p1;
            bf16x8 kf[8];
            const lds_cptr kp = kp0 + sl * SLOT;
#pragma unroll
            for (int d0 = 0; d0 < 4; ++d0) { kf[2 * d0] = *(const LAS bf16x8*)(kp + d0 * 2048); kf[2 * d0 + 1] = *(const LAS bf16x8*)(kp + d0 * 2048 + 512); }
            if (MODE == M_FOX) { const LAS float* cp = (const LAS float*)(L + AC2_OFF) + kt * 64 + 4 * hi;
#pragma unroll
                for (int g = 0; g < 4; ++g) { const f32x4 c0 = *(const LAS f32x4*)(cp + 8 * g), c1 = *(const LAS f32x4*)(cp + 32 + 8 * g);
#pragma unroll
                    for (int j = 0; j < 4; ++j) { p0[4 * g + j] = c0[j]; p1[4 * g + j] = c1[j]; } } }
            else {
#pragma unroll
                for (int r = 0; r < 16; ++r) { p0[r] = 0.f; p1[r] = 0.f; } }
            const bool near = (MODE == M_DIFF) && (kt * 64 > wq0 - 176);
            SBAR();
#pragma unroll
            for (int d0 = 0; d0 < 4; ++d0) { p0 = __builtin_amdgcn_mfma_f32_32x32x16_bf16(kf[2 * d0], qr[d0], p0, 0, 0, 0); p1 = __builtin_amdgcn_mfma_f32_32x32x16_bf16(kf[2 * d0 + 1], qr[d0], p1, 0, 0, 0); }
            if (NQ > 4) { SBAR();
#pragma unroll
                for (int d0 = 0; d0 < 4; ++d0) { kf[2 * d0] = *(const LAS bf16x8*)(kp + (d0 + 4) * 2048); kf[2 * d0 + 1] = *(const LAS bf16x8*)(kp + (d0 + 4) * 2048 + 512); }
                SBAR();
#pragma unroll
                for (int d0 = 0; d0 < 4; ++d0) { p0 = __builtin_amdgcn_mfma_f32_32x32x16_bf16(kf[2 * d0], qr[NQ > 4 ? d0 + 4 : d0], p0, 0, 0, 0); p1 = __builtin_amdgcn_mfma_f32_32x32x16_bf16(kf[2 * d0 + 1], qr[NQ > 4 ? d0 + 4 : d0], p1, 0, 0, 0); } }
            SBAR();
            s16x4 vlo[4 * NDB], vhi[4 * NDB];
            { const lds_cptr vp = vp0 + sl * SLOT;
#pragma unroll
              for (int d = 0; d < NDB; ++d)
#pragma unroll
                for (int ks = 0; ks < 4; ++ks) { vlo[4 * d + ks] = vtr(vp + d * 4096 + ks * 1024); vhi[4 * d + ks] = vtr(vp + d * 4096 + ks * 1024 + 512); } }
            SBAR();
            unsigned pw[16];
            if (MODE == M_SB) {
                if (kt * 64 + 63 >= wq0) { const int kb = kt * 64 + 4 * hi;
#pragma unroll
                    for (int r = 0; r < 16; ++r) { const int kv = kb + kcol(r); if (kv >= qabs) p0[r] = NEG; if (kv + 32 >= qabs) p1[r] = NEG; } }
                f32x16 l0, l1;
#pragma unroll
                for (int r = 0; r < 16; ++r) { l0[r] = __builtin_amdgcn_rcpf(1.0f + ex2(p0[r])); l1[r] = __builtin_amdgcn_rcpf(1.0f + ex2(p1[r])); }
#pragma unroll
                for (int hf = 1; hf >= 0; --hf)
#pragma unroll
                    for (int g = 3; g >= 0; --g) {
                        const float a0 = hf ? l1[4 * g] : l0[4 * g], a1 = hf ? l1[4 * g + 1] : l0[4 * g + 1], a2 = hf ? l1[4 * g + 2] : l0[4 * g + 2], a3 = hf ? l1[4 * g + 3] : l0[4 * g + 3];
                        const float town = (a0 * a1) * (a2 * a3);
                        const auto sw = __builtin_amdgcn_permlane32_swap(__float_as_uint(town), __float_as_uint(town), false, false);
                        const float v0 = __uint_as_float(sw[0]), v1 = __uint_as_float(sw[1]);
                        const float t3 = s_run * (hi ? 1.0f : v1), t2 = t3 * a3, t1 = t2 * a2, t0 = t1 * a1;
                        const float w0 = (1.0f - a0) * t0, w1 = (1.0f - a1) * t1, w2 = (1.0f - a2) * t2, w3 = (1.0f - a3) * t3;
                        pw[hf * 8 + g * 2] = cvtpk(w0, w1); pw[hf * 8 + g * 2 + 1] = cvtpk(w2, w3);
                        s_run *= v0 * v1;
                    }
            } else {
                if (MODE == M_DIFF) { if (near) { const LAS float* tp = (const LAS float*)(L + ATB_OFF) + h * TBN + (223 - (wq0 - kt * 64 + r32 - 4 * hi));
#pragma unroll
                    for (int r = 0; r < 16; ++r) { p0[r] += tp[kcol(r)]; p1[r] += tp[32 + kcol(r)]; } } }
                if (CAUSAL) { if (kt * 64 + 63 > wq0) { const int kb = kt * 64 + 4 * hi;
#pragma unroll
                    for (int r = 0; r < 16; ++r) { const int kv = kb + kcol(r); if (kv > qabs) p0[r] = NEG; if (kv + 32 > qabs) p1[r] = NEG; } } }
                if (!FIXREF || !have_ref) {
                float ra = fmaxf(fmaxf(p0[0], p0[1]), p1[0]), rb = fmaxf(fmaxf(p0[2], p0[3]), p1[1]); ra = fmaxf(fmaxf(ra, p1[2]), p1[3]);
#pragma unroll
                for (int r = 4; r < 16; r += 4) { ra = fmaxf(fmaxf(ra, p0[r]), p0[r + 1]); rb = fmaxf(fmaxf(rb, p0[r + 2]), p0[r + 3]); ra = fmaxf(fmaxf(ra, p1[r]), p1[r + 1]); rb = fmaxf(fmaxf(rb, p1[r + 2]), p1[r + 3]); }
                const float rm = xmax(fmaxf(ra, rb));
                if (FIXREF) { m_run = rm; have_ref = true; }
                else { const float mn = fmaxf(m_run, rm);
                if (__any(mn > m_run)) { const float al = ex2(m_run - mn); l_run *= al; m_run = mn;
#pragma unroll
                    for (int d = 0; d < NDB; ++d)
#pragma unroll
                        for (int r = 0; r < 16; ++r) o[d][r] *= al; } }
                }
                float sa = 0.f, sb = 0.f;
#pragma unroll
                for (int r = 0; r < 16; ++r) { p0[r] = ex2(p0[r] - m_run); p1[r] = ex2(p1[r] - m_run); sa += p0[r]; sb += p1[r]; }
                l_run += sa + sb;
#pragma unroll
                for (int w = 0; w < 8; ++w) { pw[w] = cvtpk(p0[2 * w], p0[2 * w + 1]); pw[8 + w] = cvtpk(p1[2 * w], p1[2 * w + 1]); }
            }
            SBAR();
#pragma unroll
            for (int ks = 0; ks < 4; ++ks) { const u32x4_t pf = (u32x4_t){pw[4 * ks], pw[4 * ks + 1], pw[4 * ks + 2], pw[4 * ks + 3]};
#pragma unroll
                for (int d = 0; d < NDB; ++d) { const s16x4 lo = vlo[4 * d + ks], hh = vhi[4 * d + ks];
                    const bf16x8 vf = (bf16x8){lo[0], lo[1], lo[2], lo[3], hh[0], hh[1], hh[2], hh[3]};
                    o[d] = __builtin_amdgcn_mfma_f32_32x32x16_bf16(vf, __builtin_bit_cast(bf16x8, pf), o[d], 0, 0, 0); } }
        }
        if (MODE == M_SB) { const bool alive = !active || __any(s_run != 0.0f);
            if (lane == 0) ((LAS unsigned*)(L + AFL_OFF + (i & 1) * 32))[wid] = alive ? 1u : 0u; }
        sl = (sl == 2) ? 0 : sl + 1;
    }
    if (MODE == M_SB) asm volatile("s_waitcnt vmcnt(0)" ::: "memory");
    if (MODE != M_SB) { const float il = 1.0f / xsum(l_run);
#pragma unroll
        for (int d = 0; d < NDB; ++d)
#pragma unroll
            for (int r = 0; r < 16; ++r) o[d][r] *= il; }
    if (MODE == M_DIFF) {
        asm volatile("s_waitcnt lgkmcnt(0)\n\ts_barrier" ::: "memory");
        LAS float* X = (LAS float*)(L + AX_OFF) + wrow * 4096 + lane;
        if (comp == 1) {
#pragma unroll
            for (int d = 0; d < NDB; ++d)
#pragma unroll
                for (int r = 0; r < 16; ++r) X[(d * 16 + r) * 64] = o[d][r] * lam; }
        asm volatile("s_waitcnt lgkmcnt(0)\n\ts_barrier" ::: "memory");
        if (comp == 0) { float ss = 0.f;
#pragma unroll
            for (int d = 0; d < NDB; ++d)
#pragma unroll
                for (int r = 0; r < 16; ++r) { o[d][r] -= X[(d * 16 + r) * 64]; ss += o[d][r] * o[d][r]; }
            ss = xsum(ss);
            const float rn = (1.0f / sqrtf(ss * (1.0f / 128.0f) + EPS)) * (1.0f - lam_init);
            const float* gn = A->in[10] + layer * 128 + 4 * hi;
#pragma unroll
            for (int d = 0; d < NDB; ++d)
#pragma unroll
                for (int g = 0; g < 4; ++g) { const f32x4 gv = *(const f32x4*)(gn + 32 * d + 8 * g);
#pragma unroll
                    for (int j = 0; j < 4; ++j) o[d][4 * g + j] *= rn * gv[j]; } }
    }
    if (MODE != M_DIFF || comp == 0) {
        bf16* yrow = (bf16*)(A->ws + WS_Y) + (size_t)((size_t)b * SEQ + wq0 + r32) * 2048 + ycol + 4 * hi;
#pragma unroll
        for (int d = 0; d < NDB; ++d)
#pragma unroll
            for (int g = 0; g < 4; ++g) { uint2 u = *(const uint2*)(yrow + 32 * d + 8 * g);
                u.x = pk2(o[d][4 * g] * __uint_as_float(u.x << 16), o[d][4 * g + 1] * __uint_as_float(u.x & 0xffff0000u));
                u.y = pk2(o[d][4 * g + 2] * __uint_as_float(u.y << 16), o[d][4 * g + 3] * __uint_as_float(u.y & 0xffff0000u));
                *(uint2*)(yrow + 32 * d + 8 * g) = u; }
    }
    if (MODE == M_DIFF) asm volatile("s_waitcnt lgkmcnt(0)\n\ts_barrier" ::: "memory");
#undef ATT_ISSUE
#undef ATT_KT
}

constexpr int NU_MAIN = 192, NU_Q = 448;
struct UnitD { int mode, b, h, qb; };
__device__ __forceinline__ UnitD decode_unit(int x, int k) {
    UnitD u;
    if (k < NU_MAIN) { const int jj = k / 24, r = k % 24;
        if (r < 12)      { u.mode = M_DIFF; const int bh = 8 * jj + x;          u.b = bh >> 2; u.h = bh & 3; u.qb = 15 - r; }
        else if (r < 18) { u.mode = M_FOX; const int bh = 8 * (2 * jj) + x;     u.b = bh >> 3; u.h = bh & 7; u.qb = 7 - (r - 12); }
        else             { u.mode = M_FOX; const int bh = 8 * (2 * jj + 1) + x; u.b = bh >> 3; u.h = bh & 7; u.qb = 7 - (r - 18); }
        return u; }
    int r = k - NU_MAIN;
    if (r < 128) { u.mode = M_SB; const int bh = 8 * (r >> 3) + x; u.b = bh >> 3; u.h = bh & 7; u.qb = 7 - (r & 7); return u; } r -= 128;
    if (r < 8)  { u.mode = M_DIFF; const int bh = 8 * r + x; u.b = bh >> 2; u.h = bh & 3; u.qb = 3; return u; } r -= 8;
    if (r < 16) { u.mode = M_FOX; const int bh = 8 * r + x; u.b = bh >> 3; u.h = bh & 7; u.qb = 1; return u; } r -= 16;
    if (r < 8)  { u.mode = M_DIFF; const int bh = 8 * r + x; u.b = bh >> 2; u.h = bh & 3; u.qb = 2; return u; } r -= 8;
    if (r < 8)  { u.mode = M_DIFF; const int bh = 8 * r + x; u.b = bh >> 2; u.h = bh & 3; u.qb = 1; return u; } r -= 8;
    if (r < 16) { u.mode = M_FOX; const int bh = 8 * r + x; u.b = bh >> 3; u.h = bh & 7; u.qb = 0; return u; } r -= 16;
    if (r < 64) { u.mode = M_MEM; const int bh = 8 * (r >> 3) + x; u.b = bh >> 2; u.h = bh & 3; u.qb = r & 7; return u; } r -= 64;
    { u.mode = M_DIFF; const int bh = 8 * r + x; u.b = bh >> 2; u.h = bh & 3; u.qb = 0; return u; }
}
__device__ __forceinline__ void attn_phase(Frame& F0, int layer) {
    Frame F = F0; asm volatile("" : "+v"(F.lane), "+v"(F.tid));
    LAS unsigned char* L = F.lds;
    { LAS float* tb = (LAS float*)(L + ATB_OFF); const float* relb = F.a->in[11];
      for (int i = F.tid; i < 4 * TBN; i += NWAVES * 64) { const int h = i / TBN, j = i % TBN, dist = 223 - j; float v = 0.f;
          if (dist >= 0 && dist < 113) v = (relb[t5_bucket(dist) * 4 + h] - relb[31 * 4 + h]) * LOG2E;
          tb[i] = v; } }
    float lam_init, lam;
    { const float* dl = F.a->in[9] + layer * 256; const float s1 = wave_sum(dl[F.lane] * dl[64 + F.lane]), s2 = wave_sum(dl[128 + F.lane] * dl[192 + F.lane]);
      lam_init = 0.8f - 0.6f * expf(-0.3f * (float)layer); lam = expf(s1) - expf(s2) + lam_init; }
    if (F.wave >= 4) __builtin_amdgcn_s_setprio(1);
    const int x0 = (int)(xb_xcc_id() & 7u);
    for (int xi = 0; xi < 8; ++xi) {
        const int x = (x0 + xi) & 7;
        gu32* qh = F.ctl + CW_QUEUE + 64 * (layer * 8 + x);
        for (;;) {
            if (F.tid == 0) *(volatile LAS unsigned*)(L + AQW_OFF) = __hip_atomic_fetch_add(qh, 1u, __ATOMIC_RELAXED, __HIP_MEMORY_SCOPE_AGENT);
            __syncthreads();
            const int k = __builtin_amdgcn_readfirstlane((int)*(volatile LAS unsigned*)(L + AQW_OFF));
            if (k >= NU_Q) break;
            const UnitD u = decode_unit(x, k);
            if (u.mode == M_SB) attn_unit<M_SB>(F.a, L, u.b, u.h, u.qb, layer, lam, lam_init);
            else if (u.mode == M_FOX) attn_unit<M_FOX>(F.a, L, u.b, u.h, u.qb, layer, lam, lam_init);
            else if (u.mode == M_DIFF) attn_unit<M_DIFF>(F.a, L, u.b, u.h, u.qb, layer, lam, lam_init);
            else attn_unit<M_MEM>(F.a, L, u.b, u.h, u.qb, layer, lam, lam_init);
        }
        __syncthreads();
    }
    __builtin_amdgcn_s_setprio(0);
}
#undef SBAR
}


constexpr int N_PHASES = 9;
#ifndef MK_ONE_LAUNCH
#define MK_ONE_LAUNCH 1
#endif
#ifndef MK_NAIVE_ATTN
#define MK_NAIVE_ATTN 0
#endif
__global__ void __launch_bounds__(NWAVES * 64, 2) mega_fwd(Args args) {
    extern __shared__ __attribute__((aligned(16))) unsigned char lds[];
    Frame F;
    F.lds = (LAS unsigned char*)lds;
    F.MISC = (volatile LAS unsigned*)(F.lds + MISC_OFF);
    F.tid = threadIdx.x; F.lane = F.tid & 63; F.wave = __builtin_amdgcn_readfirstlane(F.tid >> 6);
    F.G = gridDim.x; { const int bx = blockIdx.x; F.vcu = (F.G % 8 == 0) ? (bx % 8) * (F.G / 8) + bx / 8 : bx; }
    F.a = &args; F.ctl = (gu32*)(args.ws + WS_CTL);
    for (int u = F.tid; u < (LDS_BYTES - LDSCTL_OFF) / 4; u += NWAVES * 64) ((LAS unsigned*)(F.lds + LDSCTL_OFF))[u] = 0u;
    __syncthreads();
    XcdBarrier bar; bar.bar = (unsigned*)(F.ctl + CW_BAR); bar.x = 0; bar.st = nullptr;
    if (MK_ONE_LAUNCH) bar = xcd_barrier_post((unsigned*)(F.ctl + CW_BAR), F.MISC + 8);
    const int lo = args.ph_lo, hi = args.ph_hi;
#define IN(k) (lo <= (k) && (k) < hi)
#define SEAM(k) do { if (IN(k) && IN((k) + 1)) xcd_barrier(bar); } while (0)
    for (int l = 0; l < 2; ++l) {
        if (IN(4 * l + 0)) { p0_weights(F, l); p0_mem_rows(F, l); p0_rows(F, l); }
        SEAM(4 * l + 0);
        if (IN(4 * l + 1)) {
            cumsum_logf(F);
            { pg8::Gemm g{(const bf16*)F_OUT(F) + 1024, (const bf16*)(F_WS(F) + WS_WIN), MROWS, NPROJ, DMODEL, 2048}; pg8::StaticOrder S; S.init(MROWS, NPROJ, F.G, (int)blockIdx.x);
              pg8::EpiProj E{(bf16*)(F_WS(F) + WS_PROJ), (bf16*)(F_WS(F) + WS_Y), SEG_BYTES / 2};
              pg8::gemm_phase<pg8::EpiProj, pg8::StaticOrder, true, true>(F.lds, g, S, E); }
            { pg8::Gemm g{(const bf16*)(F_WS(F) + WS_HM), (const bf16*)(F_WS(F) + WS_WMKV), MMEM, 1024, DMODEL, DMODEL}; pg8::StaticOrder S; S.init(MMEM, 1024, F.G, (int)blockIdx.x);
              pg8::EpiBf16 E{(bf16*)(F_WS(F) + WS_MKV), 1024};
              pg8::gemm_phase<pg8::EpiBf16, pg8::StaticOrder, true, true>(F.lds, g, S, E); }
        }
        SEAM(4 * l + 1);
        if (IN(4 * l + 2)) att::attn_phase(F, l);
        SEAM(4 * l + 2);
        if (IN(4 * l + 3)) {
            pg8::Gemm g{(const bf16*)(F_WS(F) + WS_Y), (const bf16*)(F_WS(F) + WS_WOUT), MROWS, DMODEL, DMIX, DMIX}; pg8::StaticOrder S; S.init(MROWS, DMODEL, F.G, (int)blockIdx.x);
            pg8::EpiBf16 E{(bf16*)(F_WS(F) + WS_OG), DMODEL};
            pg8::gemm_phase<pg8::EpiBf16, pg8::StaticOrder, true, true>(F.lds, g, S, E);
        }
        SEAM(4 * l + 3);
    }
    if (IN(8)) p0_rows(F, 2);
#undef IN
#undef SEAM
}

extern "C" void kernel_launch(void* const* d_in, const int* in_sizes, int n_in, void* d_out, int out_size, void* d_ws, size_t ws_size, hipStream_t stream) {
    static int grid = 0;
    if (grid == 0) {
        if (n_in != 12 || out_size != MROWS * DMODEL || ws_size < WS_END) { fprintf(stderr, "kernel_launch: unexpected shapes (n_in %d out %d ws %zu)\n", n_in, out_size, ws_size); grid = -1; return; }
        int dev = 0, cus = 0, per_cu = 0;
        if (hipGetDevice(&dev) != hipSuccess || hipDeviceGetAttribute(&cus, hipDeviceAttributeMultiprocessorCount, dev) != hipSuccess) { grid = -1; return; }
        if (hipFuncSetAttribute((const void*)mega_fwd, hipFuncAttributeMaxDynamicSharedMemorySize, LDS_BYTES) != hipSuccess) { fprintf(stderr, "kernel_launch: hipFuncSetAttribute failed\n"); grid = -1; return; }
        if (hipOccupancyMaxActiveBlocksPerMultiprocessor(&per_cu, (const void*)mega_fwd, NWAVES * 64, LDS_BYTES) != hipSuccess || per_cu < 1) fprintf(stderr, "kernel_launch: occupancy query says %d\n", per_cu);
        (void)hipGetLastError();
        grid = cus;
    }
    if (grid < 0) return;
    (void)hipMemsetAsync((char*)d_ws + WS_CTL, 0, CTL_ZERO_BYTES, stream);
    Args a{};
    for (int i = 0; i < 12; ++i) a.in[i] = (const float*)d_in[i];
    a.out = (float*)d_out; a.ws = (unsigned char*)d_ws;
#if MK_ONE_LAUNCH
    a.ph_lo = 0; a.ph_hi = N_PHASES;
    hipLaunchKernelGGL(mega_fwd, dim3(grid), dim3(NWAVES * 64), LDS_BYTES, stream, a);
#else
    for (int p = 0; p < N_PHASES; ++p) {
        if (MK_NAIVE_ATTN && (p == 2 || p == 6)) {
            NArgs na{}; na.ws = (const unsigned char*)d_ws; na.wsw = (unsigned char*)d_ws; na.diff_lambda = (const float*)d_in[9]; na.diff_head_norm = (const float*)d_in[10]; na.rel_bias = (const float*)d_in[11]; na.layer = p / 4;
            hipLaunchKernelGGL(naive_diff, dim3(BATCH * 4 * 8), dim3(256), 0, stream, na);
            hipLaunchKernelGGL(naive_sb, dim3(BATCH * 8 * 8), dim3(256), 0, stream, na);
            hipLaunchKernelGGL(naive_fox, dim3(BATCH * 8 * 8), dim3(256), 0, stream, na);
            hipLaunchKernelGGL(naive_mem, dim3(BATCH * 4 * 8), dim3(256), 0, stream, na);
            continue;
        }
        a.ph_lo = p; a.ph_hi = p + 1;
        hipLaunchKernelGGL(mega_fwd, dim3(grid), dim3(NWAVES * 64), LDS_BYTES, stream, a);
    }
#endif
}
```

```cpp
#include <hip/hip_runtime.h>
#include <cstdio>
#include <cstdint>
#define PG8_TRANSPOSED 1
namespace pg8 {
#define PG8_LAS __attribute__((address_space(3)))
typedef unsigned short bf16_t;
typedef short bf16x8 __attribute__((ext_vector_type(8)));
typedef float f32x4 __attribute__((ext_vector_type(4)));
typedef unsigned u32x4 __attribute__((ext_vector_type(4)));
constexpr int BM = 256, BK = 64, HALF = 128, HTB = HALF * BK * 2  , STAGE_BYTES = 8 * HTB, NXCD = 8, WGM = 4;

__host__ __device__ __forceinline__ int lds_byte(int r, int c) { const int st = (r >> 4) * 2 + (c >> 5), rr = r & 15, cc = c & 31, ob = rr * 64 + cc * 2; return st * 1024 + (ob ^ (((ob >> 9) & 1) << 5)); }
__host__ __device__ __forceinline__ void stage_rc(int b, int& R, int& C) { const int st = b / 1024, sb = b % 1024, swz = sb ^ (((sb >> 9) & 1) << 5); R = (st >> 1) * 16 + swz / 64; C = (st & 1) * 32 + (swz % 64) / 2; }
__host__ __device__ __forceinline__ int perm32(int rho) { const int n = rho >> 4, i = rho & 15; return 8 * (i >> 2) + 4 * n + (i & 3); }

struct Unit { int pm, pn; };
struct Gemm { const bf16_t* A; const bf16_t* Bt; int M, N, K, lda; };

struct StaticOrder {
    int nM, nN, nwg, G, c;
    __host__ __device__ void init(int M, int N, int G_, int c_) { nM = M / BM; nN = N / BM; nwg = nM * nN; G = G_; c = c_; }
    __host__ __device__ bool next(int i, Unit& u) const {
        const long L = (long)i * G + c; if (L >= nwg) return false;
        int wgid = (int)L; { const int q = nwg / NXCD, r = nwg % NXCD, xcd = wgid % NXCD, off = wgid / NXCD; wgid = (xcd < r ? xcd * (q + 1) : r * (q + 1) + (xcd - r) * q) + off; }
#if PG8_TRANSPOSED
        const int nig = WGM * nM, gid = wgid / nig, fn = gid * WGM, gsz = (nN - fn) < WGM ? (nN - fn) : WGM;
        u.pn = fn + ((wgid % nig) % gsz); u.pm = (wgid % nig) / gsz; return true;
#else
        const int nig = WGM * nN, gid = wgid / nig, fm = gid * WGM, gsz = (nM - fm) < WGM ? (nM - fm) : WGM;
        u.pm = fm + ((wgid % nig) % gsz); u.pn = (wgid % nig) / gsz; return true;
#endif
    }
    __device__ __forceinline__ void a_ready(const Unit&) const {}
    __device__ __forceinline__ void done(const Unit&) const {}
};

__device__ __forceinline__ unsigned cvt_pk_bf16(float lo, float hi) { unsigned r; asm volatile("v_cvt_pk_bf16_f32 %0, %1, %2" : "=v"(r) : "v"(lo), "v"(hi)); return r; }

struct EpiBf16 {
    static constexpr bool PERM = true, AFTER_DRAIN = false;
    bf16_t* O; int ldc;
    __device__ __forceinline__ void operator()(const f32x4 (&acc)[2][2][4][2], const Unit& u, int wr, int wc, int fr, int fq) const {
        const int row0 = u.pm * BM + wr * 64 + fr; const int col0 = u.pn * BM + wc * 32 + 8 * fq;
#pragma unroll
        for (int ai = 0; ai < 2; ++ai)
#pragma unroll
            for (int m = 0; m < 4; ++m) { bf16_t* rowp = O + (size_t)(row0 + ai * HALF + m * 16) * ldc + col0;
#pragma unroll
                for (int bj = 0; bj < 2; ++bj) { const f32x4 v0 = acc[ai][bj][m][0], v1 = acc[ai][bj][m][1];
                    u32x4 w; w.x = cvt_pk_bf16(v0[0], v0[1]); w.y = cvt_pk_bf16(v0[2], v0[3]); w.z = cvt_pk_bf16(v1[0], v1[1]); w.w = cvt_pk_bf16(v1[2], v1[3]);
                    *(u32x4*)(rowp + bj * HALF) = w; } }
    }
};
__device__ __forceinline__ float silu_f(float v) { return v * __builtin_amdgcn_rcpf(1.0f + __builtin_amdgcn_exp2f(-1.4426950408889634f * v)); }
struct EpiProj {
    static constexpr bool PERM = true, AFTER_DRAIN = false;
    bf16_t* proj; bf16_t* y; size_t seg_stride;
    __device__ __forceinline__ void operator()(const f32x4 (&acc)[2][2][4][2], const Unit& u, int wr, int wc, int fr, int fq) const {
        const int row0 = u.pm * BM + wr * 64 + fr; const int colt = u.pn * BM; const bool gate = colt >= 5120;
        bf16_t* base; int ldc, col0;
        if (gate) { base = y; ldc = 2048; col0 = colt - 5120 + wc * 32 + 8 * fq; }
        else { base = proj + (size_t)(colt >> 9) * seg_stride; ldc = 512; col0 = (colt & 511) + wc * 32 + 8 * fq; }
#pragma unroll
        for (int ai = 0; ai < 2; ++ai)
#pragma unroll
            for (int m = 0; m < 4; ++m) { bf16_t* rowp = base + (size_t)(row0 + ai * HALF + m * 16) * ldc + col0;
#pragma unroll
                for (int bj = 0; bj < 2; ++bj) { f32x4 v0 = acc[ai][bj][m][0], v1 = acc[ai][bj][m][1];
                    if (gate) {
#pragma unroll
                        for (int e = 0; e < 4; ++e) { v0[e] = silu_f(v0[e]); v1[e] = silu_f(v1[e]); } }
                    u32x4 w; w.x = cvt_pk_bf16(v0[0], v0[1]); w.y = cvt_pk_bf16(v0[2], v0[3]); w.z = cvt_pk_bf16(v1[0], v1[1]); w.w = cvt_pk_bf16(v1[2], v1[3]);
                    *(u32x4*)(rowp + bj * HALF) = w; } }
    }
};
struct EpiF32 {
    static constexpr bool PERM = false, AFTER_DRAIN = false;
    float* O; int ldc;
    __device__ __forceinline__ void operator()(const f32x4 (&acc)[2][2][4][2], const Unit& u, int wr, int wc, int fr, int fq) const {
        const int col0 = u.pn * BM + wc * 32 + 4 * fq;
#pragma unroll
        for (int ai = 0; ai < 2; ++ai)
#pragma unroll
            for (int m = 0; m < 4; ++m) { float* rowp = O + (size_t)(u.pm * BM + ai * HALF + wr * 64 + m * 16 + fr) * ldc + col0;
#pragma unroll
                for (int bj = 0; bj < 2; ++bj)
#pragma unroll
                    for (int n = 0; n < 2; ++n) *(f32x4*)(rowp + bj * HALF + n * 16) = acc[ai][bj][m][n]; }
    }
};

template <class Epi, class Sched, bool ALIGN_EPI = false, bool SP2 = false>
__device__ __forceinline__ void gemm_phase(PG8_LAS unsigned char* lds, const Gemm g, const Sched& S, const Epi& E) {
    int tid_ = threadIdx.x; asm volatile("" : "+v"(tid_));
    const int tid = tid_, wid = __builtin_amdgcn_readfirstlane(tid >> 6), lane = tid & 63, wr = wid >> 2, wc = wid & 3, fr = lane & 15, fq = lane >> 4;
    const int K = g.K, nt = K / BK;
    unsigned voffA[2], voffB[2];
#pragma unroll
    for (int i = 0; i < 2; ++i) { int R, C; stage_rc(tid * 16 + i * 8192, R, C); const int Rb = Epi::PERM ? ((R & ~31) + perm32(R & 31)) : R;
        voffA[i] = (unsigned)(R * g.lda + C) * 2u; voffB[i] = (unsigned)(Rb * K + C) * 2u; }
    const size_t kstep = (size_t)(BK * 2);
    const size_t hstepA = (size_t)HALF * g.lda * 2, hstepB = (size_t)HALF * K * 2;
    const size_t tstepA = 2 * hstepA, tstepB = 2 * hstepB;
    const unsigned ldsw = (unsigned)wid * 1024u;
    const int aoff = lds_byte(wr * 64 + fr, fq * 8), boff = lds_byte(wc * 32 + fr, fq * 8);
#define PG8_SA(b, h) (((b) * 2 + (h)) * HTB)
#define PG8_SB(b, h) ((4 + (b) * 2 + (h)) * HTB)
#define PG8_STAGE(bufoff, gbase, voff) do { _Pragma("unroll") for (int _i = 0; _i < 2; ++_i) \
        __builtin_amdgcn_global_load_lds((const unsigned*)((const char*)(gbase) + (voff)[_i]), (PG8_LAS unsigned*)(lds + (bufoff) + ldsw + _i * 8192), 16, 0, 0); } while (0)
#define PG8_LDA(dst, b, h) do { _Pragma("unroll") for (int m = 0; m < 4; ++m) _Pragma("unroll") for (int k = 0; k < 2; ++k) dst[m][k] = *(const PG8_LAS bf16x8*)(lds + PG8_SA(b, h) + aoff + m * 2048 + k * 1024); } while (0)
#define PG8_LDB(dst, b, h) do { _Pragma("unroll") for (int n = 0; n < 2; ++n) _Pragma("unroll") for (int k = 0; k < 2; ++k) dst[n][k] = *(const PG8_LAS bf16x8*)(lds + PG8_SB(b, h) + boff + n * 2048 + k * 1024); } while (0)
#define PG8_MMA(ai, bj, At, Bt) do { __builtin_amdgcn_s_setprio(1); _Pragma("unroll") for (int m = 0; m < 4; ++m) _Pragma("unroll") for (int n = 0; n < 2; ++n) _Pragma("unroll") for (int k = 0; k < 2; ++k) \
        acc[ai][bj][m][n] = __builtin_amdgcn_mfma_f32_16x16x32_bf16(Bt[n][k], At[m][k], acc[ai][bj][m][n], 0, 0, 0); __builtin_amdgcn_s_setprio(0); } while (0)
#define PG8_WAIT_V(n) asm volatile("s_waitcnt vmcnt(" #n ")" ::: "memory")
#define PG8_WAIT_L(n) asm volatile("s_waitcnt lgkmcnt(" #n ")" ::: "memory")
#define PG8_BAR __builtin_amdgcn_s_barrier()
#define PG8_SCHED __builtin_amdgcn_sched_barrier(0)
    Unit cur, nxt; int ui = 0;
    if (!S.next(0, cur)) return;
    f32x4 acc[2][2][4][2];
#pragma unroll
    for (int a = 0; a < 2; ++a)
#pragma unroll
        for (int b = 0; b < 2; ++b)
#pragma unroll
            for (int m = 0; m < 4; ++m)
#pragma unroll
                for (int n = 0; n < 2; ++n) acc[a][b][m][n] = (f32x4){0.f, 0.f, 0.f, 0.f};
    bf16x8 At[4][2], B0[2][2], B1[2][2];
    const char* cA = (const char*)g.A + (size_t)cur.pm * tstepA; const char* cB = (const char*)g.Bt + (size_t)cur.pn * tstepB;
    S.a_ready(cur);
    if constexpr (SP2) {
        PG8_STAGE(PG8_SB(0, 0), cB, voffB); PG8_STAGE(PG8_SB(0, 1), cB + hstepB, voffB); PG8_STAGE(PG8_SA(0, 0), cA, voffA); PG8_STAGE(PG8_SA(0, 1), cA + hstepA, voffA);
        if (wr == 1) PG8_BAR;
        PG8_WAIT_V(2); PG8_BAR;
        PG8_STAGE(PG8_SB(1, 0), cB + kstep, voffB); PG8_STAGE(PG8_SA(1, 0), cA + kstep, voffA); PG8_STAGE(PG8_SB(1, 1), cB + hstepB + kstep, voffB);
        PG8_WAIT_V(6); PG8_BAR;
    } else {
        PG8_STAGE(PG8_SB(0, 0), cB, voffB); PG8_STAGE(PG8_SA(0, 0), cA, voffA); PG8_STAGE(PG8_SB(0, 1), cB + hstepB, voffB); PG8_STAGE(PG8_SA(0, 1), cA + hstepA, voffA);
        if (wr == 1) PG8_BAR;
        PG8_WAIT_V(4); PG8_BAR;
        PG8_STAGE(PG8_SB(1, 0), cB + kstep, voffB); PG8_STAGE(PG8_SA(1, 0), cA + kstep, voffA); PG8_STAGE(PG8_SB(1, 1), cB + hstepB + kstep, voffB);
        PG8_WAIT_V(6); PG8_BAR;
    }
    for (;;) {
        const bool has_next = S.next(ui + 1, nxt);
        const char* nA = has_next ? (const char*)g.A + (size_t)nxt.pm * tstepA : cA; const char* nB = has_next ? (const char*)g.Bt + (size_t)nxt.pn * tstepB : cB;
        for (int t = 0; t < nt; t += 2) {
            const bool last = (t == nt - 2);
            const char* a1 = cA + (size_t)(t + 1) * kstep;
            const char* a2 = last ? nA : cA + (size_t)(t + 2) * kstep; const char* b2 = last ? nB : cB + (size_t)(t + 2) * kstep;
            const char* a3 = a2 + kstep; const char* b3 = b2 + kstep;
            if (last && has_next) S.a_ready(nxt);
            if constexpr (SP2) {
            PG8_LDB(B0, 0, 0); PG8_LDB(B1, 0, 1); PG8_SCHED; PG8_LDA(At, 0, 0); PG8_STAGE(PG8_SA(1, 1), a1 + hstepA, voffA);
            PG8_WAIT_V(8); PG8_WAIT_L(0); PG8_BAR; PG8_MMA(0, 0, At, B0); PG8_MMA(0, 1, At, B1); PG8_BAR; PG8_SCHED;
            PG8_LDA(At, 0, 1); PG8_STAGE(PG8_SB(0, 0), b2, voffB); PG8_STAGE(PG8_SB(0, 1), b2 + hstepB, voffB); PG8_STAGE(PG8_SA(0, 0), a2, voffA);
            PG8_WAIT_V(8); PG8_WAIT_L(0); PG8_BAR; PG8_MMA(1, 0, At, B0); PG8_MMA(1, 1, At, B1); PG8_BAR; PG8_SCHED;
            PG8_LDB(B0, 1, 0); PG8_LDB(B1, 1, 1); PG8_SCHED; PG8_LDA(At, 1, 0); PG8_STAGE(PG8_SA(0, 1), a2 + hstepA, voffA);
            PG8_WAIT_V(8); PG8_WAIT_L(0); PG8_BAR; PG8_MMA(0, 0, At, B0); PG8_MMA(0, 1, At, B1); PG8_BAR; PG8_SCHED;
            PG8_LDA(At, 1, 1); PG8_STAGE(PG8_SB(1, 0), b3, voffB); PG8_STAGE(PG8_SB(1, 1), b3 + hstepB, voffB); PG8_STAGE(PG8_SA(1, 0), a3, voffA);
            PG8_WAIT_V(8); PG8_WAIT_L(0); PG8_BAR; PG8_MMA(1, 0, At, B0); PG8_MMA(1, 1, At, B1); PG8_BAR; PG8_SCHED;
            } else {
            PG8_LDB(B0, 0, 0); PG8_SCHED; PG8_LDA(At, 0, 0); PG8_STAGE(PG8_SA(1, 1), a1 + hstepA, voffA);
            PG8_WAIT_L(8); PG8_BAR; PG8_WAIT_L(0); PG8_MMA(0, 0, At, B0); PG8_BAR; PG8_SCHED;
            PG8_LDB(B1, 0, 1); PG8_STAGE(PG8_SB(0, 0), b2, voffB);
            PG8_BAR; PG8_WAIT_L(0); PG8_MMA(0, 1, At, B1); PG8_BAR;
            PG8_LDA(At, 0, 1); PG8_STAGE(PG8_SA(0, 0), a2, voffA);
            PG8_BAR; PG8_WAIT_L(0); PG8_MMA(1, 0, At, B0); PG8_BAR; PG8_SCHED;
            PG8_STAGE(PG8_SB(0, 1), b2 + hstepB, voffB);
            PG8_WAIT_V(6); PG8_BAR; PG8_MMA(1, 1, At, B1); PG8_BAR;
            PG8_LDB(B0, 1, 0); PG8_SCHED; PG8_LDA(At, 1, 0); PG8_STAGE(PG8_SA(0, 1), a2 + hstepA, voffA);
            PG8_WAIT_L(8); PG8_BAR; PG8_WAIT_L(0); PG8_MMA(0, 0, At, B0); PG8_BAR; PG8_SCHED;
            PG8_LDB(B1, 1, 1); PG8_STAGE(PG8_SB(1, 0), b3, voffB);
            PG8_BAR; PG8_WAIT_L(0); PG8_MMA(0, 1, At, B1); PG8_BAR;
            PG8_LDA(At, 1, 1); PG8_STAGE(PG8_SA(1, 0), a3, voffA);
            PG8_BAR; PG8_WAIT_L(0); PG8_MMA(1, 0, At, B0); PG8_BAR; PG8_SCHED;
            PG8_STAGE(PG8_SB(1, 1), b3 + hstepB, voffB);
            PG8_WAIT_V(6); PG8_BAR; PG8_MMA(1, 1, At, B1); PG8_BAR;
            }
        }
        if constexpr (ALIGN_EPI) { if (wr == 0) PG8_BAR; }
        if constexpr (!Epi::AFTER_DRAIN) { E(acc, cur, wr, wc, fr, fq); S.done(cur); }
        if (!has_next) break;
#pragma unroll
        for (int a = 0; a < 2; ++a)
#pragma unroll
            for (int b = 0; b < 2; ++b)
#pragma unroll
                for (int m = 0; m < 4; ++m)
#pragma unroll
                    for (int n = 0; n < 2; ++n) acc[a][b][m][n] = (f32x4){0.f, 0.f, 0.f, 0.f};
        cur = nxt; cA = nA; cB = nB; ++ui;
        if constexpr (ALIGN_EPI) { if (wr == 1) PG8_BAR; }
    }
    PG8_WAIT_V(0);
    if constexpr (!ALIGN_EPI) { if (wr == 0) PG8_BAR; }
    PG8_BAR;
    if constexpr (Epi::AFTER_DRAIN) { E.fused(acc, cur, wr, wc, fr, fq, lds, wid, lane); S.done(cur); }
#undef PG8_SA
#undef PG8_SB
#undef PG8_STAGE
#undef PG8_LDA
#undef PG8_LDB
#undef PG8_MMA
#undef PG8_WAIT_V
#undef PG8_WAIT_L
#undef PG8_BAR
#undef PG8_SCHED
}
}

constexpr int BATCH = 16, SEQ = 2048, DMODEL = 1024, MROWS = BATCH * SEQ;
constexpr int DMIX = 2048, NPROJ = 7168, DIN = 7176, NHF = 8;
constexpr int MEM_LEN = 256, MMEM = BATCH * MEM_LEN;
constexpr float EPS = 1e-6f, LOG2E = 1.4426950408889634f;
constexpr float QSCALE64 = 0.125f * LOG2E;
constexpr float QSCALE128 = 0.08838834764831845f * LOG2E;

constexpr size_t MiB = 1u << 20;
constexpr size_t WS_PROJ = 0;
constexpr size_t SEG_BYTES = 32 * MiB;
constexpr size_t WS_Y = 320 * MiB;
constexpr size_t WS_OG = 0;
constexpr size_t WS_WIN = 448 * MiB;
constexpr size_t WS_WOUT = 462 * MiB;
constexpr size_t WS_WMKV = 466 * MiB;
constexpr size_t WS_HM = 468 * MiB;
constexpr size_t WS_MKV = 476 * MiB;
constexpr size_t WS_LOGF = 484 * MiB;
constexpr size_t WS_C2 = 485 * MiB;
constexpr size_t WS_CTL = 486 * MiB, CTL_ZERO_BYTES = 1 * MiB;
constexpr size_t WS_END = 487 * MiB;
constexpr int CW_BAR = 4096;
constexpr int CW_QUEUE = 16384;

constexpr int RING_BYTES = 131072;
constexpr int LDSCTL_OFF = RING_BYTES, MISC_OFF = LDSCTL_OFF + 320;
constexpr int LDS_BYTES = 147456;
constexpr int NWAVES = 8;

#define GAS __attribute__((address_space(1)))
#define LAS __attribute__((address_space(3)))
typedef unsigned short bf16;
typedef unsigned v4u __attribute__((ext_vector_type(4)));
typedef float f32x4 __attribute__((ext_vector_type(4)));
typedef unsigned u32x4_t __attribute__((ext_vector_type(4)));
typedef short bf16x8 __attribute__((ext_vector_type(8)));
typedef GAS unsigned gu32;
typedef GAS unsigned long long gu64;
#define RLX_AGENT __ATOMIC_RELAXED, __HIP_MEMORY_SCOPE_AGENT
#define LDS_WAIT() asm volatile("s_waitcnt lgkmcnt(0)" ::: "memory")
#define VM_WAIT() asm volatile("s_waitcnt vmcnt(0)" ::: "memory")
__device__ __forceinline__ unsigned long long rt() { return __builtin_amdgcn_s_memrealtime(); }
__device__ __forceinline__ unsigned f2bf(float f) { unsigned u = __builtin_bit_cast(unsigned, f); return (u + 0x7fffu + ((u >> 16) & 1u)) >> 16; }
__device__ __forceinline__ unsigned pk2(float lo, float hi) { return f2bf(lo) | (f2bf(hi) << 16); }

#define XB_TMO      128
#define XB_XCNT(j)  (256  + 64 * (j))
#define XB_XSUB(j)  (1280 + 64 * (j))
#define XB_XGEN(j)  (2304 + 64 * (j))
#define XB_TOP      3328
#define XB_TOPGEN   3392
#define XCD_BAR_WORDS 3456
#define XB_SPIN_CAP (1u << 18)

__device__ __forceinline__ unsigned xb_ld(unsigned* p)              { return __hip_atomic_load(p, __ATOMIC_RELAXED, __HIP_MEMORY_SCOPE_AGENT); }
__device__ __forceinline__ unsigned xb_add(unsigned* p, unsigned v) { return __hip_atomic_fetch_add(p, v, __ATOMIC_RELAXED, __HIP_MEMORY_SCOPE_AGENT); }
__device__ __forceinline__ unsigned xb_xcc_id() { return (unsigned)__builtin_amdgcn_s_getreg((3 << 11) | 20) & 0xFu; }
#define XB_SPIN(cond, bar) do { unsigned _sp = 0; while (cond) { __builtin_amdgcn_s_sleep(1); \
    if ((++_sp & 255u) == 0u) { if (xb_ld(&(bar)[XB_TMO])) break; if (_sp > XB_SPIN_CAP) { atomicAdd(&(bar)[XB_TMO], 1u); break; } } } } while (0)

struct XcdBarrier {
    unsigned* bar; unsigned x;
    volatile LAS unsigned* st;
};

__device__ __forceinline__ XcdBarrier xcd_barrier_post(unsigned* bar, volatile LAS unsigned* st) {
    XcdBarrier b; b.bar = bar; b.x = xb_xcc_id(); b.st = st;
    if (threadIdx.x == 0) (void)xb_add(&bar[XB_XCNT(b.x)], 1u);
    return b;
}
__device__ __forceinline__ void xcd_barrier_complete(unsigned* bar, unsigned x, unsigned& nloc, unsigned& nx) {
    const unsigned G = gridDim.x * gridDim.y * gridDim.z;
    unsigned sum, cnt, mine, sp = 0u;
    for (;;) {
        sum = 0u; cnt = 0u; mine = 0u;
#pragma unroll
        for (unsigned j = 0; j < 16; ++j) { const unsigned c = xb_ld(&bar[XB_XCNT(j)]); sum += c; cnt += (c > 0u) ? 1u : 0u; mine = (j == x) ? c : mine; }
        if (sum == G) break;
        __builtin_amdgcn_s_sleep(1);
        if ((++sp & 255u) == 0u) { if (xb_ld(&bar[XB_TMO])) break; if (sp > XB_SPIN_CAP) { atomicAdd(&bar[XB_TMO], 1u); break; } }
    }
    nloc = mine > 0u ? mine : 1u; nx = cnt > 0u ? cnt : 1u;
}

__device__ __forceinline__ void xcd_barrier(const XcdBarrier& b) {
    asm volatile("s_waitcnt vmcnt(0)" ::: "memory");
    __syncthreads();
    if (threadIdx.x == 0) {
        unsigned* bar = b.bar;
        __builtin_amdgcn_s_waitcnt(0);
        unsigned nloc = b.st[0], nx = b.st[1];
        if (nloc == 0u) { xcd_barrier_complete(bar, b.x, nloc, nx); b.st[0] = nloc; b.st[1] = nx; }
        const unsigned old = xb_add(&bar[XB_XSUB(b.x)], 1u);
        const unsigned gen = old / nloc;
        if (old + 1u == (gen + 1u) * nloc) {
            __builtin_amdgcn_fence(__ATOMIC_RELEASE, "agent");
            asm volatile("s_waitcnt vmcnt(0)" ::: "memory");
            const unsigned og = xb_add(&bar[XB_TOP], 1u);
            const unsigned tg = og / nx;
            if (og + 1u == (tg + 1u) * nx) xb_add(&bar[XB_TOPGEN], 1u);
            else XB_SPIN(xb_ld(&bar[XB_TOPGEN]) == tg, bar);
            __builtin_amdgcn_fence(__ATOMIC_ACQUIRE, "agent");
            xb_add(&bar[XB_XGEN(b.x)], 1u);
            asm volatile("s_waitcnt vmcnt(0)" ::: "memory");
        } else {
            XB_SPIN(xb_ld(&bar[XB_XGEN(b.x)]) == gen, bar);
            __builtin_amdgcn_fence(__ATOMIC_ACQUIRE, "agent");
            asm volatile("s_waitcnt vmcnt(0)" ::: "memory");
        }
    }
    __syncthreads();
}

struct Args { const float* in[12]; float* out; unsigned char* ws; int ph_lo, ph_hi; };

struct Frame {
    LAS unsigned char* lds;
    volatile LAS unsigned* MISC;
    gu32* ctl;
    int tid, lane, wave;
    int vcu, G;
    const Args* a;
};
#define F_X(F) ((F).a->in[0])
#define F_MEM(F) ((F).a->in[1])
#define F_WIN(F) ((F).a->in[2])
#define F_BFORGET(F) ((F).a->in[3])
#define F_WMKV(F) ((F).a->in[4])
#define F_WOUT(F) ((F).a->in[5])
#define F_PRE(F) ((F).a->in[6])
#define F_POST(F) ((F).a->in[7])
#define F_MEMNORM(F) ((F).a->in[8])
#define F_DLAM(F) ((F).a->in[9])
#define F_DHN(F) ((F).a->in[10])
#define F_RELB(F) ((F).a->in[11])
#define F_OUT(F) ((F).a->out)
#define F_WS(F) ((F).a->ws)
__device__ __forceinline__ float bf2f(unsigned short u) { return __uint_as_float((unsigned)u << 16); }
typedef float f32x2_c __attribute__((ext_vector_type(2))); typedef __bf16 bf16x2_c __attribute__((ext_vector_type(2)));
__device__ __forceinline__ unsigned cvt2(float lo, float hi) { f32x2_c v = {lo, hi}; bf16x2_c b = __builtin_convertvector(v, bf16x2_c); return __builtin_bit_cast(unsigned, b); }
__device__ __forceinline__ float wave_sum(float v) {
#pragma unroll
    for (int o = 1; o < 64; o <<= 1) v += __shfl_xor(v, o);
    return v;
}
__device__ __forceinline__ float log_sigmoid_f(float v) { return v >= 0.f ? -log1pf(expf(-v)) : v - log1pf(expf(v)); }

__device__ __forceinline__ void p0_transpose_item(const float* W, int ldw, int K, bf16* WT, int k0, int n0, int csrc0, float sc, LAS float* scr, int lane) {
#pragma unroll 8
    for (int i = 0; i < 32; ++i) { const int kk = 2 * i + (lane >> 5); scr[kk * 33 + (lane & 31)] = W[(size_t)(k0 + kk) * ldw + csrc0 + (lane & 31)]; }
    LDS_WAIT(); asm volatile("" ::: "memory");
    const int c = lane & 7;
#pragma unroll
    for (int j = 0; j < 4; ++j) { const int n = (lane >> 3) + 8 * j; const LAS float* s = scr + (8 * c) * 33 + n;
        v4u o; o.x = cvt2(s[0 * 33] * sc, s[1 * 33] * sc); o.y = cvt2(s[2 * 33] * sc, s[3 * 33] * sc); o.z = cvt2(s[4 * 33] * sc, s[5 * 33] * sc); o.w = cvt2(s[6 * 33] * sc, s[7 * 33] * sc);
        *(GAS v4u*)(WT + (size_t)(n0 + n) * K + k0 + 8 * c) = o; }
    LDS_WAIT(); asm volatile("" ::: "memory");
}
__device__ __forceinline__ void p0_weights(Frame& F0, int l) {
    Frame F = F0; asm volatile("" : "+v"(F.lane), "+v"(F.tid));
    LAS float* scr = (LAS float*)(F.lds + F.wave * 8448);
    const int gw = F.vcu * NWAVES + F.wave, NGW = F.G * NWAVES;
    constexpr int I_IN = 16 * 224, I_OUT = 32 * 32, I_MKV = 16 * 32;
    const float* win = F_WIN(F) + (size_t)l * DMODEL * DIN; const float* wout = F_WOUT(F) + (size_t)l * DMIX * DMODEL; const float* wmkv = F_WMKV(F) + (size_t)l * DMODEL * 1024;
    for (int it = gw; it < I_IN + I_OUT + I_MKV; it += NGW) {
        int r = it;
        if (r < I_IN) { const int kb = r / 224, nb = r % 224, n0 = 32 * nb; const int csrc0 = n0 + (n0 >= 4608 ? 8 : 0);
            float sc = 1.f; if (n0 < 512 || (n0 >= 1536 && n0 < 2048) || (n0 >= 3072 && n0 < 3584)) sc = QSCALE64; else if (n0 >= 4608 && n0 < 5120) sc = QSCALE128;
            p0_transpose_item(win, DIN, DMODEL, (bf16*)(F_WS(F) + WS_WIN), 64 * kb, n0, csrc0, sc, scr, F.lane); continue; }
        r -= I_IN;
        if (r < I_OUT) { const int kb = r / 32, nb = r % 32; p0_transpose_item(wout, DMODEL, DMIX, (bf16*)(F_WS(F) + WS_WOUT), 64 * kb, 32 * nb, 32 * nb, 1.f, scr, F.lane); continue; }
        r -= I_OUT;
        { const int kb = r / 32, nb = r % 32; p0_transpose_item(wmkv, 1024, DMODEL, (bf16*)(F_WS(F) + WS_WMKV), 64 * kb, 32 * nb, 32 * nb, 1.f, scr, F.lane); }
    }
}
__device__ __forceinline__ void p0_mem_rows(Frame& F0, int l) {
    Frame F = F0; asm volatile("" : "+v"(F.lane), "+v"(F.tid));
    const int gw = F.vcu * NWAVES + F.wave, NGW = F.G * NWAVES;
    const GAS f32x4* gp = (const GAS f32x4*)(F_MEMNORM(F) + l * DMODEL) + F.lane; f32x4 g[4];
#pragma unroll
    for (int j = 0; j < 4; ++j) g[j] = gp[64 * j];
    for (int m = gw; m < MMEM; m += NGW) {
        const GAS f32x4* xr = (const GAS f32x4*)(F_MEM(F) + (size_t)m * DMODEL) + F.lane; f32x4 v[4]; float s2 = 0.f;
#pragma unroll
        for (int j = 0; j < 4; ++j) { v[j] = xr[64 * j]; s2 += (v[j].x * v[j].x + v[j].y * v[j].y) + (v[j].z * v[j].z + v[j].w * v[j].w); }
        const float r = 1.0f / sqrtf(wave_sum(s2) * (1.f / DMODEL) + EPS);
        GAS unsigned long long* o8 = (GAS unsigned long long*)(F_WS(F) + WS_HM + (size_t)m * DMODEL * 2) + F.lane;
#pragma unroll
        for (int j = 0; j < 4; ++j) { const f32x4 h = v[j] * r * g[j]; o8[64 * j] = (unsigned long long)cvt2(h.x, h.y) | ((unsigned long long)cvt2(h.z, h.w) << 32); }
    }
}
struct RowIn { f32x4 v[4]; v4u og[2]; v4u n1[2]; };
__device__ __forceinline__ void bf8_to_f(const v4u u, f32x4& a, f32x4& b) {
    a.x = __uint_as_float(u.x << 16); a.y = __uint_as_float(u.x & 0xffff0000u); a.z = __uint_as_float(u.y << 16); a.w = __uint_as_float(u.y & 0xffff0000u);
    b.x = __uint_as_float(u.z << 16); b.y = __uint_as_float(u.z & 0xffff0000u); b.z = __uint_as_float(u.w << 16); b.w = __uint_as_float(u.w & 0xffff0000u); }
__device__ __forceinline__ v4u f_to_bf8(const f32x4 a, const f32x4 b) { v4u u; u.x = cvt2(a.x, a.y); u.y = cvt2(a.z, a.w); u.z = cvt2(b.x, b.y); u.w = cvt2(b.z, b.w); return u; }
__device__ __forceinline__ float sumsq4(const f32x4 (&v)[4]) { float s = 0.f;
#pragma unroll
    for (int j = 0; j < 4; ++j) s += (v[j].x * v[j].x + v[j].y * v[j].y) + (v[j].z * v[j].z + v[j].w * v[j].w);
    return s; }
__device__ __forceinline__ void row_load(Frame& F, int l, int m, int lane, RowIn& R) {
    const GAS f32x4* xr = (const GAS f32x4*)(F_X(F) + (size_t)m * DMODEL + 8 * lane);
    R.v[0] = xr[0]; R.v[1] = xr[1]; R.v[2] = xr[128]; R.v[3] = xr[129];
    if (l > 0) { const GAS v4u* orow = (const GAS v4u*)((const bf16*)(F_WS(F) + WS_OG) + (size_t)m * DMODEL + 8 * lane); R.og[0] = orow[0]; R.og[1] = orow[64]; }
    if (l == 2) { const GAS v4u* nr = (const GAS v4u*)((const bf16*)((unsigned char*)F_OUT(F) + (size_t)m * 4096) + 8 * lane); R.n1[0] = nr[0]; R.n1[1] = nr[64]; }
}
__device__ __forceinline__ void row_compute(Frame& F, int l, int m, int lane, RowIn& R, const f32x4 (&gpre)[4], const f32x4 (&gpost)[4], const LAS float* wf) {
    unsigned char* slot = (unsigned char*)F_OUT(F) + (size_t)m * 4096;
    f32x4 v[4];
#pragma unroll
    for (int j = 0; j < 4; ++j) v[j] = R.v[j];
    if (l > 0) {
        f32x4 o[4]; bf8_to_f(R.og[0], o[0], o[1]); bf8_to_f(R.og[1], o[2], o[3]);
        const float ro = 1.0f / sqrtf(wave_sum(sumsq4(o)) * (1.f / DMODEL) + EPS);
        if (l == 1) {
            f32x4 n[4];
#pragma unroll
            for (int j = 0; j < 4; ++j) n[j] = o[j] * ro * gpost[j];
            const v4u n0 = f_to_bf8(n[0], n[1]), n1 = f_to_bf8(n[2], n[3]);
            GAS v4u* nw = (GAS v4u*)((bf16*)slot + 8 * lane); nw[0] = n0; nw[64] = n1;
            f32x4 t[4]; bf8_to_f(n0, t[0], t[1]); bf8_to_f(n1, t[2], t[3]);
#pragma unroll
            for (int j = 0; j < 4; ++j) v[j] = v[j] + t[j];
        } else {
            f32x4 t[4]; bf8_to_f(R.n1[0], t[0], t[1]); bf8_to_f(R.n1[1], t[2], t[3]);
            GAS f32x4* outr = (GAS f32x4*)((float*)slot + 8 * lane);
            outr[0] = v[0] + t[0] + o[0] * ro * gpost[0]; outr[1] = v[1] + t[1] + o[1] * ro * gpost[1];
            outr[128] = v[2] + t[2] + o[2] * ro * gpost[2]; outr[129] = v[3] + t[3] + o[3] * ro * gpost[3];
            return;
        }
    }
    const float r = 1.0f / sqrtf(wave_sum(sumsq4(v)) * (1.f / DMODEL) + EPS);
    f32x4 h[4];
#pragma unroll
    for (int j = 0; j < 4; ++j) h[j] = v[j] * r * gpre[j];
    { GAS v4u* hw = (GAS v4u*)((bf16*)(slot + 2048) + 8 * lane); hw[0] = f_to_bf8(h[0], h[1]); hw[64] = f_to_bf8(h[2], h[3]); }
    float fl[8];
#pragma unroll
    for (int f = 0; f < 8; ++f) { const LAS f32x4* wp = (const LAS f32x4*)(wf + f * 1024 + 8 * lane); const f32x4 w0 = wp[0], w1 = wp[1], w2 = wp[128], w3 = wp[129];
        fl[f] = ((h[0].x * w0.x + h[0].y * w0.y) + (h[0].z * w0.z + h[0].w * w0.w)) + ((h[1].x * w1.x + h[1].y * w1.y) + (h[1].z * w1.z + h[1].w * w1.w))
              + ((h[2].x * w2.x + h[2].y * w2.y) + (h[2].z * w2.z + h[2].w * w2.w)) + ((h[3].x * w3.x + h[3].y * w3.y) + (h[3].z * w3.z + h[3].w * w3.w));
        if (f & 1) __builtin_amdgcn_sched_barrier(0); }
    float t4[4], t2[2];
    { const bool up = (lane & 32) != 0;
#pragma unroll
      for (int i = 0; i < 4; ++i) { const float send = up ? fl[i] : fl[4 + i], keep = up ? fl[4 + i] : fl[i]; t4[i] = keep + __shfl_xor(send, 32); } }
    { const bool up = (lane & 16) != 0;
#pragma unroll
      for (int i = 0; i < 2; ++i) { const float send = up ? t4[i] : t4[2 + i], keep = up ? t4[2 + i] : t4[i]; t2[i] = keep + __shfl_xor(send, 16); } }
    float fv; { const bool up = (lane & 8) != 0; const float send = up ? t2[0] : t2[1], keep = up ? t2[1] : t2[0]; fv = keep + __shfl_xor(send, 8); }
    fv += __shfl_xor(fv, 4); fv += __shfl_xor(fv, 2); fv += __shfl_xor(fv, 1);
    if ((lane & 7) == 0) { const int f = ((lane >> 5) & 1) * 4 + ((lane >> 4) & 1) * 2 + ((lane >> 3) & 1); const int b = m / SEQ, s = m % SEQ;
        ((float*)(F_WS(F) + WS_LOGF))[((size_t)b * NHF + f) * SEQ + s] = log_sigmoid_f(fv + F_BFORGET(F)[l * NHF + f]); }
}
__device__ __forceinline__ void p0_rows(Frame& F0, int l) {
    Frame F = F0; asm volatile("" : "+v"(F.lane), "+v"(F.tid));
    const int gw = F.vcu * NWAVES + F.wave, NGW = F.G * NWAVES, lane = F.lane;
    LAS float* wf = (LAS float*)(F.lds + 98304);
    if (l < 2) {
        const float* win = F_WIN(F) + (size_t)l * DMODEL * DIN + 4608;
        for (int idx = F.tid; idx < 8192; idx += NWAVES * 64) { const int k = idx >> 3, f = idx & 7; wf[f * 1024 + k] = win[(size_t)k * DIN + f]; }
        __syncthreads();
    }
    f32x4 gpre[4], gpost[4];
#pragma unroll
    for (int j = 0; j < 4; ++j) { gpre[j] = (f32x4){0.f, 0.f, 0.f, 0.f}; gpost[j] = gpre[j]; }
    if (l < 2) { const GAS f32x4* gp = (const GAS f32x4*)(F_PRE(F) + l * DMODEL + 8 * lane); gpre[0] = gp[0]; gpre[1] = gp[1]; gpre[2] = gp[128]; gpre[3] = gp[129]; }
    if (l > 0) { const GAS f32x4* gp = (const GAS f32x4*)(F_POST(F) + (l - 1) * DMODEL + 8 * lane); gpost[0] = gp[0]; gpost[1] = gp[1]; gpost[2] = gp[128]; gpost[3] = gp[129]; }
    for (int m = gw; m < MROWS; m += 2 * NGW) {
        const int m2 = m + NGW; const bool two = m2 < MROWS;
        RowIn A, B;
        row_load(F, l, m, lane, A);
        if (two) row_load(F, l, m2, lane, B);
        if (l == 2) asm volatile("s_waitcnt vmcnt(0)" ::: "memory");
        row_compute(F, l, m, lane, A, gpre, gpost, wf);
        if (two) row_compute(F, l, m2, lane, B, gpre, gpost, wf);
    }
}
__device__ __forceinline__ void cumsum_logf(Frame& F0) {
    Frame F = F0; asm volatile("" : "+v"(F.lane), "+v"(F.tid));
    const int bh = blockIdx.x;
    if (bh >= BATCH * NHF || F.wave != 0) return;
    const float* src = (const float*)(F_WS(F) + WS_LOGF) + (size_t)bh * SEQ + 32 * F.lane; float* dst = (float*)(F_WS(F) + WS_C2) + (size_t)bh * SEQ + 32 * F.lane;
    float v[32];
#pragma unroll
    for (int i = 0; i < 8; ++i) { const f32x4 t = *(const GAS f32x4*)(src + 4 * i); v[4 * i] = t.x; v[4 * i + 1] = t.y; v[4 * i + 2] = t.z; v[4 * i + 3] = t.w; }
#pragma unroll
    for (int i = 1; i < 32; ++i) v[i] += v[i - 1];
    float tot = v[31], inc = tot;
#pragma unroll
    for (int o = 1; o < 64; o <<= 1) { const float t = __shfl_up(inc, o); if (F.lane >= o) inc += t; }
    const float off = inc - tot;
#pragma unroll
    for (int i = 0; i < 8; ++i) { f32x4 t; t.x = (v[4 * i] + off) * -LOG2E; t.y = (v[4 * i + 1] + off) * -LOG2E; t.z = (v[4 * i + 2] + off) * -LOG2E; t.w = (v[4 * i + 3] + off) * -LOG2E; *(GAS f32x4*)(dst + 4 * i) = t; }
}

struct NArgs { const unsigned char* ws; unsigned char* wsw; const float* diff_lambda; const float* diff_head_norm; const float* rel_bias; int layer; int pad; };
__device__ __forceinline__ void ld_row64(const bf16* p, float* q) {
#pragma unroll
    for (int i = 0; i < 8; ++i) { const uint4 u = *(const uint4*)(p + 8 * i);
        q[8 * i] = __uint_as_float(u.x << 16); q[8 * i + 1] = __uint_as_float(u.x & 0xffff0000u); q[8 * i + 2] = __uint_as_float(u.y << 16); q[8 * i + 3] = __uint_as_float(u.y & 0xffff0000u);
        q[8 * i + 4] = __uint_as_float(u.z << 16); q[8 * i + 5] = __uint_as_float(u.z & 0xffff0000u); q[8 * i + 6] = __uint_as_float(u.w << 16); q[8 * i + 7] = __uint_as_float(u.w & 0xffff0000u); }
}
__device__ __forceinline__ float dot64(const bf16* p, const float* q) {
    float s = 0.f;
#pragma unroll
    for (int i = 0; i < 8; ++i) { const uint4 u = *(const uint4*)(p + 8 * i);
        s += q[8 * i] * __uint_as_float(u.x << 16) + q[8 * i + 1] * __uint_as_float(u.x & 0xffff0000u) + q[8 * i + 2] * __uint_as_float(u.y << 16) + q[8 * i + 3] * __uint_as_float(u.y & 0xffff0000u)
           + q[8 * i + 4] * __uint_as_float(u.z << 16) + q[8 * i + 5] * __uint_as_float(u.z & 0xffff0000u) + q[8 * i + 6] * __uint_as_float(u.w << 16) + q[8 * i + 7] * __uint_as_float(u.w & 0xffff0000u); }
    return s;
}
__device__ __forceinline__ void axpy64(const bf16* p, float a, float* acc) {
#pragma unroll
    for (int i = 0; i < 8; ++i) { const uint4 u = *(const uint4*)(p + 8 * i);
        acc[8 * i] += a * __uint_as_float(u.x << 16); acc[8 * i + 1] += a * __uint_as_float(u.x & 0xffff0000u); acc[8 * i + 2] += a * __uint_as_float(u.y << 16); acc[8 * i + 3] += a * __uint_as_float(u.y & 0xffff0000u);
        acc[8 * i + 4] += a * __uint_as_float(u.z << 16); acc[8 * i + 5] += a * __uint_as_float(u.z & 0xffff0000u); acc[8 * i + 6] += a * __uint_as_float(u.w << 16); acc[8 * i + 7] += a * __uint_as_float(u.w & 0xffff0000u); }
}
__device__ __forceinline__ void store_y64(bf16* yrow, const float* o) {
#pragma unroll
    for (int i = 0; i < 8; ++i) { uint4 u = *(const uint4*)(yrow + 8 * i);
        u.x = pk2(o[8 * i] * __uint_as_float(u.x << 16), o[8 * i + 1] * __uint_as_float(u.x & 0xffff0000u)); u.y = pk2(o[8 * i + 2] * __uint_as_float(u.y << 16), o[8 * i + 3] * __uint_as_float(u.y & 0xffff0000u));
        u.z = pk2(o[8 * i + 4] * __uint_as_float(u.z << 16), o[8 * i + 5] * __uint_as_float(u.z & 0xffff0000u)); u.w = pk2(o[8 * i + 6] * __uint_as_float(u.w << 16), o[8 * i + 7] * __uint_as_float(u.w & 0xffff0000u));
        *(uint4*)(yrow + 8 * i) = u; }
}
__device__ __forceinline__ int t5_bucket(int n) {
    if (n < 16) return n;
    int large = 16 + (int)(logf((float)n / 16.0f) / logf(8.0f) * 16.0f);
    return large < 31 ? large : 31;
}
__device__ __forceinline__ float diff_lam(const float* dl, int l, float& lam_init) {
    float s1 = 0.f, s2 = 0.f;
    for (int i = 0; i < 64; ++i) { s1 += dl[l * 256 + i] * dl[l * 256 + 64 + i]; s2 += dl[l * 256 + 128 + i] * dl[l * 256 + 192 + i]; }
    lam_init = 0.8f - 0.6f * expf(-0.3f * (float)l);
    return expf(s1) - expf(s2) + lam_init;
}
__global__ void __launch_bounds__(256) naive_sb(NArgs a) {
    const int qb = blockIdx.x & 7, h = (blockIdx.x >> 3) & 7, b = blockIdx.x >> 6; const int t = qb * 256 + threadIdx.x; const size_t row = (size_t)b * SEQ + t;
    const bf16* Q = (const bf16*)(a.ws + WS_PROJ + 3 * SEG_BYTES); const bf16* K = (const bf16*)(a.ws + WS_PROJ + 4 * SEG_BYTES); const bf16* V = (const bf16*)(a.ws + WS_PROJ + 5 * SEG_BYTES);
    float q[64], acc[64]; ld_row64(Q + row * 512 + h * 64, q);
#pragma unroll
    for (int d = 0; d < 64; ++d) acc[d] = 0.f;
    float tail = 0.f;
    for (int s = qb * 256 + 254; s >= 0; --s) {
        if (s < t) { const size_t kr = ((size_t)b * SEQ + s) * 512 + h * 64; const float z = dot64(K + kr, q); const float e = exp2f(z), L = log2f(1.0f + e);
            const float w = exp2f(z - L + tail); tail -= L; axpy64(V + kr, w, acc); }
    }
    store_y64((bf16*)(a.wsw + WS_Y) + row * 2048 + 512 + h * 64, acc);
}
__global__ void __launch_bounds__(256) naive_fox(NArgs a) {
    const int qb = blockIdx.x & 7, h = (blockIdx.x >> 3) & 7, b = blockIdx.x >> 6; const int t = qb * 256 + threadIdx.x; const size_t row = (size_t)b * SEQ + t;
    const bf16* Q = (const bf16*)(a.ws + WS_PROJ + 6 * SEG_BYTES); const bf16* K = (const bf16*)(a.ws + WS_PROJ + 7 * SEG_BYTES); const bf16* V = (const bf16*)(a.ws + WS_PROJ + 8 * SEG_BYTES);
    const float* c2 = (const float*)(a.ws + WS_C2) + ((size_t)b * NHF + h) * SEQ;
    float q[64], acc[64]; ld_row64(Q + row * 512 + h * 64, q);
#pragma unroll
    for (int d = 0; d < 64; ++d) acc[d] = 0.f;
    float m = -1e30f, lsum = 0.f; const float ct = c2[t];
    for (int s = 0; s <= qb * 256 + 255; ++s) {
        if (s <= t) { const size_t kr = ((size_t)b * SEQ + s) * 512 + h * 64; const float xx = dot64(K + kr, q) + (c2[s] - ct); const float mn = fmaxf(m, xx), al = exp2f(m - mn), p = exp2f(xx - mn);
            lsum = lsum * al + p; m = mn;
#pragma unroll
            for (int d = 0; d < 64; ++d) acc[d] *= al;
            axpy64(V + kr, p, acc); }
    }
    const float il = 1.0f / lsum;
#pragma unroll
    for (int d = 0; d < 64; ++d) acc[d] *= il;
    store_y64((bf16*)(a.wsw + WS_Y) + row * 2048 + 1024 + h * 64, acc);
}
__global__ void __launch_bounds__(256) naive_mem(NArgs a) {
    const int qb = blockIdx.x & 7, h = (blockIdx.x >> 3) & 3, b = blockIdx.x >> 5; const int t = qb * 256 + threadIdx.x; const size_t row = (size_t)b * SEQ + t;
    const bf16* Q = (const bf16*)(a.ws + WS_PROJ + 9 * SEG_BYTES); const bf16* KV = (const bf16*)(a.ws + WS_MKV);
    float q[128]; ld_row64(Q + row * 512 + h * 128, q); ld_row64(Q + row * 512 + h * 128 + 64, q + 64);
#pragma unroll
    for (int dh = 0; dh < 2; ++dh) {
        float acc[64];
#pragma unroll
        for (int d = 0; d < 64; ++d) acc[d] = 0.f;
        float m = -1e30f, lsum = 0.f;
        for (int s = 0; s < MEM_LEN; ++s) { const size_t kr = ((size_t)b * MEM_LEN + s) * 1024 + h * 128; const float xx = dot64(KV + kr, q) + dot64(KV + kr + 64, q + 64);
            const float mn = fmaxf(m, xx), al = exp2f(m - mn), p = exp2f(xx - mn); lsum = lsum * al + p; m = mn;
#pragma unroll
            for (int d = 0; d < 64; ++d) acc[d] *= al;
            axpy64(KV + kr + 512 + dh * 64, p, acc); }
        const float il = 1.0f / lsum;
#pragma unroll
        for (int d = 0; d < 64; ++d) acc[d] *= il;
        store_y64((bf16*)(a.wsw + WS_Y) + row * 2048 + 1536 + h * 128 + dh * 64, acc);
    }
}
template <int C> __device__ __forceinline__ void naive_diff_pass(const bf16* Q, const bf16* K, const bf16* V, const float* rel_bias, int b, int h, int t, int tmax, int dh, float* res, float coef) {
    const size_t row = (size_t)b * SEQ + t; float q[64], acc[64]; ld_row64(Q + row * 512 + h * 128 + C * 64, q);
#pragma unroll
    for (int d = 0; d < 64; ++d) acc[d] = 0.f;
    float m = -1e30f, lsum = 0.f;
    for (int s = 0; s <= tmax; ++s) {
        if (s <= t) { const size_t kr = ((size_t)b * SEQ + s) * 512 + h * 128; const float xx = dot64(K + kr + C * 64, q) + rel_bias[t5_bucket(t - s) * 4 + h] * LOG2E;
            const float mn = fmaxf(m, xx), al = exp2f(m - mn), p = exp2f(xx - mn); lsum = lsum * al + p; m = mn;
#pragma unroll
            for (int d = 0; d < 64; ++d) acc[d] *= al;
            axpy64(V + kr + dh * 64, p, acc); }
    }
    const float il = coef / lsum;
#pragma unroll
    for (int d = 0; d < 64; ++d) res[d] += acc[d] * il;
}
__global__ void __launch_bounds__(256) naive_diff(NArgs a) {
    const int qb = blockIdx.x & 7, h = (blockIdx.x >> 3) & 3, b = blockIdx.x >> 5; const int t = qb * 256 + threadIdx.x; const size_t row = (size_t)b * SEQ + t;
    const bf16* Q = (const bf16*)(a.ws + WS_PROJ); const bf16* K = (const bf16*)(a.ws + WS_PROJ + 1 * SEG_BYTES); const bf16* V = (const bf16*)(a.ws + WS_PROJ + 2 * SEG_BYTES);
    float lam_init; const float lam = diff_lam(a.diff_lambda, a.layer, lam_init);
    float o0[64], o1[64];
#pragma unroll
    for (int d = 0; d < 64; ++d) { o0[d] = 0.f; o1[d] = 0.f; }
    const int tmax = qb * 256 + 255;
    naive_diff_pass<0>(Q, K, V, a.rel_bias, b, h, t, tmax, 0, o0, 1.0f); naive_diff_pass<1>(Q, K, V, a.rel_bias, b, h, t, tmax, 0, o0, -lam);
    naive_diff_pass<0>(Q, K, V, a.rel_bias, b, h, t, tmax, 1, o1, 1.0f); naive_diff_pass<1>(Q, K, V, a.rel_bias, b, h, t, tmax, 1, o1, -lam);
    float ss = 0.f;
#pragma unroll
    for (int d = 0; d < 64; ++d) ss += o0[d] * o0[d] + o1[d] * o1[d];
    const float r = (1.0f / sqrtf(ss * (1.0f / 128.0f) + EPS)) * (1.0f - lam_init); const float* g = a.diff_head_norm + a.layer * 128;
#pragma unroll
    for (int d = 0; d < 64; ++d) { o0[d] *= r * g[d]; o1[d] *= r * g[64 + d]; }
    bf16* yrow = (bf16*)(a.wsw + WS_Y) + row * 2048 + h * 128; store_y64(yrow, o0); store_y64(yrow + 64, o1);
}

namespace att {
typedef float f32x16 __attribute__((ext_vector_type(16)));
typedef short s16x4 __attribute__((ext_vector_type(4)));
typedef short v4i16_t __attribute__((ext_vector_type(4)));
typedef LAS const char* lds_cptr;
typedef float f32x2_t __attribute__((ext_vector_type(2))); typedef __bf16 bf16x2_t __attribute__((ext_vector_type(2)));
constexpr int AK_OFF = 0, AV_OFF = 49152, SLOT = 16384, AC2_OFF = 98304, ATB_OFF = 106496, AQW_OFF = 111616, AFL_OFF = 111616 + 64, AX_OFF = 0;
constexpr int TBN = 320;
enum { M_SB = 0, M_FOX = 1, M_DIFF = 2, M_MEM = 3 };
constexpr float NEG = -1e30f;
#define SBAR() __builtin_amdgcn_sched_barrier(0)
__device__ __forceinline__ void glds16(const void* gsrc, unsigned lds_dst) { unsigned keep;
    asm volatile("s_mov_b32 %0, m0\n\ts_mov_b32 m0, %2\n\ts_nop 0\n\tglobal_load_lds_dwordx4 %1, off\n\ts_mov_b32 m0, %0" : "=&s"(keep) : "v"(gsrc), "s"(lds_dst) : "memory"); }
__device__ __forceinline__ s16x4 vtr(lds_cptr p) { return __builtin_bit_cast(s16x4, __builtin_amdgcn_ds_read_tr16_b64_v4i16((LAS v4i16_t*)p)); }
__device__ __forceinline__ unsigned cvtpk(float lo, float hi) { f32x2_t v = {lo, hi}; bf16x2_t b = __builtin_convertvector(v, bf16x2_t); return __builtin_bit_cast(unsigned, b); }
__device__ __forceinline__ float ex2(float v) { return __builtin_amdgcn_exp2f(v); }
__device__ __forceinline__ float lg2(float v) { return __builtin_amdgcn_logf(v); }
__device__ __forceinline__ float xsum(float v) { auto rr = __builtin_amdgcn_permlane32_swap(__float_as_uint(v), __float_as_uint(v), false, false); return __uint_as_float(rr[0]) + __uint_as_float(rr[1]); }
__device__ __forceinline__ float xmax(float v) { auto rr = __builtin_amdgcn_permlane32_swap(__float_as_uint(v), __float_as_uint(v), false, false); return fmaxf(__uint_as_float(rr[0]), __uint_as_float(rr[1])); }
__device__ __forceinline__ int kcol(int r) { return (r & 3) + 8 * (r >> 2); }

template <int MODE>
__device__ __forceinline__ void attn_unit(const Args* A, LAS unsigned char* L, int b, int h, int qb, int layer, float lam, float lam_init) {
    constexpr int DQK = (MODE == M_MEM) ? 128 : 64, DV = (MODE == M_SB || MODE == M_FOX) ? 64 : 128;
    constexpr int KCH = (MODE == M_SB || MODE == M_FOX) ? 8 : 16, VPC = DV / 8, ROWS = (MODE == M_DIFF) ? 128 : 256;
    constexpr int NQ = DQK / 16, NDB = DV / 32, NPT = KCH / 8 + VPC / 8;
    constexpr bool CAUSAL = MODE != M_MEM;
    int tid_ = threadIdx.x; asm volatile("" : "+v"(tid_));
    const int tid = tid_, lane = tid & 63, r32 = lane & 31, hi = lane >> 5, wid = __builtin_amdgcn_readfirstlane(tid >> 6);
    const int wrow = (MODE == M_DIFF) ? (wid & 3) : wid, comp = (MODE == M_DIFF) ? (wid >> 2) : 0;
    const int q0 = qb * ROWS, wq0 = q0 + wrow * 32;
    const unsigned char* ws = A->ws;
    const bf16 *Qg, *Kg, *Vg; int pitchK = 512, ycol;
    if (MODE == M_SB)   { Qg = (const bf16*)(ws + WS_PROJ + 3 * SEG_BYTES) + (size_t)b * SEQ * 512 + h * 64; Kg = (const bf16*)(ws + WS_PROJ + 4 * SEG_BYTES) + (size_t)b * SEQ * 512 + h * 64; Vg = (const bf16*)(ws + WS_PROJ + 5 * SEG_BYTES) + (size_t)b * SEQ * 512 + h * 64; ycol = 512 + h * 64; }
    if (MODE == M_FOX)  { Qg = (const bf16*)(ws + WS_PROJ + 6 * SEG_BYTES) + (size_t)b * SEQ * 512 + h * 64; Kg = (const bf16*)(ws + WS_PROJ + 7 * SEG_BYTES) + (size_t)b * SEQ * 512 + h * 64; Vg = (const bf16*)(ws + WS_PROJ + 8 * SEG_BYTES) + (size_t)b * SEQ * 512 + h * 64; ycol = 1024 + h * 64; }
    if (MODE == M_DIFF) { Qg = (const bf16*)(ws + WS_PROJ) + (size_t)b * SEQ * 512 + h * 128 + comp * 64; Kg = (const bf16*)(ws + WS_PROJ + 1 * SEG_BYTES) + (size_t)b * SEQ * 512 + h * 128; Vg = (const bf16*)(ws + WS_PROJ + 2 * SEG_BYTES) + (size_t)b * SEQ * 512 + h * 128; ycol = h * 128; }
    if (MODE == M_MEM)  { Qg = (const bf16*)(ws + WS_PROJ + 9 * SEG_BYTES) + (size_t)b * SEQ * 512 + h * 128; Kg = (const bf16*)(ws + WS_MKV) + (size_t)b * MEM_LEN * 1024 + h * 128; Vg = Kg + 512; pitchK = 1024; ycol = 1536 + h * 128; }
    const int NT = (MODE == M_MEM) ? 4 : (q0 + ROWS) / 64;
    const unsigned lds0 = (unsigned)(uintptr_t)L;
    const bf16* ksrc = Kg + (size_t)lane * pitchK + wid * 8;
    const bf16* vsrc = Vg + (size_t)(16 * (wid & 3) + (lane >> 2)) * pitchK + (wid >> 2) * 32 + (lane & 3) * 8;
#define ATT_ISSUE(kt, sl) do { const size_t toff_ = (size_t)(kt) * 64 * pitchK; \
        _Pragma("unroll") for (int i_ = 0; i_ < KCH / 8; ++i_) glds16(ksrc + toff_ + i_ * 64, (unsigned)__builtin_amdgcn_readfirstlane(lds0 + AK_OFF + (sl) * SLOT + (wid + 8 * i_) * 1024)); \
        _Pragma("unroll") for (int i_ = 0; i_ < VPC / 8; ++i_) glds16(vsrc + toff_ + i_ * 64, (unsigned)__builtin_amdgcn_readfirstlane(lds0 + AV_OFF + (sl) * SLOT + (wid + 8 * i_) * 1024)); } while (0)
#define ATT_KT(i) (CAUSAL ? (NT - 1 - (i)) : (i))
    if (MODE == M_FOX) { const float* c2 = (const float*)(ws + WS_C2) + ((size_t)b * NHF + h) * SEQ; glds16(c2 + wid * 256 + lane * 4, (unsigned)__builtin_amdgcn_readfirstlane(lds0 + AC2_OFF + wid * 1024)); }
    ATT_ISSUE(ATT_KT(0), 0);
    if (NT > 1) ATT_ISSUE(ATT_KT(1), 1);
    bf16x8 qr[NQ];
    { const bf16* qp = Qg + (size_t)(wq0 + r32) * 512 + hi * 8;
#pragma unroll
      for (int d0 = 0; d0 < NQ; ++d0) qr[d0] = *(const bf16x8*)(qp + d0 * 16);
#pragma unroll
      for (int d0 = 0; d0 < NQ; ++d0) asm volatile("" : "+v"(qr[d0])); }
    f32x16 o[NDB];
#pragma unroll
    for (int d = 0; d < NDB; ++d)
#pragma unroll
        for (int r = 0; r < 16; ++r) o[d][r] = 0.f;
    constexpr bool FIXREF = (MODE == M_FOX || MODE == M_DIFF);
    bool have_ref = false;
    float m_run = NEG, l_run = 0.f, s_run = 1.0f;
    const int qabs = wq0 + r32;
    const lds_cptr L3 = (lds_cptr)L;
    const lds_cptr kp0 = L3 + AK_OFF + (comp * 8 + hi) * 1024 + r32 * 16;
    const lds_cptr vp0 = L3 + AV_OFF + ((lane >> 4) & 1) * 32 + (lane & 3) * 8 + (4 * hi + ((lane & 15) >> 2)) * 64;
    int sl = 0;
    for (int i = 0; i < NT; ++i) {
        if (i + 1 < NT) asm volatile("s_waitcnt vmcnt(%0) lgkmcnt(0)\n\ts_barrier" :: "n"(NPT) : "memory");
        else asm volatile("s_waitcnt vmcnt(0) lgkmcnt(0)\n\ts_barrier" ::: "memory");
        if (MODE == M_SB) { if (i > 0) {
            const LAS u32x4_t* fp = (const LAS u32x4_t*)(L + AFL_OFF + ((i - 1) & 1) * 32); const u32x4_t f0 = fp[0], f1 = fp[1];
            if (__builtin_amdgcn_readfirstlane((int)((f0.x | f0.y) | (f0.z | f0.w) | (f1.x | f1.y) | (f1.z | f1.w))) == 0) break; } }
        if (i + 2 < NT) { const int sl2 = (sl >= 1) ? sl - 1 : 2; ATT_ISSUE(ATT_KT(i + 2), sl2); }
        const int kt = ATT_KT(i);
        const bool active = !CAUSAL || (kt * 64 <= wq0 + 31);
        if (active) {
            f32x16 p0, p1;
            bf16x8 kf[8];
            const lds_cptr kp = kp0 + sl * SLOT;
#pragma unroll
            for (int d0 = 0; d0 < 4; ++d0) { kf[2 * d0] = *(const LAS bf16x8*)(kp + d0 * 2048); kf[2 * d0 + 1] = *(const LAS bf16x8*)(kp + d0 * 2048 + 512); }
            if (MODE == M_FOX) { const LAS float* cp = (const LAS float*)(L + AC2_OFF) + kt * 64 + 4 * hi;
#pragma unroll
                for (int g = 0; g < 4; ++g) { const f32x4 c0 = *(const LAS f32x4*)(cp + 8 * g), c1 = *(const LAS f32x4*)(cp + 32 + 8 * g);
#pragma unroll
                    for (int j = 0; j < 4; ++j) { p0[4 * g + j] = c0[j]; p1[4 * g + j] = c1[j]; } } }
            else {
#pragma unroll
                for (int r = 0; r < 16; ++r) { p0[r] = 0.f; p1[r] = 0.f; } }
            const bool near = (MODE == M_DIFF) && (kt * 64 > wq0 - 176);
            SBAR();
#pragma unroll
            for (int d0 = 0; d0 < 4; ++d0) { p0 = __builtin_amdgcn_mfma_f32_32x32x16_bf16(kf[2 * d0], qr[d0], p0, 0, 0, 0); p1 = __builtin_amdgcn_mfma_f32_32x32x16_bf16(kf[2 * d0 + 1], qr[d0], p1, 0, 0, 0); }
            if (NQ > 4) { SBAR();
#pragma unroll
                for (int d0 = 0; d0 < 4; ++d0) { kf[2 * d0] = *(const LAS bf16x8*)(kp + (d0 + 4) * 2048); kf[2 * d0 + 1] = *(const LAS bf16x8*)(kp + (d0 + 4) * 2048 + 512); }
                SBAR();
#pragma unroll
                for (int d0 = 0; d0 < 4; ++d0) { p0 = __builtin_amdgcn_mfma_f32_32x32x16_bf16(kf[2 * d0], qr[NQ > 4 ? d0 + 4 : d0], p0, 0, 0, 0); p1 = __builtin_amdgcn_mfma_f32_32x32x16_bf16(kf[2 * d0 + 1], qr[NQ > 4 ? d0 + 4 : d0], p1, 0, 0, 0); } }
            SBAR();
            s16x4 vlo[4 * NDB], vhi[4 * NDB];
            { const lds_cptr vp = vp0 + sl * SLOT;
#pragma unroll
              for (int d = 0; d < NDB; ++d)
#pragma unroll
                for (int ks = 0; ks < 4; ++ks) { vlo[4 * d + ks] = vtr(vp + d * 4096 + ks * 1024); vhi[4 * d + ks] = vtr(vp + d * 4096 + ks * 1024 + 512); } }
            SBAR();
            unsigned pw[16];
            if (MODE == M_SB) {
                if (kt * 64 + 63 >= wq0) { const int kb = kt * 64 + 4 * hi;
#pragma unroll
                    for (int r = 0; r < 16; ++r) { const int kv = kb + kcol(r); if (kv >= qabs) p0[r] = NEG; if (kv + 32 >= qabs) p1[r] = NEG; } }
                f32x16 l0, l1;
#pragma unroll
                for (int r = 0; r < 16; ++r) { l0[r] = __builtin_amdgcn_rcpf(1.0f + ex2(p0[r])); l1[r] = __builtin_amdgcn_rcpf(1.0f + ex2(p1[r])); }
#pragma unroll
                for (int hf = 1; hf >= 0; --hf)
#pragma unroll
                    for (int g = 3; g >= 0; --g) {
                        const float a0 = hf ? l1[4 * g] : l0[4 * g], a1 = hf ? l1[4 * g + 1] : l0[4 * g + 1], a2 = hf ? l1[4 * g + 2] : l0[4 * g + 2], a3 = hf ? l1[4 * g + 3] : l0[4 * g + 3];
                        const float town = (a0 * a1) * (a2 * a3);
                        const auto sw = __builtin_amdgcn_permlane32_swap(__float_as_uint(town), __float_as_uint(town), false, false);
                        const float v0 = __uint_as_float(sw[0]), v1 = __uint_as_float(sw[1]);
                        const float t3 = s_run * (hi ? 1.0f : v1), t2 = t3 * a3, t1 = t2 * a2, t0 = t1 * a1;
                        const float w0 = (1.0f - a0) * t0, w1 = (1.0f - a1) * t1, w2 = (1.0f - a2) * t2, w3 = (1.0f - a3) * t3;
                        pw[hf * 8 + g * 2] = cvtpk(w0, w1); pw[hf * 8 + g * 2 + 1] = cvtpk(w2, w3);
                        s_run *= v0 * v1;
                    }
            } else {
                if (MODE == M_DIFF) { if (near) { const LAS float* tp = (const LAS float*)(L + ATB_OFF) + h * TBN + (223 - (wq0 - kt * 64 + r32 - 4 * hi));
#pragma unroll
                    for (int r = 0; r < 16; ++r) { p0[r] += tp[kcol(r)]; p1[r] += tp[32 + kcol(r)]; } } }
                if (CAUSAL) { if (kt * 64 + 63 > wq0) { const int kb = kt * 64 + 4 * hi;
#pragma unroll
                    for (int r = 0; r < 16; ++r) { const int kv = kb + kcol(r); if (kv > qabs) p0[r] = NEG; if (kv + 32 > qabs) p1[r] = NEG; } } }
                if (!FIXREF || !have_ref) {
                float ra = fmaxf(fmaxf(p0[0], p0[1]), p1[0]), rb = fmaxf(fmaxf(p0[2], p0[3]), p1[1]); ra = fmaxf(fmaxf(ra, p1[2]), p1[3]);
#pragma unroll
                for (int r = 4; r < 16; r += 4) { ra = fmaxf(fmaxf(ra, p0[r]), p0[r + 1]); rb = fmaxf(fmaxf(rb, p0[r + 2]), p0[r + 3]); ra = fmaxf(fmaxf(ra, p1[r]), p1[r + 1]); rb = fmaxf(fmaxf(rb, p1[r + 2]), p1[r + 3]); }
                const float rm = xmax(fmaxf(ra, rb));
                if (FIXREF) { m_run = rm; have_ref = true; }
                else { const float mn = fmaxf(m_run, rm);
                if (__any(mn > m_run)) { const float al = ex2(m_run - mn); l_run *= al; m_run = mn;
#pragma unroll
                    for (int d = 0; d < NDB; ++d)
#pragma unroll
                        for (int r = 0; r < 16; ++r) o[d][r] *= al; } }
                }
                float sa = 0.f, sb = 0.f;
#pragma unroll
                for (int r = 0; r < 16; ++r) { p0[r] = ex2(p0[r] - m_run); p1[r] = ex2(p1[r] - m_run); sa += p0[r]; sb += p1[r]; }
                l_run += sa + sb;
#pragma unroll
                for (int w = 0; w < 8; ++w) { pw[w] = cvtpk(p0[2 * w], p0[2 * w + 1]); pw[8 + w] = cvtpk(p1[2 * w], p1[2 * w + 1]); }
            }
            SBAR();
#pragma unroll
            for (int ks = 0; ks < 4; ++ks) { const u32x4_t pf = (u32x4_t){pw[4 * ks], pw[4 * ks + 1], pw[4 * ks + 2], pw[4 * ks + 3]};
#pragma unroll
                for (int d = 0; d < NDB; ++d) { const s16x4 lo = vlo[4 * d + ks], hh = vhi[4 * d + ks];
                    const bf16x8 vf = (bf16x8){lo[0], lo[1], lo[2], lo[3], hh[0], hh[1], hh[2], hh[3]};
                    o[d] = __builtin_amdgcn_mfma_f32_32x32x16_bf16(vf, __builtin_bit_cast(bf16x8, pf), o[d], 0, 0, 0); } }
        }
        if (MODE == M_SB) { const bool alive = !active || __any(s_run != 0.0f);
            if (lane == 0) ((LAS unsigned*)(L + AFL_OFF + (i & 1) * 32))[wid] = alive ? 1u : 0u; }
        sl = (sl == 2) ? 0 : sl + 1;
    }
    if (MODE == M_SB) asm volatile("s_waitcnt vmcnt(0)" ::: "memory");
    if (MODE != M_SB) { const float il = 1.0f / xsum(l_run);
#pragma unroll
        for (int d = 0; d < NDB; ++d)
#pragma unroll
            for (int r = 0; r < 16; ++r) o[d][r] *= il; }
    if (MODE == M_DIFF) {
        asm volatile("s_waitcnt lgkmcnt(0)\n\ts_barrier" ::: "memory");
        LAS float* X = (LAS float*)(L + AX_OFF) + wrow * 4096 + lane;
        if (comp == 1) {
#pragma unroll
            for (int d = 0; d < NDB; ++d)
#pragma unroll
                for (int r = 0; r < 16; ++r) X[(d * 16 + r) * 64] = o[d][r] * lam; }
        asm volatile("s_waitcnt lgkmcnt(0)\n\ts_barrier" ::: "memory");
        if (comp == 0) { float ss = 0.f;
#pragma unroll
            for (int d = 0; d < NDB; ++d)
#pragma unroll
                for (int r = 0; r < 16; ++r) { o[d][r] -= X[(d * 16 + r) * 64]; ss += o[d][r] * o[d][r]; }
            ss = xsum(ss);
            const float rn = (1.0f / sqrtf(ss * (1.0f / 128.0f) + EPS)) * (1.0f - lam_init);
            const float* gn = A->in[10] + layer * 128 + 4 * hi;
#pragma unroll
            for (int d = 0; d < NDB; ++d)
#pragma unroll
                for (int g = 0; g < 4; ++g) { const f32x4 gv = *(const f32x4*)(gn + 32 * d + 8 * g);
#pragma unroll
                    for (int j = 0; j < 4; ++j) o[d][4 * g + j] *= rn * gv[j]; } }
    }
    if (MODE != M_DIFF || comp == 0) {
        bf16* yrow = (bf16*)(A->ws + WS_Y) + (size_t)((size_t)b * SEQ + wq0 + r32) * 2048 + ycol + 4 * hi;
#pragma unroll
        for (int d = 0; d < NDB; ++d)
#pragma unroll
            for (int g = 0; g < 4; ++g) { uint2 u = *(const uint2*)(yrow + 32 * d + 8 * g);
                u.x = cvtpk(o[d][4 * g] * __uint_as_float(u.x << 16), o[d][4 * g + 1] * __uint_as_float(u.x & 0xffff0000u));
                u.y = cvtpk(o[d][4 * g + 2] * __uint_as_float(u.y << 16), o[d][4 * g + 3] * __uint_as_float(u.y & 0xffff0000u));
                *(uint2*)(yrow + 32 * d + 8 * g) = u; }
    }
    if (MODE == M_DIFF) asm volatile("s_waitcnt lgkmcnt(0)\n\ts_barrier" ::: "memory");
#undef ATT_ISSUE
#undef ATT_KT
}

constexpr int NU_MAIN = 192, NU_Q = 448;
struct UnitD { int mode, b, h, qb; };
__device__ __forceinline__ UnitD decode_unit(int x, int k) {
    UnitD u;
    if (k < NU_MAIN) { const int jj = k / 24, r = k % 24;
        if (r < 12)      { u.mode = M_DIFF; const int bh = 8 * jj + x;          u.b = bh >> 2; u.h = bh & 3; u.qb = 15 - r; }
        else if (r < 18) { u.mode = M_FOX; const int bh = 8 * (2 * jj) + x;     u.b = bh >> 3; u.h = bh & 7; u.qb = 7 - (r - 12); }
        else             { u.mode = M_FOX; const int bh = 8 * (2 * jj + 1) + x; u.b = bh >> 3; u.h = bh & 7; u.qb = 7 - (r - 18); }
        return u; }
    int r = k - NU_MAIN;
    if (r < 128) { u.mode = M_SB; const int bh = 8 * (r >> 3) + x; u.b = bh >> 3; u.h = bh & 7; u.qb = 7 - (r & 7); return u; } r -= 128;
    if (r < 8)  { u.mode = M_DIFF; const int bh = 8 * r + x; u.b = bh >> 2; u.h = bh & 3; u.qb = 3; return u; } r -= 8;
    if (r < 16) { u.mode = M_FOX; const int bh = 8 * r + x; u.b = bh >> 3; u.h = bh & 7; u.qb = 1; return u; } r -= 16;
    if (r < 8)  { u.mode = M_DIFF; const int bh = 8 * r + x; u.b = bh >> 2; u.h = bh & 3; u.qb = 2; return u; } r -= 8;
    if (r < 8)  { u.mode = M_DIFF; const int bh = 8 * r + x; u.b = bh >> 2; u.h = bh & 3; u.qb = 1; return u; } r -= 8;
    if (r < 16) { u.mode = M_FOX; const int bh = 8 * r + x; u.b = bh >> 3; u.h = bh & 7; u.qb = 0; return u; } r -= 16;
    if (r < 64) { u.mode = M_MEM; const int bh = 8 * (r >> 3) + x; u.b = bh >> 2; u.h = bh & 3; u.qb = r & 7; return u; } r -= 64;
    { u.mode = M_DIFF; const int bh = 8 * r + x; u.b = bh >> 2; u.h = bh & 3; u.qb = 0; return u; }
}
__device__ __forceinline__ void attn_phase(Frame& F0, int layer) {
    Frame F = F0; asm volatile("" : "+v"(F.lane), "+v"(F.tid));
    LAS unsigned char* L = F.lds;
    { LAS float* tb = (LAS float*)(L + ATB_OFF); const float* relb = F.a->in[11];
      for (int i = F.tid; i < 4 * TBN; i += NWAVES * 64) { const int h = i / TBN, j = i % TBN, dist = 223 - j; float v = 0.f;
          if (dist >= 0 && dist < 113) v = (relb[t5_bucket(dist) * 4 + h] - relb[31 * 4 + h]) * LOG2E;
          tb[i] = v; } }
    float lam_init, lam;
    { const float* dl = F.a->in[9] + layer * 256; const float s1 = wave_sum(dl[F.lane] * dl[64 + F.lane]), s2 = wave_sum(dl[128 + F.lane] * dl[192 + F.lane]);
      lam_init = 0.8f - 0.6f * expf(-0.3f * (float)layer); lam = expf(s1) - expf(s2) + lam_init; }
    if (F.wave >= 4) __builtin_amdgcn_s_setprio(1);
    const int x0 = (int)(xb_xcc_id() & 7u);
    for (int xi = 0; xi < 8; ++xi) {
        const int x = (x0 + xi) & 7;
        gu32* qh = F.ctl + CW_QUEUE + 64 * (layer * 8 + x);
        for (;;) {
            if (F.tid == 0) *(volatile LAS unsigned*)(L + AQW_OFF) = __hip_atomic_fetch_add(qh, 1u, __ATOMIC_RELAXED, __HIP_MEMORY_SCOPE_AGENT);
            __syncthreads();
            const int k = __builtin_amdgcn_readfirstlane((int)*(volatile LAS unsigned*)(L + AQW_OFF));
            if (k >= NU_Q) break;
            const UnitD u = decode_unit(x, k);
            if (u.mode == M_SB) attn_unit<M_SB>(F.a, L, u.b, u.h, u.qb, layer, lam, lam_init);
            else if (u.mode == M_FOX) attn_unit<M_FOX>(F.a, L, u.b, u.h, u.qb, layer, lam, lam_init);
            else if (u.mode == M_DIFF) attn_unit<M_DIFF>(F.a, L, u.b, u.h, u.qb, layer, lam, lam_init);
            else attn_unit<M_MEM>(F.a, L, u.b, u.h, u.qb, layer, lam, lam_init);
        }
        __syncthreads();
    }
    __builtin_amdgcn_s_setprio(0);
}
#undef SBAR
}


constexpr int N_PHASES = 9;
#ifndef MK_ONE_LAUNCH
#define MK_ONE_LAUNCH 1
#endif
#ifndef MK_NAIVE_ATTN
#define MK_NAIVE_ATTN 0
#endif
__global__ void __launch_bounds__(NWAVES * 64, 2) mega_fwd(Args args) {
    extern __shared__ __attribute__((aligned(16))) unsigned char lds[];
    Frame F;
    F.lds = (LAS unsigned char*)lds;
    F.MISC = (volatile LAS unsigned*)(F.lds + MISC_OFF);
    F.tid = threadIdx.x; F.lane = F.tid & 63; F.wave = __builtin_amdgcn_readfirstlane(F.tid >> 6);
    F.G = gridDim.x; { const int bx = blockIdx.x; F.vcu = (F.G % 8 == 0) ? (bx % 8) * (F.G / 8) + bx / 8 : bx; }
    F.a = &args; F.ctl = (gu32*)(args.ws + WS_CTL);
    for (int u = F.tid; u < (LDS_BYTES - LDSCTL_OFF) / 4; u += NWAVES * 64) ((LAS unsigned*)(F.lds + LDSCTL_OFF))[u] = 0u;
    __syncthreads();
    XcdBarrier bar; bar.bar = (unsigned*)(F.ctl + CW_BAR); bar.x = 0; bar.st = nullptr;
    if (MK_ONE_LAUNCH) bar = xcd_barrier_post((unsigned*)(F.ctl + CW_BAR), F.MISC + 8);
    const int lo = args.ph_lo, hi = args.ph_hi;
#define IN(k) (lo <= (k) && (k) < hi)
#define SEAM(k) do { if (IN(k) && IN((k) + 1)) xcd_barrier(bar); } while (0)
    for (int l = 0; l < 2; ++l) {
        if (IN(4 * l + 0)) { p0_weights(F, l); p0_mem_rows(F, l); p0_rows(F, l); }
        SEAM(4 * l + 0);
        if (IN(4 * l + 1)) {
            cumsum_logf(F);
            { pg8::Gemm g{(const bf16*)F_OUT(F) + 1024, (const bf16*)(F_WS(F) + WS_WIN), MROWS, NPROJ, DMODEL, 2048}; pg8::StaticOrder S; S.init(MROWS, NPROJ, F.G, (int)blockIdx.x);
              pg8::EpiProj E{(bf16*)(F_WS(F) + WS_PROJ), (bf16*)(F_WS(F) + WS_Y), SEG_BYTES / 2};
              pg8::gemm_phase<pg8::EpiProj, pg8::StaticOrder, true, true>(F.lds, g, S, E); }
            { pg8::Gemm g{(const bf16*)(F_WS(F) + WS_HM), (const bf16*)(F_WS(F) + WS_WMKV), MMEM, 1024, DMODEL, DMODEL}; pg8::StaticOrder S; S.init(MMEM, 1024, F.G, (int)blockIdx.x);
              pg8::EpiBf16 E{(bf16*)(F_WS(F) + WS_MKV), 1024};
              pg8::gemm_phase<pg8::EpiBf16, pg8::StaticOrder, true, true>(F.lds, g, S, E); }
        }
        SEAM(4 * l + 1);
        if (IN(4 * l + 2)) att::attn_phase(F, l);
        SEAM(4 * l + 2);
        if (IN(4 * l + 3)) {
            pg8::Gemm g{(const bf16*)(F_WS(F) + WS_Y), (const bf16*)(F_WS(F) + WS_WOUT), MROWS, DMODEL, DMIX, DMIX}; pg8::StaticOrder S; S.init(MROWS, DMODEL, F.G, (int)blockIdx.x);
            pg8::EpiBf16 E{(bf16*)(F_WS(F) + WS_OG), DMODEL};
            pg8::gemm_phase<pg8::EpiBf16, pg8::StaticOrder, true, true>(F.lds, g, S, E);
        }
        SEAM(4 * l + 3);
    }
    if (IN(8)) p0_rows(F, 2);
#undef IN
#undef SEAM
}

extern "C" void kernel_launch(void* const* d_in, const int* in_sizes, int n_in, void* d_out, int out_size, void* d_ws, size_t ws_size, hipStream_t stream) {
    static int grid = 0;
    if (grid == 0) {
        if (n_in != 12 || out_size != MROWS * DMODEL || ws_size < WS_END) { fprintf(stderr, "kernel_launch: unexpected shapes (n_in %d out %d ws %zu)\n", n_in, out_size, ws_size); grid = -1; return; }
        int dev = 0, cus = 0, per_cu = 0;
        if (hipGetDevice(&dev) != hipSuccess || hipDeviceGetAttribute(&cus, hipDeviceAttributeMultiprocessorCount, dev) != hipSuccess) { grid = -1; return; }
        if (hipFuncSetAttribute((const void*)mega_fwd, hipFuncAttributeMaxDynamicSharedMemorySize, LDS_BYTES) != hipSuccess) { fprintf(stderr, "kernel_launch: hipFuncSetAttribute failed\n"); grid = -1; return; }
        if (hipOccupancyMaxActiveBlocksPerMultiprocessor(&per_cu, (const void*)mega_fwd, NWAVES * 64, LDS_BYTES) != hipSuccess || per_cu < 1) fprintf(stderr, "kernel_launch: occupancy query says %d\n", per_cu);
        (void)hipGetLastError();
        grid = cus;
    }
    if (grid < 0) return;
    (void)hipMemsetAsync((char*)d_ws + WS_CTL, 0, CTL_ZERO_BYTES, stream);
    Args a{};
    for (int i = 0; i < 12; ++i) a.in[i] = (const float*)d_in[i];
    a.out = (float*)d_out; a.ws = (unsigned char*)d_ws;
#if MK_ONE_LAUNCH
    a.ph_lo = 0; a.ph_hi = N_PHASES;
    hipLaunchKernelGGL(mega_fwd, dim3(grid), dim3(NWAVES * 64), LDS_BYTES, stream, a);
#else
    for (int p = 0; p < N_PHASES; ++p) {
        if (MK_NAIVE_ATTN && (p == 2 || p == 6)) {
            NArgs na{}; na.ws = (const unsigned char*)d_ws; na.wsw = (unsigned char*)d_ws; na.diff_lambda = (const float*)d_in[9]; na.diff_head_norm = (const float*)d_in[10]; na.rel_bias = (const float*)d_in[11]; na.layer = p / 4;
            hipLaunchKernelGGL(naive_diff, dim3(BATCH * 4 * 8), dim3(256), 0, stream, na);
            hipLaunchKernelGGL(naive_sb, dim3(BATCH * 8 * 8), dim3(256), 0, stream, na);
            hipLaunchKernelGGL(naive_fox, dim3(BATCH * 8 * 8), dim3(256), 0, stream, na);
            hipLaunchKernelGGL(naive_mem, dim3(BATCH * 4 * 8), dim3(256), 0, stream, na);
            continue;
        }
        a.ph_lo = p; a.ph_hi = p + 1;
        hipLaunchKernelGGL(mega_fwd, dim3(grid), dim3(NWAVES * 64), LDS_BYTES, stream, a);
    }
#endif
}
```
